# Optimizing an MI355X kernel written in HIP

```python
import math
import jax, jax.numpy as jnp
from jax import lax
import numpy as np

D_MODEL = 1024
BATCH = 8
SEQ = 2048
DEPTH = 1

GDN_HEADS = 8
GDN_DK = 128
GDN_DV = 128
CONV_K = 4
CHUNK = 64
DSA_HEADS = 8
DSA_DH = 128
KV_RANK = 256
IDX_HEADS = 8
IDX_DIM = 64
TOPK_MAX = 256
Q_BLOCK = 128
NUM_BUCKETS = 32
MAX_DISTANCE = 128
EPS = 1e-6

GDN_W = GDN_HEADS * GDN_DV
DSA_W = DSA_HEADS * DSA_DH
SPLITS = (GDN_HEADS * GDN_DK, GDN_HEADS * GDN_DK, GDN_W,
          GDN_W, GDN_HEADS, GDN_HEADS,
          DSA_W, KV_RANK, DSA_W,
          IDX_HEADS * IDX_DIM, IDX_DIM, IDX_HEADS,
          2 * D_MODEL)
PROJ_W = sum(SPLITS)

kernel_name = 'hybrid_gdn_dsa_gated_merge_block'


def _split_points(sizes):
    pts, acc = [], 0
    for s in sizes[:-1]:
        acc += s
        pts.append(acc)
    return pts


def rms_norm(x, g):
    xf = x.astype(jnp.float32)
    y = xf * lax.rsqrt(jnp.mean(xf * xf, axis=-1, keepdims=True) + EPS)
    return (y * g.astype(jnp.float32)).astype(x.dtype)


def l2norm(x):
    return x * lax.rsqrt(jnp.sum(x * x, axis=-1, keepdims=True) + EPS)


def causal_dwconv_silu(u, w):
    C = u.shape[-1]
    y = lax.conv_general_dilated(u, w[:, None, :].astype(u.dtype), window_strides=(1,),
                                 padding=[(CONV_K - 1, 0)],
                                 dimension_numbers=('NWC', 'WIO', 'NWC'),
                                 feature_group_count=C)
    return jax.nn.silu(y)


def gated_delta_rule(q, k, v, g, beta):
    B, T, H, DK = q.shape
    DV = v.shape[-1]
    N = T // CHUNK

    def chunks(a):
        return a.reshape(B, N, CHUNK, H, -1).transpose(0, 3, 1, 2, 4)

    q, k, v = chunks(q), chunks(k), chunks(v)
    g = g.reshape(B, N, CHUNK, H).transpose(0, 3, 1, 2)
    beta = beta.reshape(B, N, CHUNK, H).transpose(0, 3, 1, 2)
    decay = jnp.cumsum(g, axis=-1)
    pos = jnp.arange(CHUNK)
    causal = pos[:, None] >= pos[None, :]
    strict = pos[:, None] > pos[None, :]
    gamma = jnp.exp(jnp.where(causal, decay[..., :, None] - decay[..., None, :], -jnp.inf))
    kb = k * beta[..., None]
    a_mat = jnp.where(strict, jnp.einsum('bhnid,bhnjd->bhnij', kb, k) * gamma, 0.0)
    eye = jnp.eye(CHUNK, dtype=q.dtype)
    rhs = jnp.concatenate([v * beta[..., None], kb * jnp.exp(decay)[..., None]], axis=-1)
    sol = lax.linalg.triangular_solve(a_mat + eye, rhs, left_side=True, lower=True)
    u, w = sol[..., :DV], sol[..., DV:]
    attn = jnp.einsum('bhnid,bhnjd->bhnij', q, k) * gamma
    qg = q * jnp.exp(decay)[..., None]
    d_last = decay[..., -1]
    k_dec = k * jnp.exp(d_last[..., None] - decay)[..., None]

    def step(S, xs):
        u_n, w_n, qg_n, attn_n, kd_n, dl_n = xs
        v_new = u_n - jnp.einsum('bhcd,bhde->bhce', w_n, S)
        o = jnp.einsum('bhcd,bhde->bhce', qg_n, S) + jnp.einsum('bhij,bhje->bhie', attn_n, v_new)
        S = S * jnp.exp(dl_n)[..., None, None] + jnp.einsum('bhcd,bhce->bhde', kd_n, v_new)
        return S, o

    xs = tuple(jnp.moveaxis(a, 2, 0) for a in (u, w, qg, attn, k_dec, d_last))
    S0 = jnp.zeros((B, H, DK, DV), q.dtype)
    _, o = lax.scan(step, S0, xs)
    return o.transpose(1, 0, 3, 2, 4).reshape(B, T, H, DV)


def t5_bucket(dist):
    n = jnp.maximum(dist, 0)
    max_exact = NUM_BUCKETS // 2
    nf = jnp.maximum(n, 1).astype(jnp.float32)
    large = max_exact + (jnp.log(nf / max_exact) / math.log(MAX_DISTANCE / max_exact)
                         * (NUM_BUCKETS - max_exact)).astype(jnp.int32)
    large = jnp.minimum(large, NUM_BUCKETS - 1)
    return jnp.where(n < max_exact, n, large)


def dsa_attention(q_lat, c_kv, q_idx, k_idx, w_idx, rel_bias):
    B, T, H, DC = q_lat.shape
    S = c_kv.shape[1]
    k_sel = min(TOPK_MAX, S // 4)
    nb = T // Q_BLOCK
    f32 = jnp.float32

    def blocks(a):
        return jnp.moveaxis(a.reshape(B, nb, Q_BLOCK, *a.shape[2:]), 1, 0)

    key_pos = jnp.arange(S)
    k_idx32 = k_idx.astype(f32)

    def one_block(xs):
        ql, qi, wi, t0 = xs
        t = t0 + jnp.arange(Q_BLOCK)
        dots = jnp.einsum('bqhd,bsd->bqhs', qi.astype(f32), k_idx32)
        score = jnp.einsum('bqh,bqhs->bqs', wi.astype(f32), jax.nn.relu(dots))
        admissible = key_pos[None, :] <= t[:, None]
        score = jnp.where(admissible[None], score, -jnp.inf)
        _, sel = lax.top_k(score, k_sel)
        valid = sel <= t[None, :, None]
        kv = jax.vmap(lambda ck, ii: ck[ii])(c_kv, sel)
        logits = jnp.einsum('bqhc,bqkc->bqhk', ql, kv).astype(f32)
        bias = rel_bias[t5_bucket(t[None, :, None] - sel)]
        logits = logits + jnp.moveaxis(bias, -1, 2).astype(f32)
        logits = jnp.where(valid[:, :, None, :], logits, -jnp.inf)
        p = jax.nn.softmax(logits, axis=-1).astype(kv.dtype)
        return jnp.einsum('bqhk,bqkc->bqhc', p, kv)

    t0s = jnp.arange(nb) * Q_BLOCK
    o = lax.map(one_block, (blocks(q_lat), blocks(q_idx), blocks(w_idx), t0s))
    return jnp.moveaxis(o, 0, 1).reshape(B, T, H, DC)


def setup_inputs(seed: int = 0) -> dict:
    key = jax.random.key(seed)
    ks = jax.random.split(key, 20)
    nrm = jax.random.normal
    D = D_MODEL
    x = nrm(ks[0], (BATCH, SEQ, D), jnp.float32)
    c = nrm(ks[1], (BATCH, D), jnp.float32)
    norm_g = 1.0 + 0.02 * nrm(ks[2], (DEPTH, D), jnp.float32)
    w_ada = nrm(ks[3], (DEPTH, D, 3 * D), jnp.float32) * D ** -0.5
    b_ada = 0.01 * nrm(ks[4], (DEPTH, 3 * D), jnp.float32)
    w_in = nrm(ks[5], (DEPTH, D, PROJ_W), jnp.float32) * D ** -0.5
    conv_w = nrm(ks[6], (DEPTH, CONV_K, 2 * GDN_HEADS * GDN_DK + GDN_W), jnp.float32) * CONV_K ** -0.5
    a_log = jnp.log(jax.random.uniform(ks[7], (DEPTH, GDN_HEADS), jnp.float32, 1.0, 16.0))
    dt = jnp.exp(jax.random.uniform(ks[8], (DEPTH, GDN_HEADS), jnp.float32,
                                    math.log(1e-3), math.log(1e-1)))
    dt_bias = jnp.log(jnp.expm1(dt))
    gdn_norm_g = 1.0 + 0.02 * nrm(ks[9], (DEPTH, GDN_DV), jnp.float32)
    w_o_gdn = nrm(ks[10], (DEPTH, GDN_W, D), jnp.float32) * GDN_W ** -0.5
    kv_norm_g = 1.0 + 0.02 * nrm(ks[11], (DEPTH, KV_RANK), jnp.float32)
    w_uk = nrm(ks[12], (DEPTH, KV_RANK, DSA_HEADS, DSA_DH), jnp.float32) * KV_RANK ** -0.5
    w_uv = nrm(ks[13], (DEPTH, KV_RANK, DSA_HEADS, DSA_DH), jnp.float32) * KV_RANK ** -0.5
    w_o_dsa = nrm(ks[14], (DEPTH, DSA_W, D), jnp.float32) * DSA_W ** -0.5
    w_out = nrm(ks[15], (DEPTH, D, D), jnp.float32) * D ** -0.5
    rel_bias = 0.5 * nrm(ks[16], (NUM_BUCKETS, DSA_HEADS), jnp.float32)
    final_g = 1.0 + 0.02 * nrm(ks[17], (D,), jnp.float32)
    return {'x': x, 'c': c, 'norm_g': norm_g, 'w_ada': w_ada, 'b_ada': b_ada, 'w_in': w_in,
            'conv_w': conv_w, 'a_log': a_log, 'dt_bias': dt_bias, 'gdn_norm_g': gdn_norm_g,
            'w_o_gdn': w_o_gdn, 'kv_norm_g': kv_norm_g, 'w_uk': w_uk, 'w_uv': w_uv,
            'w_o_dsa': w_o_dsa, 'w_out': w_out, 'rel_bias': rel_bias, 'final_g': final_g}


def reference(x, c, norm_g, w_ada, b_ada, w_in, conv_w, a_log, dt_bias, gdn_norm_g, w_o_gdn,
              kv_norm_g, w_uk, w_uv, w_o_dsa, w_out, rel_bias, final_g):
    B, T, D = x.shape
    f32 = jnp.float32
    pts = _split_points(SPLITS)
    qkv_pts = [GDN_HEADS * GDN_DK, 2 * GDN_HEADS * GDN_DK]
    for l in range(DEPTH):
        mod = jax.nn.silu(c) @ w_ada[l] + b_ada[l]
        shift, scale, gate = jnp.split(mod, 3, axis=-1)
        h = rms_norm(x, norm_g[l]) * (1.0 + scale[:, None]) + shift[:, None]
        proj = h @ w_in[l]
        (qa, ka, va, za, aa, ba, qb, ckv, zb, qi, ki, wi, gl) = jnp.split(proj, pts, axis=-1)

        qkv = causal_dwconv_silu(jnp.concatenate([qa, ka, va], axis=-1), conv_w[l])
        qa, ka, va = jnp.split(qkv, qkv_pts, axis=-1)
        qa = l2norm(qa.reshape(B, T, GDN_HEADS, GDN_DK).astype(f32)) * GDN_DK ** -0.5
        ka = l2norm(ka.reshape(B, T, GDN_HEADS, GDN_DK).astype(f32))
        va = va.reshape(B, T, GDN_HEADS, GDN_DV).astype(f32)
        beta = jax.nn.sigmoid(ba.astype(f32))
        g = -jnp.exp(a_log[l].astype(f32)) * jax.nn.softplus(aa.astype(f32) + dt_bias[l].astype(f32))
        oa = gated_delta_rule(qa, ka, va, g, beta)
        oa = rms_norm(oa, gdn_norm_g[l]).astype(x.dtype).reshape(B, T, GDN_W) * jax.nn.silu(za)
        ya = oa @ w_o_gdn[l]

        ckv = rms_norm(ckv, kv_norm_g[l])
        qb = qb.reshape(B, T, DSA_HEADS, DSA_DH)
        q_lat = jnp.einsum('bthd,chd->bthc', qb, w_uk[l]) * DSA_DH ** -0.5
        qi = qi.reshape(B, T, IDX_HEADS, IDX_DIM)
        wi = wi * (IDX_HEADS ** -0.5 * IDX_DIM ** -0.5)
        o_lat = dsa_attention(q_lat, ckv, qi, ki, wi, rel_bias)
        ob = jnp.einsum('bthc,chd->bthd', o_lat, w_uv[l]).reshape(B, T, DSA_W) * jax.nn.silu(zb)
        yb = ob @ w_o_dsa[l]

        ga, gb = jnp.split(jax.nn.sigmoid(gl), 2, axis=-1)
        out = (ga * ya + gb * yb) @ w_out[l]
        x = x + gate[:, None] * out
    return rms_norm(x, final_g)
```

```cpp
#include <hip/hip_runtime.h>
#include <stdint.h>
#include <stdio.h>

typedef unsigned short bf16_t;
__device__ __forceinline__ float bf2f(bf16_t v) { return __uint_as_float(((unsigned)v) << 16); }
__device__ __forceinline__ bf16_t f2bf(float f) { unsigned u = __float_as_uint(f); u += 0x7FFFu + ((u >> 16) & 1u); return (bf16_t)(u >> 16); }
__device__ __forceinline__ float silu_f(float x) { return x / (1.f + __expf(-x)); }
__device__ __forceinline__ float sigmoid_f(float x) { return 1.f / (1.f + __expf(-x)); }
__device__ __forceinline__ float wave_sum(float v) {
#pragma unroll
    for (int o = 32; o > 0; o >>= 1) v += __shfl_xor(v, o);
    return v;
}
__device__ __forceinline__ float wave_max(float v) {
#pragma unroll
    for (int o = 32; o > 0; o >>= 1) v = fmaxf(v, __shfl_xor(v, o));
    return v;
}

constexpr int NB = 8, NT = 2048, DM = 1024, MROWS = NB * NT;
constexpr int NPAD = 7168;
constexpr int NWT = 9216;
constexpr size_t MiB = 1ull << 20;
constexpr size_t OFF_CTL = 0, OFF_MOD = 64 * 1024, OFF_SMALL = 1 * MiB, OFF_KI = 3 * MiB, OFF_CKV = 5 * MiB, OFF_QI = 13 * MiB,
                 OFF_QA = 29 * MiB, OFF_KA = 61 * MiB, OFF_VA = 93 * MiB, OFF_ZA = 125 * MiB, OFF_QB = 157 * MiB, OFF_ZB = 189 * MiB,
                 OFF_H = 221 * MiB, OFF_WOUT_T = 253 * MiB, WS_NEED = 255 * MiB;
constexpr size_t OFF_XNEW = OFF_QA, OFF_MERGED = OFF_VA;
constexpr size_t OO_WT = 0, OO_WOG_T = 18 * MiB, OO_WOD_T = 20 * MiB;

__host__ __device__ __forceinline__ int wt_col(int n) {
    if (n < 4096) return n;
    if (n < 5120) return 4112 + (n - 4096);
    if (n < 6144) return 5392 + (n - 5120);
    if (n < 6400) return 5136 + (n - 6144);
    if (n < 6912) return 6416 + (n - 6400);
    if (n < 6976) return 6928 + (n - 6912);
    if (n < 6984) return 4096 + (n - 6976);
    if (n < 6992) return 4104 + (n - 6984);
    if (n < 7000) return 6992 + (n - 6992);
    if (n < 7168) return -1;
    return 7000 + (n - 7168);
}

struct Bufs {
    bf16_t *QA, *KA, *VA, *ZA, *QB, *ZB, *CKV, *QI, *KI, *H, *WT, *WOG_T, *WOD_T, *WOUT_T, *MERGED;
    float *SMALL, *MOD, *XNEW;
};

__global__ void k_mod(const float* __restrict__ c, const float* __restrict__ w_ada, const float* __restrict__ b_ada, float* __restrict__ mod) {
    const int j = blockIdx.x * 256 + threadIdx.x, b = blockIdx.y;
    float acc = 0.f;
    for (int i = 0; i < DM; ++i) { const float cv = c[b * DM + i]; acc += silu_f(cv) * w_ada[(size_t)i * 3072 + j]; }
    mod[b * 3072 + j] = acc + b_ada[j];
}
__global__ void k_transpose_cvt(const float* __restrict__ src, int ld_src, bf16_t* __restrict__ dst, int N, int K, int mode) {
    __shared__ float tile[32][33];
    const int n0 = blockIdx.x * 32, k0 = blockIdx.y * 32, tx = threadIdx.x & 31, ty = threadIdx.x >> 5;
#pragma unroll
    for (int i = 0; i < 4; ++i) {
        const int k = k0 + ty + i * 8, n = n0 + tx; const int col = mode ? wt_col(n) : n;
        tile[ty + i * 8][tx] = (col >= 0) ? src[(size_t)k * ld_src + col] : 0.f;
    }
    __syncthreads();
#pragma unroll
    for (int i = 0; i < 4; ++i) { const int n = n0 + ty + i * 8, k = k0 + tx; dst[(size_t)n * K + k] = f2bf(tile[tx][ty + i * 8]); }
}
__global__ void k_h(const float* __restrict__ x, const float* __restrict__ norm_g, const float* __restrict__ mod, bf16_t* __restrict__ H) {
    const int row = blockIdx.x * 4 + (threadIdx.x >> 6), lane = threadIdx.x & 63, b = row >> 11;
    const float* xr = x + (size_t)row * DM; float v[16]; float ss = 0.f;
#pragma unroll
    for (int i = 0; i < 16; ++i) { v[i] = xr[lane + 64 * i]; ss += v[i] * v[i]; }
    ss = wave_sum(ss);
    const float r = rsqrtf(ss * (1.f / DM) + 1e-6f);
#pragma unroll
    for (int i = 0; i < 16; ++i) { const int col = lane + 64 * i; float y = v[i] * r * norm_g[col]; y = y * (1.f + mod[b * 3072 + 1024 + col]) + mod[b * 3072 + col]; H[(size_t)row * DM + col] = f2bf(y); }
}

__device__ __forceinline__ void gemm_tile_64(const bf16_t* __restrict__ A, int lda, const bf16_t* __restrict__ Bt, int ldb, int K, int row0, int col0,
                                             float (&acc)[4][4], float* As, float* Bs) {
    const int tid = threadIdx.x, tx = tid & 15, ty = tid >> 4, lr = tid >> 2, lk = (tid & 3) * 8;
    for (int k0 = 0; k0 < K; k0 += 32) {
        const uint4 av = *(const uint4*)(A + (size_t)(row0 + lr) * lda + k0 + lk);
        const uint4 bv = *(const uint4*)(Bt + (size_t)(col0 + lr) * ldb + k0 + lk);
        __syncthreads();
        const unsigned aw[4] = {av.x, av.y, av.z, av.w}, bw[4] = {bv.x, bv.y, bv.z, bv.w};
#pragma unroll
        for (int j = 0; j < 4; ++j) {
            As[(lk + 2 * j) * 68 + lr] = __uint_as_float(aw[j] << 16); As[(lk + 2 * j + 1) * 68 + lr] = __uint_as_float(aw[j] & 0xFFFF0000u);
            Bs[(lk + 2 * j) * 68 + lr] = __uint_as_float(bw[j] << 16); Bs[(lk + 2 * j + 1) * 68 + lr] = __uint_as_float(bw[j] & 0xFFFF0000u);
        }
        __syncthreads();
#pragma unroll 8
        for (int k = 0; k < 32; ++k) {
            const float4 a = *(const float4*)(As + k * 68 + ty * 4), b = *(const float4*)(Bs + k * 68 + tx * 4);
            const float aa[4] = {a.x, a.y, a.z, a.w}, bb[4] = {b.x, b.y, b.z, b.w};
#pragma unroll
            for (int i = 0; i < 4; ++i)
#pragma unroll
                for (int j = 0; j < 4; ++j) acc[i][j] += aa[i] * bb[j];
        }
    }
}
__device__ __forceinline__ void zero_acc(float (&acc)[4][4]) {
#pragma unroll
    for (int i = 0; i < 4; ++i)
#pragma unroll
        for (int j = 0; j < 4; ++j) acc[i][j] = 0.f;
}

__global__ void __launch_bounds__(256) k_proj_naive(Bufs B) {
    __shared__ float As[32 * 68], Bs[32 * 68];
    const int col0 = blockIdx.x * 64, row0 = blockIdx.y * 64, tx = threadIdx.x & 15, ty = threadIdx.x >> 4;
    float acc[4][4]; zero_acc(acc);
    gemm_tile_64(B.H, DM, B.WT, DM, DM, row0, col0, acc, As, Bs);
#pragma unroll
    for (int i = 0; i < 4; ++i)
#pragma unroll
        for (int j = 0; j < 4; ++j) {
            const size_t row = row0 + ty * 4 + i; const int n = col0 + tx * 4 + j; const float v = acc[i][j];
            if (n < 1024) B.QA[row * 1024 + n] = f2bf(v);
            else if (n < 2048) B.KA[row * 1024 + (n - 1024)] = f2bf(v);
            else if (n < 3072) B.VA[row * 1024 + (n - 2048)] = f2bf(v);
            else if (n < 4096) B.ZA[row * 1024 + (n - 3072)] = f2bf(v);
            else if (n < 5120) B.QB[row * 1024 + (n - 4096)] = f2bf(v);
            else if (n < 6144) B.ZB[row * 1024 + (n - 5120)] = f2bf(v);
            else if (n < 6400) B.CKV[row * 256 + (n - 6144)] = f2bf(v);
            else if (n < 6912) B.QI[row * 512 + (n - 6400)] = f2bf(v);
            else if (n < 6976) B.KI[row * 64 + (n - 6912)] = f2bf(v);
            else if (n < 7000) B.SMALL[row * 32 + (n - 6976)] = v;
        }
}

__global__ void k_ckvnorm(bf16_t* __restrict__ CKV, const float* __restrict__ g) {
    const int row = blockIdx.x * 4 + (threadIdx.x >> 6), lane = threadIdx.x & 63;
    bf16_t* r = CKV + (size_t)row * 256; float v[4]; float ss = 0.f;
#pragma unroll
    for (int i = 0; i < 4; ++i) { v[i] = bf2f(r[lane + 64 * i]); ss += v[i] * v[i]; }
    ss = wave_sum(ss);
    const float rs = rsqrtf(ss * (1.f / 256.f) + 1e-6f);
#pragma unroll
    for (int i = 0; i < 4; ++i) r[lane + 64 * i] = f2bf(v[i] * rs * g[lane + 64 * i]);
}

__global__ void __launch_bounds__(256) k_gdn_naive(Bufs B, const float* __restrict__ conv_w, const float* __restrict__ a_log, const float* __restrict__ dt_bias,
                                                   const float* __restrict__ gdn_norm_g) {
    const int b = blockIdx.x >> 3, h = blockIdx.x & 7, tid = threadIdx.x, dv = tid & 127, half = tid >> 7, wv = tid >> 6;
    __shared__ float sq[128], sk[128], sv[128], part[2][128], part2[2][128], sred[4], sred2[2];
    float S[64];
#pragma unroll
    for (int i = 0; i < 64; ++i) S[i] = 0.f;
    const int ch0 = (half == 0 ? 0 : 1024) + h * 128 + dv, ch1 = 2048 + h * 128 + dv;
    float w0[4], w1[4];
#pragma unroll
    for (int j = 0; j < 4; ++j) { w0[j] = conv_w[j * 3072 + ch0]; w1[j] = conv_w[j * 3072 + ch1]; }
    float h0a = 0.f, h0b = 0.f, h0c = 0.f, h1a = 0.f, h1b = 0.f, h1c = 0.f;
    const float Aexp = __expf(a_log[h]), dtb = dt_bias[h], gn = gdn_norm_g[dv];
    const bf16_t* src0 = (half == 0 ? B.QA : B.KA);
    for (int t = 0; t < NT; ++t) {
        const size_t row = (size_t)b * NT + t;
        const float raw0 = bf2f(src0[row * 1024 + h * 128 + dv]);
        const float y0 = silu_f(w0[0] * h0a + w0[1] * h0b + w0[2] * h0c + w0[3] * raw0);
        h0a = h0b; h0b = h0c; h0c = raw0;
        if (half == 0) {
            const float raw1 = bf2f(B.VA[row * 1024 + h * 128 + dv]);
            const float y1 = silu_f(w1[0] * h1a + w1[1] * h1b + w1[2] * h1c + w1[3] * raw1);
            h1a = h1b; h1b = h1c; h1c = raw1;
            sq[dv] = y0; sv[dv] = y1;
        } else sk[dv] = y0;
        const float s2 = wave_sum(y0 * y0);
        if ((tid & 63) == 0) sred[wv] = s2;
        __syncthreads();
        const float qn = rsqrtf(sred[0] + sred[1] + 1e-6f) * 0.08838834764831845f, kn = rsqrtf(sred[2] + sred[3] + 1e-6f);
        const float beta = sigmoid_f(B.SMALL[row * 32 + 8 + h]);
        const float xg = B.SMALL[row * 32 + h] + dtb;
        const float sp = xg > 20.f ? xg : log1pf(__expf(xg));
        const float a = __expf(-Aexp * sp);
        float p = 0.f;
#pragma unroll
        for (int i = 0; i < 64; ++i) p += sk[half * 64 + i] * S[i];
        part[half][dv] = p * kn;
        __syncthreads();
        const float kS = part[0][dv] + part[1][dv];
        const float vnew = beta * (sv[dv] - a * kS);
        float o = 0.f;
#pragma unroll
        for (int i = 0; i < 64; ++i) { S[i] = a * S[i] + (sk[half * 64 + i] * kn) * vnew; o += sq[half * 64 + i] * S[i]; }
        part2[half][dv] = o * qn;
        __syncthreads();
        float ov = 0.f;
        if (half == 0) {
            ov = part2[0][dv] + part2[1][dv];
            const float o2 = wave_sum(ov * ov);
            if ((tid & 63) == 0) sred2[wv] = o2;
        }
        __syncthreads();
        if (half == 0) {
            const float rs = rsqrtf((sred2[0] + sred2[1]) * (1.f / 128.f) + 1e-6f);
            const size_t zi = row * 1024 + h * 128 + dv;
            const float z = bf2f(B.ZA[zi]);
            B.ZA[zi] = f2bf(ov * rs * gn * silu_f(z));
        }
    }
}

__device__ const unsigned char T5_BUCKET[128] = {
    0, 1, 2, 3, 4, 5, 6, 7, 8, 9, 10, 11, 12, 13, 14, 15, 16, 16, 16, 17, 17, 18, 18, 18, 19, 19, 19, 20, 20, 20, 20, 21,
    21, 21, 21, 22, 22, 22, 22, 22, 23, 23, 23, 23, 23, 23, 24, 24, 24, 24, 24, 24, 25, 25, 25, 25, 25, 25, 25, 26, 26, 26, 26, 26,
    26, 26, 26, 27, 27, 27, 27, 27, 27, 27, 27, 27, 27, 28, 28, 28, 28, 28, 28, 28, 28, 28, 28, 29, 29, 29, 29, 29, 29, 29, 29, 29,
    29, 29, 29, 30, 30, 30, 30, 30, 30, 30, 30, 30, 30, 30, 30, 30, 30, 31, 31, 31, 31, 31, 31, 31, 31, 31, 31, 31, 31, 31, 31, 31};
__device__ __forceinline__ int t5_bucket(int n) { return n >= 128 ? 31 : (int)T5_BUCKET[n]; }

__global__ void __launch_bounds__(256) k_dsa_naive(Bufs B, const float* __restrict__ w_uk, const float* __restrict__ w_uv, const float* __restrict__ rel_bias) {
    const int row = blockIdx.x, b = row >> 11, t = row & 2047, tid = threadIdx.x, lane = tid & 63, wv = tid >> 6;
    __shared__ float s_score[2048], s_qi[512], s_wi[8], s_q[1024], s_qlat[2048], s_p[2048], s_ol[2048];
    __shared__ int s_sel[256]; __shared__ int s_cnt;
    for (int i = tid; i < 512; i += 256) s_qi[i] = bf2f(B.QI[(size_t)row * 512 + i]);
    for (int i = tid; i < 1024; i += 256) s_q[i] = bf2f(B.QB[(size_t)row * 1024 + i]);
    if (tid < 8) s_wi[tid] = B.SMALL[(size_t)row * 32 + 16 + tid] * 0.04419417382415922f;
    if (tid == 0) s_cnt = 0;
    __syncthreads();
    const int nvalid = t + 1;
    for (int s = tid; s < nvalid; s += 256) {
        const bf16_t* kr = B.KI + ((size_t)b * NT + s) * 64;
        float acc[8];
#pragma unroll
        for (int hh = 0; hh < 8; ++hh) acc[hh] = 0.f;
        for (int d = 0; d < 64; ++d) { const float kd = bf2f(kr[d]);
#pragma unroll
            for (int hh = 0; hh < 8; ++hh) acc[hh] += s_qi[hh * 64 + d] * kd; }
        float sc = 0.f;
#pragma unroll
        for (int hh = 0; hh < 8; ++hh) sc += s_wi[hh] * fmaxf(acc[hh], 0.f);
        s_score[s] = sc;
    }
    __syncthreads();
    int nsel;
    if (nvalid <= 256) { for (int s = tid; s < nvalid; s += 256) s_sel[s] = s; nsel = nvalid; }
    else {
        for (int s = tid; s < nvalid; s += 256) {
            const float v = s_score[s]; int rank = 0;
            for (int s2 = 0; s2 < nvalid; ++s2) { const float v2 = s_score[s2]; rank += (v2 > v || (v2 == v && s2 < s)) ? 1 : 0; }
            if (rank < 256) { const int pos = atomicAdd(&s_cnt, 1); s_sel[pos] = s; }
        }
        nsel = 256;
    }
    for (int o = tid; o < 2048; o += 256) {
        const int hh = o >> 8, c = o & 255; const float* wr = w_uk + (size_t)c * 1024 + hh * 128; float d = 0.f;
        for (int k = 0; k < 128; ++k) d += s_q[hh * 128 + k] * wr[k];
        s_qlat[o] = d * 0.08838834764831845f;
    }
    __syncthreads();
    for (int o = tid; o < 2048; o += 256) {
        const int hh = o >> 8, k = o & 255;
        if (k < nsel) {
            const int s = s_sel[k]; const bf16_t* cr = B.CKV + ((size_t)b * NT + s) * 256; float d = 0.f;
            for (int c = 0; c < 256; ++c) d += s_qlat[hh * 256 + c] * bf2f(cr[c]);
            s_p[o] = d + rel_bias[t5_bucket(t - s) * 8 + hh];
        }
    }
    __syncthreads();
    for (int hh = wv; hh < 8; hh += 4) {
        float m = -3.0e38f;
        for (int k = lane; k < nsel; k += 64) m = fmaxf(m, s_p[hh * 256 + k]);
        m = wave_max(m);
        float sum = 0.f;
        for (int k = lane; k < nsel; k += 64) { const float e = __expf(s_p[hh * 256 + k] - m); s_p[hh * 256 + k] = e; sum += e; }
        sum = wave_sum(sum);
        const float inv = 1.f / sum;
        for (int k = lane; k < nsel; k += 64) s_p[hh * 256 + k] *= inv;
    }
    __syncthreads();
    for (int o = tid; o < 2048; o += 256) {
        const int hh = o >> 8, c = o & 255; float d = 0.f;
        for (int k = 0; k < nsel; ++k) d += s_p[hh * 256 + k] * bf2f(B.CKV[((size_t)b * NT + s_sel[k]) * 256 + c]);
        s_ol[o] = d;
    }
    __syncthreads();
    for (int o = tid; o < 1024; o += 256) {
        const int hh = o >> 7, d = o & 127; float acc = 0.f;
        for (int c = 0; c < 256; ++c) acc += s_ol[hh * 256 + c] * w_uv[(size_t)c * 1024 + hh * 128 + d];
        const float z = bf2f(B.ZB[(size_t)row * 1024 + o]);
        B.QB[(size_t)row * 1024 + o] = f2bf(acc * silu_f(z));
    }
}

__global__ void __launch_bounds__(256) k_merge_naive(Bufs B) {
    __shared__ float As[32 * 68], Bs[32 * 68];
    const int col0 = blockIdx.x * 64, row0 = blockIdx.y * 64, tx = threadIdx.x & 15, ty = threadIdx.x >> 4;
    float ga[4][4], gb[4][4], ya[4][4], yb[4][4]; zero_acc(ga); zero_acc(gb); zero_acc(ya); zero_acc(yb);
    gemm_tile_64(B.H, DM, B.WT + (size_t)7168 * DM, DM, DM, row0, col0, ga, As, Bs);
    gemm_tile_64(B.H, DM, B.WT + (size_t)8192 * DM, DM, DM, row0, col0, gb, As, Bs);
    gemm_tile_64(B.ZA, DM, B.WOG_T, DM, DM, row0, col0, ya, As, Bs);
    gemm_tile_64(B.QB, DM, B.WOD_T, DM, DM, row0, col0, yb, As, Bs);
#pragma unroll
    for (int i = 0; i < 4; ++i)
#pragma unroll
        for (int j = 0; j < 4; ++j) {
            const size_t row = row0 + ty * 4 + i; const int n = col0 + tx * 4 + j;
            B.MERGED[row * 1024 + n] = f2bf(sigmoid_f(ga[i][j]) * ya[i][j] + sigmoid_f(gb[i][j]) * yb[i][j]);
        }
}
__global__ void __launch_bounds__(256) k_out_naive(Bufs B, const float* __restrict__ x) {
    __shared__ float As[32 * 68], Bs[32 * 68];
    const int col0 = blockIdx.x * 64, row0 = blockIdx.y * 64, tx = threadIdx.x & 15, ty = threadIdx.x >> 4;
    float acc[4][4]; zero_acc(acc);
    gemm_tile_64(B.MERGED, DM, B.WOUT_T, DM, DM, row0, col0, acc, As, Bs);
#pragma unroll
    for (int i = 0; i < 4; ++i)
#pragma unroll
        for (int j = 0; j < 4; ++j) {
            const size_t row = row0 + ty * 4 + i; const int n = col0 + tx * 4 + j; const int b = (int)(row >> 11);
            B.XNEW[row * 1024 + n] = x[row * 1024 + n] + B.MOD[b * 3072 + 2048 + n] * acc[i][j];
        }
}
__global__ void k_final(const float* __restrict__ xnew, const float* __restrict__ final_g, float* __restrict__ out) {
    const int row = blockIdx.x * 4 + (threadIdx.x >> 6), lane = threadIdx.x & 63;
    const float* xr = xnew + (size_t)row * DM; float v[16]; float ss = 0.f;
#pragma unroll
    for (int i = 0; i < 16; ++i) { v[i] = xr[lane + 64 * i]; ss += v[i] * v[i]; }
    ss = wave_sum(ss);
    const float r = rsqrtf(ss * (1.f / DM) + 1e-6f);
#pragma unroll
    for (int i = 0; i < 16; ++i) { const int col = lane + 64 * i; out[(size_t)row * DM + col] = v[i] * r * final_g[col]; }
}

extern "C" void kernel_launch(void* const* d_in, const int* in_sizes, int n_in, void* d_out, int out_size, void* d_ws, size_t ws_size, hipStream_t stream) {
    if (n_in != 18 || ws_size < WS_NEED || out_size != MROWS * DM) { fprintf(stderr, "kernel_launch: unexpected shapes (n_in %d, ws %zu, out %d)\n", n_in, ws_size, out_size); return; }
    const float* x = (const float*)d_in[0]; const float* c = (const float*)d_in[1]; const float* norm_g = (const float*)d_in[2];
    const float* w_ada = (const float*)d_in[3]; const float* b_ada = (const float*)d_in[4]; const float* w_in = (const float*)d_in[5];
    const float* conv_w = (const float*)d_in[6]; const float* a_log = (const float*)d_in[7]; const float* dt_bias = (const float*)d_in[8];
    const float* gdn_norm_g = (const float*)d_in[9]; const float* w_o_gdn = (const float*)d_in[10]; const float* kv_norm_g = (const float*)d_in[11];
    const float* w_uk = (const float*)d_in[12]; const float* w_uv = (const float*)d_in[13]; const float* w_o_dsa = (const float*)d_in[14];
    const float* w_out = (const float*)d_in[15]; const float* rel_bias = (const float*)d_in[16]; const float* final_g = (const float*)d_in[17];
    char* ws = (char*)d_ws; char* os = (char*)d_out;
    Bufs B{};
    B.QA = (bf16_t*)(ws + OFF_QA); B.KA = (bf16_t*)(ws + OFF_KA); B.VA = (bf16_t*)(ws + OFF_VA); B.ZA = (bf16_t*)(ws + OFF_ZA);
    B.QB = (bf16_t*)(ws + OFF_QB); B.ZB = (bf16_t*)(ws + OFF_ZB); B.CKV = (bf16_t*)(ws + OFF_CKV); B.QI = (bf16_t*)(ws + OFF_QI);
    B.KI = (bf16_t*)(ws + OFF_KI); B.H = (bf16_t*)(ws + OFF_H); B.WT = (bf16_t*)(os + OO_WT); B.WOG_T = (bf16_t*)(os + OO_WOG_T);
    B.WOD_T = (bf16_t*)(os + OO_WOD_T); B.WOUT_T = (bf16_t*)(ws + OFF_WOUT_T); B.MERGED = (bf16_t*)(ws + OFF_MERGED);
    B.SMALL = (float*)(ws + OFF_SMALL); B.MOD = (float*)(ws + OFF_MOD); B.XNEW = (float*)(ws + OFF_XNEW);

    hipLaunchKernelGGL(k_mod, dim3(12, 8), dim3(256), 0, stream, c, w_ada, b_ada, B.MOD);
    hipLaunchKernelGGL(k_transpose_cvt, dim3(NWT / 32, DM / 32), dim3(256), 0, stream, w_in, 9048, B.WT, NWT, DM, 1);
    hipLaunchKernelGGL(k_transpose_cvt, dim3(32, 32), dim3(256), 0, stream, w_o_gdn, 1024, B.WOG_T, 1024, 1024, 0);
    hipLaunchKernelGGL(k_transpose_cvt, dim3(32, 32), dim3(256), 0, stream, w_o_dsa, 1024, B.WOD_T, 1024, 1024, 0);
    hipLaunchKernelGGL(k_transpose_cvt, dim3(32, 32), dim3(256), 0, stream, w_out, 1024, B.WOUT_T, 1024, 1024, 0);
    hipLaunchKernelGGL(k_h, dim3(MROWS / 4), dim3(256), 0, stream, x, norm_g, B.MOD, B.H);
    hipLaunchKernelGGL(k_proj_naive, dim3(NPAD / 64, MROWS / 64), dim3(256), 0, stream, B);
    hipLaunchKernelGGL(k_ckvnorm, dim3(MROWS / 4), dim3(256), 0, stream, B.CKV, kv_norm_g);
    hipLaunchKernelGGL(k_gdn_naive, dim3(64), dim3(256), 0, stream, B, conv_w, a_log, dt_bias, gdn_norm_g);
    hipLaunchKernelGGL(k_dsa_naive, dim3(MROWS), dim3(256), 0, stream, B, w_uk, w_uv, rel_bias);
    hipLaunchKernelGGL(k_merge_naive, dim3(DM / 64, MROWS / 64), dim3(256), 0, stream, B);
    hipLaunchKernelGGL(k_out_naive, dim3(DM / 64, MROWS / 64), dim3(256), 0, stream, B, x);
    hipLaunchKernelGGL(k_final, dim3(MROWS / 4), dim3(256), 0, stream, B.XNEW, final_g, (float*)d_out);
}
```

```cpp
#include <hip/hip_runtime.h>
#include <stdint.h>
#include <stdio.h>

#define LAS __attribute__((address_space(3)))
typedef unsigned short bf16_t;
typedef short bf16x8 __attribute__((ext_vector_type(8)));
typedef float f32x4 __attribute__((ext_vector_type(4)));
typedef unsigned u32x4 __attribute__((ext_vector_type(4)));
typedef unsigned u32x2 __attribute__((ext_vector_type(2)));
__device__ __forceinline__ float bf2f(bf16_t v) { return __uint_as_float(((unsigned)v) << 16); }
__device__ __forceinline__ bf16_t f2bf(float f) { unsigned u = __float_as_uint(f); u += 0x7FFFu + ((u >> 16) & 1u); return (bf16_t)(u >> 16); }
__device__ __forceinline__ float bflo(unsigned w) { return __uint_as_float(w << 16); }
__device__ __forceinline__ float bfhi(unsigned w) { return __uint_as_float(w & 0xFFFF0000u); }
__device__ __forceinline__ unsigned cvt_pk_bf16(float lo, float hi) { unsigned r; asm volatile("v_cvt_pk_bf16_f32 %0, %1, %2" : "=v"(r) : "v"(lo), "v"(hi)); return r; }
__device__ __forceinline__ float silu_f(float x) { return x / (1.f + __expf(-x)); }
__device__ __forceinline__ float sigmoid_f(float x) { return 1.f / (1.f + __expf(-x)); }
__device__ __forceinline__ float wave_sum(float v) {
#pragma unroll
    for (int o = 32; o > 0; o >>= 1) v += __shfl_xor(v, o);
    return v;
}
__device__ __forceinline__ float wave_max(float v) {
#pragma unroll
    for (int o = 32; o > 0; o >>= 1) v = fmaxf(v, __shfl_xor(v, o));
    return v;
}

constexpr int NB = 8, NT = 2048, DM = 1024, MROWS = NB * NT;
constexpr int NPAD = 7168;
constexpr int NWT = 9216;
constexpr size_t MiB = 1ull << 20;
constexpr size_t OFF_CTL = 0, CTL_ZERO_BYTES = 64 * 1024, OFF_MOD = 64 * 1024, OFF_SMALL = 1 * MiB, OFF_KI = 3 * MiB, OFF_CKV = 5 * MiB, OFF_QI = 13 * MiB,
                 OFF_QA = 29 * MiB, OFF_KA = 61 * MiB, OFF_VA = 93 * MiB, OFF_ZA = 125 * MiB, OFF_QB = 157 * MiB, OFF_ZB = 189 * MiB,
                 OFF_H = 221 * MiB, OFF_WOUT_T = 253 * MiB, WS_NEED = 255 * MiB;
constexpr size_t OFF_XNEW = OFF_QA, OFF_MERGED = OFF_VA, OFF_PARK = OFF_KA;
constexpr size_t OO_WT = 0, OO_WOG_T = 18 * MiB, OO_WOD_T = 20 * MiB;
constexpr size_t OO_TPATT = 31 * MiB;
constexpr size_t OO_STASH = 55 * MiB;
constexpr size_t OO_DEC = 60 * MiB;
constexpr size_t OO_WUK_B = 22 * MiB;
constexpr size_t OO_WUV_T = 22 * MiB + 512 * 1024;
constexpr size_t OO_IDX = 23 * MiB;
constexpr int CW_BAR = 1024;

__host__ __device__ __forceinline__ int wt_col(int n) {
    if (n < 4096) return n;
    if (n < 5120) return 4112 + (n - 4096);
    if (n < 6144) return 5392 + (n - 5120);
    if (n < 6400) return 5136 + (n - 6144);
    if (n < 6912) return 6416 + (n - 6400);
    if (n < 6976) return 6928 + (n - 6912);
    if (n < 6984) return 4096 + (n - 6976);
    if (n < 6992) return 4104 + (n - 6984);
    if (n < 7000) return 6992 + (n - 6992);
    if (n < 7168) return -1;
    return 7000 + (n - 7168);
}

struct Bufs {
    bf16_t *QA, *KA, *VA, *ZA, *QB, *ZB, *CKV, *QI, *KI, *H, *WT, *WOG_T, *WOD_T, *WOUT_T, *MERGED, *PARK;
    float *SMALL, *MOD, *XNEW;
};
__host__ __device__ __forceinline__ Bufs make_bufs(char* ws, char* os) {
    Bufs B;
    B.QA = (bf16_t*)(ws + OFF_QA); B.KA = (bf16_t*)(ws + OFF_KA); B.VA = (bf16_t*)(ws + OFF_VA); B.ZA = (bf16_t*)(ws + OFF_ZA);
    B.QB = (bf16_t*)(ws + OFF_QB); B.ZB = (bf16_t*)(ws + OFF_ZB); B.CKV = (bf16_t*)(ws + OFF_CKV); B.QI = (bf16_t*)(ws + OFF_QI);
    B.KI = (bf16_t*)(ws + OFF_KI); B.H = (bf16_t*)(ws + OFF_H); B.WT = (bf16_t*)(os + OO_WT); B.WOG_T = (bf16_t*)(os + OO_WOG_T);
    B.WOD_T = (bf16_t*)(os + OO_WOD_T); B.WOUT_T = (bf16_t*)(ws + OFF_WOUT_T); B.MERGED = (bf16_t*)(ws + OFF_MERGED); B.PARK = (bf16_t*)(ws + OFF_PARK);
    B.SMALL = (float*)(ws + OFF_SMALL); B.MOD = (float*)(ws + OFF_MOD); B.XNEW = (float*)(ws + OFF_XNEW);
    return B;
}

namespace pg8 {
#define PG8_LAS __attribute__((address_space(3)))
constexpr int BM = 256, BK = 64, HALF = 128, HTB = HALF * BK * 2  , STAGE_BYTES = 8 * HTB, NXCD = 8, WGM = 8;
__host__ __device__ __forceinline__ int lds_byte(int r, int c) { const int st = (r >> 4) * 2 + (c >> 5), rr = r & 15, cc = c & 31, ob = rr * 64 + cc * 2; return st * 1024 + (ob ^ (((ob >> 9) & 1) << 5)); }
__host__ __device__ __forceinline__ void stage_rc(int b, int& R, int& C) { const int st = b / 1024, sb = b % 1024, swz = sb ^ (((sb >> 9) & 1) << 5); R = (st >> 1) * 16 + swz / 64; C = (st & 1) * 32 + (swz % 64) / 2; }
__host__ __device__ __forceinline__ int perm32(int rho) { const int n = rho >> 4, i = rho & 15; return 8 * (i >> 2) + 4 * n + (i & 3); }
struct Unit { int pm, pn, st; };
struct StaticOrder {
    int nM, nN, nwg, G, c;
    __host__ __device__ void init(int M, int N, int G_, int c_) { nM = M / BM; nN = N / BM; nwg = nM * nN; G = G_; c = c_; }
    __host__ __device__ bool tile(int i, int& pm, int& pn) const {
        const long L = (long)i * G + c; if (L >= nwg) return false;
        int wgid = (int)L; { const int q = nwg / NXCD, r = nwg % NXCD, xcd = wgid % NXCD, off = wgid / NXCD; wgid = (xcd < r ? xcd * (q + 1) : r * (q + 1) + (xcd - r) * q) + off; }
        const int nig = WGM * nN, gid = wgid / nig, fm = gid * WGM, gsz = (nM - fm) < WGM ? (nM - fm) : WGM;
        pm = fm + ((wgid % nig) % gsz); pn = (wgid % nig) / gsz; return true;
    }
};
template <class Epi, class Sched, bool ALIGN_EPI = false, bool SP2 = false>
__device__ __forceinline__ void gemm_phase(PG8_LAS unsigned char* lds, const int K, const int lda, const int ldb, const Sched& S, const Epi& E) {
    const int tid = threadIdx.x, wid = __builtin_amdgcn_readfirstlane(tid >> 6), lane = tid & 63, wr = wid >> 2, wc = wid & 3, fr = lane & 15, fq = lane >> 4;
    const int nt = K / BK;
    unsigned voffA[2], voffB[2];
#pragma unroll
    for (int i = 0; i < 2; ++i) { int R, C; stage_rc(tid * 16 + i * 8192, R, C); const int Rb = Epi::PERM ? ((R & ~31) + perm32(R & 31)) : R;
        voffA[i] = (unsigned)(R * lda + C) * 2u; voffB[i] = (unsigned)(Rb * ldb + C) * 2u; }
    const size_t kstep = (size_t)(BK * 2);
    const size_t hstepA = (size_t)HALF * lda * 2, hstepB = (size_t)HALF * ldb * 2;
    const unsigned ldsw = (unsigned)wid * 1024u;
    const int aoff = lds_byte(wr * 64 + fr, fq * 8), boff = lds_byte(wc * 32 + fr, fq * 8);
#define PG8_SA(b, h) (((b) * 2 + (h)) * HTB)
#define PG8_SB(b, h) ((4 + (b) * 2 + (h)) * HTB)
#define PG8_STAGE(bufoff, gbase, voff) do { _Pragma("unroll") for (int _i = 0; _i < 2; ++_i) \
        __builtin_amdgcn_global_load_lds((const unsigned*)((const char*)(gbase) + (voff)[_i]), (PG8_LAS unsigned*)(lds + (bufoff) + ldsw + _i * 8192), 16, 0, 0); } while (0)
#define PG8_LDA(dst, b, h) do { _Pragma("unroll") for (int m = 0; m < 4; ++m) _Pragma("unroll") for (int k = 0; k < 2; ++k) dst[m][k] = *(const PG8_LAS bf16x8*)(lds + PG8_SA(b, h) + aoff + m * 2048 + k * 1024); } while (0)
#define PG8_LDB(dst, b, h) do { _Pragma("unroll") for (int n = 0; n < 2; ++n) _Pragma("unroll") for (int k = 0; k < 2; ++k) dst[n][k] = *(const PG8_LAS bf16x8*)(lds + PG8_SB(b, h) + boff + n * 2048 + k * 1024); } while (0)
#define PG8_MMA(ai, bj, At, Bt) do { __builtin_amdgcn_s_setprio(1); _Pragma("unroll") for (int m = 0; m < 4; ++m) _Pragma("unroll") for (int n = 0; n < 2; ++n) _Pragma("unroll") for (int k = 0; k < 2; ++k) \
        acc[ai][bj][m][n] = __builtin_amdgcn_mfma_f32_16x16x32_bf16(Bt[n][k], At[m][k], acc[ai][bj][m][n], 0, 0, 0); __builtin_amdgcn_s_setprio(0); } while (0)
#define PG8_WAIT_V(n) asm volatile("s_waitcnt vmcnt(" #n ")" ::: "memory")
#define PG8_WAIT_L(n) asm volatile("s_waitcnt lgkmcnt(" #n ")" ::: "memory")
#define PG8_BAR __builtin_amdgcn_s_barrier()
#define PG8_SCHED __builtin_amdgcn_sched_barrier(0)
    Unit cur, nxt; int ui = 0;
    if (!S.next(0, cur)) return;
    f32x4 acc[2][2][4][2];
#pragma unroll
    for (int a = 0; a < 2; ++a)
#pragma unroll
        for (int b = 0; b < 2; ++b)
#pragma unroll
            for (int m = 0; m < 4; ++m)
#pragma unroll
                for (int n = 0; n < 2; ++n) acc[a][b][m][n] = (f32x4){0.f, 0.f, 0.f, 0.f};
    bf16x8 At[4][2], B0[2][2], B1[2][2];
    const char* cA = S.a_ptr(cur); const char* cB = S.b_ptr(cur);
    S.a_ready(cur);
    if constexpr (SP2) {
        PG8_STAGE(PG8_SB(0, 0), cB, voffB); PG8_STAGE(PG8_SB(0, 1), cB + hstepB, voffB); PG8_STAGE(PG8_SA(0, 0), cA, voffA); PG8_STAGE(PG8_SA(0, 1), cA + hstepA, voffA);
        if (wr == 1) PG8_BAR;
        PG8_WAIT_V(2); PG8_BAR;
        PG8_STAGE(PG8_SB(1, 0), cB + kstep, voffB); PG8_STAGE(PG8_SA(1, 0), cA + kstep, voffA); PG8_STAGE(PG8_SB(1, 1), cB + hstepB + kstep, voffB);
        PG8_WAIT_V(6); PG8_BAR;
    } else {
        PG8_STAGE(PG8_SB(0, 0), cB, voffB); PG8_STAGE(PG8_SA(0, 0), cA, voffA); PG8_STAGE(PG8_SB(0, 1), cB + hstepB, voffB); PG8_STAGE(PG8_SA(0, 1), cA + hstepA, voffA);
        if (wr == 1) PG8_BAR;
        PG8_WAIT_V(4); PG8_BAR;
        PG8_STAGE(PG8_SB(1, 0), cB + kstep, voffB); PG8_STAGE(PG8_SA(1, 0), cA + kstep, voffA); PG8_STAGE(PG8_SB(1, 1), cB + hstepB + kstep, voffB);
        PG8_WAIT_V(6); PG8_BAR;
    }
    for (;;) {
        const bool has_next = S.next(ui + 1, nxt);
        const char* nA = has_next ? S.a_ptr(nxt) : cA; const char* nB = has_next ? S.b_ptr(nxt) : cB;
        for (int t = 0; t < nt; t += 2) {
            const bool last = (t == nt - 2);
            const char* a1 = cA + (size_t)(t + 1) * kstep;
            const char* a2 = last ? nA : cA + (size_t)(t + 2) * kstep; const char* b2 = last ? nB : cB + (size_t)(t + 2) * kstep;
            const char* a3 = a2 + kstep; const char* b3 = b2 + kstep;
            if (last && has_next) S.a_ready(nxt);
            if constexpr (SP2) {
            PG8_LDB(B0, 0, 0); PG8_LDB(B1, 0, 1); PG8_SCHED; PG8_LDA(At, 0, 0); PG8_STAGE(PG8_SA(1, 1), a1 + hstepA, voffA);
            PG8_WAIT_V(8); PG8_WAIT_L(0); PG8_BAR; PG8_MMA(0, 0, At, B0); PG8_MMA(0, 1, At, B1); PG8_BAR; PG8_SCHED;
            PG8_LDA(At, 0, 1); PG8_STAGE(PG8_SB(0, 0), b2, voffB); PG8_STAGE(PG8_SB(0, 1), b2 + hstepB, voffB); PG8_STAGE(PG8_SA(0, 0), a2, voffA);
            PG8_WAIT_V(8); PG8_WAIT_L(0); PG8_BAR; PG8_MMA(1, 0, At, B0); PG8_MMA(1, 1, At, B1); PG8_BAR; PG8_SCHED;
            PG8_LDB(B0, 1, 0); PG8_LDB(B1, 1, 1); PG8_SCHED; PG8_LDA(At, 1, 0); PG8_STAGE(PG8_SA(0, 1), a2 + hstepA, voffA);
            PG8_WAIT_V(8); PG8_WAIT_L(0); PG8_BAR; PG8_MMA(0, 0, At, B0); PG8_MMA(0, 1, At, B1); PG8_BAR; PG8_SCHED;
            PG8_LDA(At, 1, 1); PG8_STAGE(PG8_SB(1, 0), b3, voffB); PG8_STAGE(PG8_SB(1, 1), b3 + hstepB, voffB); PG8_STAGE(PG8_SA(1, 0), a3, voffA);
            PG8_WAIT_V(8); PG8_WAIT_L(0); PG8_BAR; PG8_MMA(1, 0, At, B0); PG8_MMA(1, 1, At, B1); PG8_BAR; PG8_SCHED;
            } else {
            PG8_LDB(B0, 0, 0); PG8_SCHED; PG8_LDA(At, 0, 0); PG8_STAGE(PG8_SA(1, 1), a1 + hstepA, voffA);
            PG8_WAIT_L(8); PG8_BAR; PG8_WAIT_L(0); PG8_MMA(0, 0, At, B0); PG8_BAR; PG8_SCHED;
            PG8_LDB(B1, 0, 1); PG8_STAGE(PG8_SB(0, 0), b2, voffB);
            PG8_BAR; PG8_WAIT_L(0); PG8_MMA(0, 1, At, B1); PG8_BAR;
            PG8_LDA(At, 0, 1); PG8_STAGE(PG8_SA(0, 0), a2, voffA);
            PG8_BAR; PG8_WAIT_L(0); PG8_MMA(1, 0, At, B0); PG8_BAR; PG8_SCHED;
            PG8_STAGE(PG8_SB(0, 1), b2 + hstepB, voffB);
            PG8_WAIT_V(6); PG8_BAR; PG8_MMA(1, 1, At, B1); PG8_BAR;
            PG8_LDB(B0, 1, 0); PG8_SCHED; PG8_LDA(At, 1, 0); PG8_STAGE(PG8_SA(0, 1), a2 + hstepA, voffA);
            PG8_WAIT_L(8); PG8_BAR; PG8_WAIT_L(0); PG8_MMA(0, 0, At, B0); PG8_BAR; PG8_SCHED;
            PG8_LDB(B1, 1, 1); PG8_STAGE(PG8_SB(1, 0), b3, voffB);
            PG8_BAR; PG8_WAIT_L(0); PG8_MMA(0, 1, At, B1); PG8_BAR;
            PG8_LDA(At, 1, 1); PG8_STAGE(PG8_SA(1, 0), a3, voffA);
            PG8_BAR; PG8_WAIT_L(0); PG8_MMA(1, 0, At, B0); PG8_BAR; PG8_SCHED;
            PG8_STAGE(PG8_SB(1, 1), b3 + hstepB, voffB);
            PG8_WAIT_V(6); PG8_BAR; PG8_MMA(1, 1, At, B1); PG8_BAR;
            }
        }
        if constexpr (ALIGN_EPI) { if (wr == 0) PG8_BAR; }
        if constexpr (!Epi::AFTER_DRAIN) { E(acc, cur, wr, wc, fr, fq); S.done(cur); }
        if (!has_next) break;
#pragma unroll
        for (int a = 0; a < 2; ++a)
#pragma unroll
            for (int b = 0; b < 2; ++b)
#pragma unroll
                for (int m = 0; m < 4; ++m)
#pragma unroll
                    for (int n = 0; n < 2; ++n) acc[a][b][m][n] = (f32x4){0.f, 0.f, 0.f, 0.f};
        cur = nxt; cA = nA; cB = nB; ++ui;
        if constexpr (ALIGN_EPI) { if (wr == 1) PG8_BAR; }
    }
    PG8_WAIT_V(0);
    if constexpr (!ALIGN_EPI) { if (wr == 0) PG8_BAR; }
    PG8_BAR;
    if constexpr (Epi::AFTER_DRAIN) { E.fused(acc, cur, wr, wc, fr, fq, lds, wid, lane); S.done(cur); }
#undef PG8_SA
#undef PG8_SB
#undef PG8_STAGE
#undef PG8_LDA
#undef PG8_LDB
#undef PG8_MMA
#undef PG8_WAIT_V
#undef PG8_WAIT_L
#undef PG8_BAR
#undef PG8_SCHED
}
}

struct SchedProj {
    pg8::StaticOrder so; const char* A; const char* Bt;
    __device__ __forceinline__ bool next(int i, pg8::Unit& u) const { u.st = 0; return so.tile(i, u.pm, u.pn); }
    __device__ __forceinline__ const char* a_ptr(const pg8::Unit& u) const { return A + (size_t)u.pm * (256 * DM * 2); }
    __device__ __forceinline__ const char* b_ptr(const pg8::Unit& u) const { return Bt + (size_t)u.pn * (256 * DM * 2); }
    __device__ __forceinline__ void a_ready(const pg8::Unit&) const {}
    __device__ __forceinline__ void done(const pg8::Unit&) const {}
};
struct SchedMerge {
    pg8::StaticOrder so; const char* ws; const char* os;
    __device__ __forceinline__ bool next(int i, pg8::Unit& u) const { u.st = i & 3; return so.tile(i >> 2, u.pm, u.pn); }
    __device__ __forceinline__ const char* a_ptr(const pg8::Unit& u) const {
        const size_t off = (u.st == 1) ? OFF_ZA : (u.st == 3) ? OFF_QB : OFF_H;
        return ws + off + (size_t)u.pm * (256 * DM * 2); }
    __device__ __forceinline__ const char* b_ptr(const pg8::Unit& u) const {
        const size_t off = (u.st == 0) ? (OO_WT + (size_t)7168 * DM * 2) : (u.st == 1) ? OO_WOG_T : (u.st == 2) ? (OO_WT + (size_t)8192 * DM * 2) : OO_WOD_T;
        return os + off + (size_t)u.pn * (256 * DM * 2); }
    __device__ __forceinline__ void a_ready(const pg8::Unit&) const {}
    __device__ __forceinline__ void done(const pg8::Unit&) const {}
};

__device__ __forceinline__ u32x4 pack8(const f32x4 v0, const f32x4 v1) { u32x4 w; w.x = cvt_pk_bf16(v0[0], v0[1]); w.y = cvt_pk_bf16(v0[2], v0[3]); w.z = cvt_pk_bf16(v1[0], v1[1]); w.w = cvt_pk_bf16(v1[2], v1[3]); return w; }
struct EpiProj {
    static constexpr bool PERM = true, AFTER_DRAIN = false;
    char* ws; char* os;
    __device__ __forceinline__ void operator()(const f32x4 (&acc)[2][2][4][2], const pg8::Unit& u, int wr, int wc, int fr, int fq) const {
        const int row0 = u.pm * 256 + wr * 64 + fr, lc0 = wc * 32 + 8 * fq, pn = u.pn;
        bf16_t* const KI = (bf16_t*)(ws + OFF_KI); float* const SMALL = (float*)(ws + OFF_SMALL);
        if (pn < 27) {
            bf16_t* base; int ldc, cb;
            if (pn < 24) { base = (bf16_t*)(ws + OFF_QA + (size_t)(pn >> 2) * (32 * MiB)); ldc = 1024; cb = (pn & 3) * 256; }
            else if (pn == 24) { base = (bf16_t*)(ws + OFF_CKV); ldc = 256; cb = 0; }
            else { base = (bf16_t*)(ws + OFF_QI); ldc = 512; cb = (pn - 25) * 256; }
#pragma unroll
            for (int ai = 0; ai < 2; ++ai)
#pragma unroll
                for (int m = 0; m < 4; ++m) { bf16_t* rowp = base + (size_t)(row0 + ai * 128 + m * 16) * ldc + cb + lc0;
#pragma unroll
                    for (int bj = 0; bj < 2; ++bj) *(u32x4*)(rowp + bj * 128) = pack8(acc[ai][bj][m][0], acc[ai][bj][m][1]); }
            if (pn < 12 && fr >= 13) {
                bf16_t* st = (bf16_t*)(os + OO_STASH) + (size_t)(pn >> 2) * (256 * 3 * 1024);
#pragma unroll
                for (int ai = 0; ai < 2; ++ai) { const int row = row0 + ai * 128 + 48; bf16_t* sp = st + ((size_t)(row >> 6) * 3 + ((row & 63) - 61)) * 1024 + cb + lc0;
#pragma unroll
                    for (int bj = 0; bj < 2; ++bj) *(u32x4*)(sp + bj * 128) = pack8(acc[ai][bj][3][0], acc[ai][bj][3][1]); }
            }
        } else {
#pragma unroll
            for (int ai = 0; ai < 2; ++ai)
#pragma unroll
                for (int m = 0; m < 4; ++m) { const size_t row = (size_t)(row0 + ai * 128 + m * 16);
                    if (lc0 < 64) *(u32x4*)(KI + row * 64 + lc0) = pack8(acc[ai][0][m][0], acc[ai][0][m][1]);
                    else if (lc0 < 88) { *(f32x4*)(SMALL + row * 32 + (lc0 - 64)) = acc[ai][0][m][0]; *(f32x4*)(SMALL + row * 32 + (lc0 - 64) + 4) = acc[ai][0][m][1]; } }
        }
    }
};
__device__ __forceinline__ f32x4 sig4(const f32x4 v) { f32x4 r; r[0] = sigmoid_f(v[0]); r[1] = sigmoid_f(v[1]); r[2] = sigmoid_f(v[2]); r[3] = sigmoid_f(v[3]); return r; }
__device__ __forceinline__ void unpack8(const u32x4 w, f32x4& a, f32x4& b) { a[0] = bflo(w.x); a[1] = bfhi(w.x); a[2] = bflo(w.y); a[3] = bfhi(w.y); b[0] = bflo(w.z); b[1] = bfhi(w.z); b[2] = bflo(w.w); b[3] = bfhi(w.w); }
struct EpiMerge {
    static constexpr bool PERM = true, AFTER_DRAIN = false;
    bf16_t* MERGED; bf16_t* PARK;
    __device__ __forceinline__ void operator()(const f32x4 (&acc)[2][2][4][2], const pg8::Unit& u, int wr, int wc, int fr, int fq) const {
        const int row0 = u.pm * 256 + wr * 64 + fr, col0 = u.pn * 256 + wc * 32 + 8 * fq, st = u.st;
#pragma unroll
        for (int ai = 0; ai < 2; ++ai)
#pragma unroll
            for (int m = 0; m < 4; ++m) { const size_t off = (size_t)(row0 + ai * 128 + m * 16) * 1024 + col0;
#pragma unroll
                for (int bj = 0; bj < 2; ++bj) {
                    const f32x4 v0 = acc[ai][bj][m][0], v1 = acc[ai][bj][m][1];
                    u32x4* pm_ = (u32x4*)(MERGED + off + bj * 128); u32x4* pp_ = (u32x4*)(PARK + off + bj * 128);
                    if (st == 0) *pm_ = pack8(sig4(v0), sig4(v1));
                    else if (st == 1) { f32x4 g0, g1; unpack8(*pm_, g0, g1); *pm_ = pack8(g0 * v0, g1 * v1); }
                    else if (st == 2) *pp_ = pack8(sig4(v0), sig4(v1));
                    else { f32x4 a0, a1, g0, g1; unpack8(*pm_, a0, a1); unpack8(*pp_, g0, g1); *pm_ = pack8(a0 + g0 * v0, a1 + g1 * v1); }
                } }
    }
};
struct EpiOut {
    static constexpr bool PERM = false, AFTER_DRAIN = false;
    const float* x; const float* MOD; float* XNEW;
    __device__ __forceinline__ void operator()(const f32x4 (&acc)[2][2][4][2], const pg8::Unit& u, int wr, int wc, int fr, int fq) const {
        const int row0 = u.pm * 256 + wr * 64 + fr, col0 = u.pn * 256 + wc * 32 + 4 * fq; const int b = u.pm >> 3;
        f32x4 gv[2][2];
#pragma unroll
        for (int bj = 0; bj < 2; ++bj)
#pragma unroll
            for (int n = 0; n < 2; ++n) gv[bj][n] = *(const f32x4*)(MOD + b * 3072 + 2048 + col0 + bj * 128 + n * 16);
#pragma unroll
        for (int ai = 0; ai < 2; ++ai)
#pragma unroll
            for (int m = 0; m < 4; ++m) { const size_t off = (size_t)(row0 + ai * 128 + m * 16) * 1024 + col0;
#pragma unroll
                for (int bj = 0; bj < 2; ++bj)
#pragma unroll
                    for (int n = 0; n < 2; ++n) { const f32x4 xv = *(const f32x4*)(x + off + bj * 128 + n * 16); *(f32x4*)(XNEW + off + bj * 128 + n * 16) = xv + gv[bj][n] * acc[ai][bj][m][n]; } }
    }
};

#define XB_TMO      128
#define XB_XCNT(j)  (256  + 64 * (j))
#define XB_XSUB(j)  (1280 + 64 * (j))
#define XB_XGEN(j)  (2304 + 64 * (j))
#define XB_TOP      3328
#define XB_TOPGEN   3392
#define XCD_BAR_WORDS 3456
#define XB_SPIN_CAP (1u << 18)

__device__ __forceinline__ unsigned xb_ld(unsigned* p)              { return __hip_atomic_load(p, __ATOMIC_RELAXED, __HIP_MEMORY_SCOPE_AGENT); }
__device__ __forceinline__ unsigned xb_add(unsigned* p, unsigned v) { return __hip_atomic_fetch_add(p, v, __ATOMIC_RELAXED, __HIP_MEMORY_SCOPE_AGENT); }
__device__ __forceinline__ unsigned xb_xcc_id() { return (unsigned)__builtin_amdgcn_s_getreg((3 << 11) | 20) & 0xFu; }
#define XB_SPIN(cond, bar) do { unsigned _sp = 0; while (cond) { __builtin_amdgcn_s_sleep(1); \
    if ((++_sp & 255u) == 0u) { if (xb_ld(&(bar)[XB_TMO])) break; if (_sp > XB_SPIN_CAP) { atomicAdd(&(bar)[XB_TMO], 1u); break; } } } } while (0)

struct XcdBarrier {
    unsigned* bar; unsigned x;
    volatile LAS unsigned* st;
};

__device__ __forceinline__ XcdBarrier xcd_barrier_post(unsigned* bar, volatile LAS unsigned* st) {
    XcdBarrier b; b.bar = bar; b.x = xb_xcc_id(); b.st = st;
    if (threadIdx.x == 0) (void)xb_add(&bar[XB_XCNT(b.x)], 1u);
    return b;
}
__device__ __forceinline__ void xcd_barrier_complete(unsigned* bar, unsigned x, unsigned& nloc, unsigned& nx) {
    const unsigned G = gridDim.x * gridDim.y * gridDim.z;
    unsigned sum, cnt, mine, sp = 0u;
    for (;;) {
        sum = 0u; cnt = 0u; mine = 0u;
#pragma unroll
        for (unsigned j = 0; j < 16; ++j) { const unsigned c = xb_ld(&bar[XB_XCNT(j)]); sum += c; cnt += (c > 0u) ? 1u : 0u; mine = (j == x) ? c : mine; }
        if (sum == G) break;
        __builtin_amdgcn_s_sleep(1);
        if ((++sp & 255u) == 0u) { if (xb_ld(&bar[XB_TMO])) break; if (sp > XB_SPIN_CAP) { atomicAdd(&bar[XB_TMO], 1u); break; } }
    }
    nloc = mine > 0u ? mine : 1u; nx = cnt > 0u ? cnt : 1u;
}

__device__ __forceinline__ void xcd_barrier(const XcdBarrier& b) {
    asm volatile("s_waitcnt vmcnt(0)" ::: "memory");
    __syncthreads();
    if (threadIdx.x == 0) {
        unsigned* bar = b.bar;
        __builtin_amdgcn_s_waitcnt(0);
        unsigned nloc = b.st[0], nx = b.st[1];
        if (nloc == 0u) { xcd_barrier_complete(bar, b.x, nloc, nx); b.st[0] = nloc; b.st[1] = nx; }
        const unsigned old = xb_add(&bar[XB_XSUB(b.x)], 1u);
        const unsigned gen = old / nloc;
        if (old + 1u == (gen + 1u) * nloc) {
            __builtin_amdgcn_fence(__ATOMIC_RELEASE, "agent");
            asm volatile("s_waitcnt vmcnt(0)" ::: "memory");
            const unsigned og = xb_add(&bar[XB_TOP], 1u);
            const unsigned tg = og / nx;
            if (og + 1u == (tg + 1u) * nx) xb_add(&bar[XB_TOPGEN], 1u);
            else XB_SPIN(xb_ld(&bar[XB_TOPGEN]) == tg, bar);
            __builtin_amdgcn_fence(__ATOMIC_ACQUIRE, "agent");
            xb_add(&bar[XB_XGEN(b.x)], 1u);
            asm volatile("s_waitcnt vmcnt(0)" ::: "memory");
        } else {
            XB_SPIN(xb_ld(&bar[XB_XGEN(b.x)]) == gen, bar);
            __builtin_amdgcn_fence(__ATOMIC_ACQUIRE, "agent");
            asm volatile("s_waitcnt vmcnt(0)" ::: "memory");
        }
    }
    __syncthreads();
}

constexpr int NWAVES = 8, NTHR = 512;
constexpr int RING_OFF = 0, RING_BYTES = 131072, LDS_BYTES = 163840, LDSCTL_OFF = LDS_BYTES - 256;
struct Params { const float* in[18]; float* out; char* ws; int ph_lo, ph_hi, li, pad; };

__device__ __forceinline__ void tr_tiles(const float* __restrict__ src, const int ld_src, bf16_t* __restrict__ dst, const int mode, const int ntn, LAS unsigned char* lds, const int nkt = 32, const int dstld = DM) {
    const int tid = threadIdx.x, G = gridDim.x, sub = tid >> 8, t = tid & 255, tx = t & 31, ty = t >> 5;
    LAS float* tile = (LAS float*)lds + sub * (32 * 33);
    const int NTILES = ntn * nkt;
    for (int base = blockIdx.x * 2; base < NTILES; base += G * 2) {
        const int id = base + sub, tn = id / nkt, tk = id % nkt, n0 = tn * 32, k0 = tk * 32;
        if (id < NTILES) {
#pragma unroll
            for (int i = 0; i < 4; ++i) { const int k = k0 + ty + i * 8, n = n0 + tx; const int col = mode ? wt_col(n) : n; tile[(ty + i * 8) * 33 + tx] = (col >= 0) ? src[(size_t)k * ld_src + col] : 0.f; }
        }
        __syncthreads();
        if (id < NTILES) {
#pragma unroll
            for (int i = 0; i < 4; ++i) { const int n = n0 + ty + i * 8, k = k0 + tx; dst[(size_t)n * dstld + k] = f2bf(tile[tx * 33 + ty + i * 8]); }
        }
        __syncthreads();
    }
}
__device__ __forceinline__ void p0_prologue(const Params& p, const Bufs& B, LAS unsigned char* lds) {
    const int tid = threadIdx.x, G = gridDim.x;
    tr_tiles(p.in[5], 9048, B.WT, 1, NWT / 32, lds);
    tr_tiles(p.in[10], 1024, B.WOG_T, 0, 32, lds);
    tr_tiles(p.in[14], 1024, B.WOD_T, 0, 32, lds);
    tr_tiles(p.in[15], 1024, B.WOUT_T, 0, 32, lds);
    tr_tiles(p.in[13], 1024, (bf16_t*)((char*)p.out + OO_WUV_T), 0, 32, lds, 8, 256);
    { bf16_t* wk = (bf16_t*)((char*)p.out + OO_WUK_B); const float* src = p.in[12]; for (int i = blockIdx.x * NTHR + threadIdx.x; i < 256 * 1024; i += G * NTHR) wk[i] = f2bf(src[i]); }
    {
        LAS float* sc = (LAS float*)(lds + 16384);
        LAS float* part = (LAS float*)(lds + 16384 + 32768);
        const float* c = p.in[1]; const float* w_ada = p.in[3]; const float* b_ada = p.in[4];
        for (int jb = blockIdx.x; jb < 192; jb += G) {
            for (int i = tid; i < 8192; i += NTHR) sc[i] = silu_f(c[i]);
            __syncthreads();
            const int jj = tid & 15, sl = tid >> 4, j = jb * 16 + jj;
            float acc[8];
#pragma unroll
            for (int b = 0; b < 8; ++b) acc[b] = 0.f;
            for (int ii = 0; ii < 32; ++ii) { const int i = sl * 32 + ii; const float w = w_ada[(size_t)i * 3072 + j];
#pragma unroll
                for (int b = 0; b < 8; ++b) acc[b] += sc[b * 1024 + i] * w; }
#pragma unroll
            for (int b = 0; b < 8; ++b) part[(sl * 8 + b) * 16 + jj] = acc[b];
            __syncthreads();
            if (tid < 128) { const int b = tid >> 4, j2 = tid & 15; float s = 0.f;
                for (int s2 = 0; s2 < 32; ++s2) s += part[(s2 * 8 + b) * 16 + j2];
                B.MOD[b * 3072 + jb * 16 + j2] = s + b_ada[jb * 16 + j2]; }
            __syncthreads();
        }
    }
}
__device__ __forceinline__ void p1_h(const Params& p, const Bufs& B) {
    const int tid = threadIdx.x, lane = tid & 63, wave = tid >> 6, G = gridDim.x;
    const float* x = p.in[0]; const float* ng = p.in[2];
    for (int row = blockIdx.x * NWAVES + wave; row < MROWS; row += G * NWAVES) {
        const int b = row >> 11; const float* xr = x + (size_t)row * DM; f32x4 v[4]; float ss = 0.f;
#pragma unroll
        for (int i = 0; i < 4; ++i) { v[i] = *(const f32x4*)(xr + 4 * lane + 256 * i); ss += v[i][0] * v[i][0] + v[i][1] * v[i][1] + v[i][2] * v[i][2] + v[i][3] * v[i][3]; }
        ss = wave_sum(ss);
        const float r = rsqrtf(ss * (1.f / DM) + 1e-6f);
#pragma unroll
        for (int i = 0; i < 4; ++i) { const int col = 4 * lane + 256 * i;
            const f32x4 g = *(const f32x4*)(ng + col), sc = *(const f32x4*)(B.MOD + b * 3072 + 1024 + col), sh = *(const f32x4*)(B.MOD + b * 3072 + col);
            const f32x4 y = (v[i] * r * g) * (sc + 1.0f) + sh;
            u32x2 w; w.x = cvt_pk_bf16(y[0], y[1]); w.y = cvt_pk_bf16(y[2], y[3]);
            *(u32x2*)(B.H + (size_t)row * DM + col) = w; }
    }
}
__device__ __forceinline__ void p8_final(const Params& p, const Bufs& B) {
    const int tid = threadIdx.x, lane = tid & 63, wave = tid >> 6, G = gridDim.x;
    const float* fg = p.in[17];
    for (int row = blockIdx.x * NWAVES + wave; row < MROWS; row += G * NWAVES) {
        const float* xr = B.XNEW + (size_t)row * DM; f32x4 v[4]; float ss = 0.f;
#pragma unroll
        for (int i = 0; i < 4; ++i) { v[i] = *(const f32x4*)(xr + 4 * lane + 256 * i); ss += v[i][0] * v[i][0] + v[i][1] * v[i][1] + v[i][2] * v[i][2] + v[i][3] * v[i][3]; }
        ss = wave_sum(ss);
        const float r = rsqrtf(ss * (1.f / DM) + 1e-6f);
#pragma unroll
        for (int i = 0; i < 4; ++i) { const int col = 4 * lane + 256 * i; const f32x4 g = *(const f32x4*)(fg + col); *(f32x4*)(p.out + (size_t)row * DM + col) = v[i] * r * g; }
    }
}


typedef float f32x16 __attribute__((ext_vector_type(16)));
#define MFMA32(a, b, c) __builtin_amdgcn_mfma_f32_32x32x16_bf16((a), (b), (c), 0, 0, 0)
__device__ __forceinline__ int crow(int reg, int h) { return (reg & 3) + 8 * (reg >> 2) + 4 * h; }
constexpr int G1_ROWB = 272, G1_IMG = 64 * G1_ROWB, G1_WAVE = G1_IMG + 2048;

template <int MODE>
__device__ __forceinline__ void g1_conv(const bf16_t* __restrict__ X, const bf16_t* __restrict__ stash  , const float* __restrict__ cw  ,
                                        LAS unsigned char* img, int b, int n, int h, int lane) {
    const int col = h * 128 + 2 * lane; const unsigned row0 = (unsigned)(b * NT + n * 64);
    const __amdgpu_buffer_rsrc_t rs = __builtin_amdgcn_make_buffer_rsrc((void*)X, 0, MROWS * 1024 * 2, 0x00020000);
    const unsigned voff = (unsigned)col * 2u;
    float w[4][2];
#pragma unroll
    for (int j = 0; j < 4; ++j) { w[j][0] = cw[j * 3072 + col]; w[j][1] = cw[j * 3072 + col + 1]; }
    float h0[2] = {0.f, 0.f}, h1[2] = {0.f, 0.f}, h2[2] = {0.f, 0.f};
    if (n > 0) {
        const bf16_t* sp = stash + ((size_t)(b * 32 + n - 1) * 3) * 1024 + col;
        const unsigned a0 = *(const unsigned*)(sp), a1 = *(const unsigned*)(sp + 1024), a2 = *(const unsigned*)(sp + 2048);
        h0[0] = bflo(a0); h0[1] = bfhi(a0); h1[0] = bflo(a1); h1[1] = bfhi(a1); h2[0] = bflo(a2); h2[1] = bfhi(a2);
    }
#pragma unroll 1
    for (int q4 = 0; q4 < 4; ++q4) {
        unsigned raw[16];
        const unsigned rb = (row0 + q4 * 16) * 2048u;
#pragma unroll
        for (int t = 0; t < 16; ++t) raw[t] = __builtin_amdgcn_raw_buffer_load_b32(rs, voff, rb + t * 2048u, 0);
#pragma unroll
        for (int t = 0; t < 16; ++t) {
            const float x0 = bflo(raw[t]), x1 = bfhi(raw[t]);
            const float y0 = silu_f(w[0][0] * h0[0] + w[1][0] * h1[0] + w[2][0] * h2[0] + w[3][0] * x0);
            const float y1 = silu_f(w[0][1] * h0[1] + w[1][1] * h1[1] + w[2][1] * h2[1] + w[3][1] * x1);
            h0[0] = h1[0]; h1[0] = h2[0]; h2[0] = x0; h0[1] = h1[1]; h1[1] = h2[1]; h2[1] = x1;
            const unsigned pk = cvt_pk_bf16(y0, y1);
            if (MODE == 0) *(LAS unsigned*)(img + (q4 * 16 + t) * G1_ROWB + 4 * lane) = pk;
            else __builtin_amdgcn_raw_buffer_store_b32(pk, rs, voff, rb + t * 2048u, 0);
        }
    }
}
__device__ __forceinline__ float g1_diag(const f32x16& g, int r, int hh) {
    float d = 0.f;
#pragma unroll
    for (int reg = 0; reg < 16; ++reg) d = (crow(reg, hh) == r) ? g[reg] : d;
    return d + __shfl_xor(d, 32);
}
__device__ __forceinline__ void g1_store_norm(bf16_t* __restrict__ Xout, const LAS unsigned char* img, const LAS float* scl, float mul, int b, int n, int h, int lane) {
    const size_t row0 = (size_t)b * NT + n * 64;
#pragma unroll 4
    for (int ps = 0; ps < 16; ++ps) {
        const int row = ps * 4 + (lane >> 4), c16 = lane & 15;
        const u32x4 v = *(const LAS u32x4*)(img + row * G1_ROWB + 16 * c16);
        const float s = scl[row] * mul;
        u32x4 o; o.x = cvt_pk_bf16(bflo(v.x) * s, bfhi(v.x) * s); o.y = cvt_pk_bf16(bflo(v.y) * s, bfhi(v.y) * s); o.z = cvt_pk_bf16(bflo(v.z) * s, bfhi(v.z) * s); o.w = cvt_pk_bf16(bflo(v.w) * s, bfhi(v.w) * s);
        *(u32x4*)(Xout + (row0 + row) * 1024 + h * 128 + 8 * c16) = o;
    }
}
__device__ __forceinline__ void g1_phase(const Params& p, LAS unsigned char* lds) {
    const int tid = threadIdx.x, lane0 = tid & 63, h = tid >> 6, G = gridDim.x;
    char* ws = p.ws; char* os = (char*)p.out;
    bf16_t* QA = (bf16_t*)(ws + OFF_QA); bf16_t* KA = (bf16_t*)(ws + OFF_KA); bf16_t* VA = (bf16_t*)(ws + OFF_VA);
    const float* SMALL = (const float*)(ws + OFF_SMALL);
    const bf16_t* STASH = (const bf16_t*)(os + OO_STASH);
    const float* conv_w = p.in[6];
    LAS unsigned char* img = lds + h * G1_WAVE;
    LAS float* sm = (LAS float*)(img + G1_IMG);
    const float Aexp = __expf(p.in[7][h]), dtb = p.in[8][h];
    for (int unit = blockIdx.x; unit < NB * 32; unit += G) {
        int lane = lane0; asm volatile("" : "+v"(lane));
        const int r = lane & 31, hh = lane >> 5;
        const int b = unit >> 5, n = unit & 31; const size_t row0 = (size_t)b * NT + n * 64;
        const int u = (b * 8 + h) * 32 + n;
        float gi, beta, d;
        {
            const float xg = SMALL[(row0 + lane) * 32 + h] + dtb;
            const float sp = xg > 20.f ? xg : log1pf(__expf(xg));
            gi = -Aexp * sp; beta = sigmoid_f(SMALL[(row0 + lane) * 32 + 8 + h]);
            d = gi;
#pragma unroll
            for (int o = 1; o < 64; o <<= 1) { const float v = __shfl_up(d, o); if (lane >= o) d += v; }
            const float dl = __shfl(d, 63);
            float* dec = (float*)(os + OO_DEC) + (size_t)u * 256;
            dec[lane] = __expf(d); dec[64 + lane] = __expf(dl - d); dec[128 + lane] = gi; dec[192 + lane] = beta;
            sm[128 + lane] = d; sm[192 + lane] = beta;
        }
        g1_conv<0>(KA, STASH + (size_t)1 * 256 * 3 * 1024, conv_w + 1024, img, b, n, h, lane);
        __syncthreads();
        f32x16 g00, g10, g11;
#pragma unroll
        for (int i = 0; i < 16; ++i) { g00[i] = 0.f; g10[i] = 0.f; g11[i] = 0.f; }
#pragma unroll 2
        for (int s = 0; s < 8; ++s) {
            const bf16x8 k0 = *(const LAS bf16x8*)(img + (r) * G1_ROWB + (16 * s + 8 * hh) * 2), k1 = *(const LAS bf16x8*)(img + (32 + r) * G1_ROWB + (16 * s + 8 * hh) * 2);
            g00 = MFMA32(k0, k0, g00); g10 = MFMA32(k1, k0, g10); g11 = MFMA32(k1, k1, g11);
        }
        {
            const float nlo = rsqrtf(g1_diag(g00, r, hh) + 1e-6f), nhi = rsqrtf(g1_diag(g11, r, hh) + 1e-6f);
            if (hh == 0) { sm[r] = nlo; sm[32 + r] = nhi; }
        }
        __syncthreads();
        g1_store_norm(KA, img, sm, 1.0f, b, n, h, lane);
        asm volatile("s_waitcnt vmcnt(0)" ::: "memory");
        __syncthreads();
        g1_conv<0>(QA, STASH, conv_w, img, b, n, h, lane);
        __syncthreads();
        {
            f32x16 qq0, qq1;
#pragma unroll
            for (int i = 0; i < 16; ++i) { qq0[i] = 0.f; qq1[i] = 0.f; }
#pragma unroll 2
            for (int s = 0; s < 8; ++s) {
                const bf16x8 qa = *(const LAS bf16x8*)(img + (r) * G1_ROWB + (16 * s + 8 * hh) * 2), qb = *(const LAS bf16x8*)(img + (32 + r) * G1_ROWB + (16 * s + 8 * hh) * 2);
                qq0 = MFMA32(qa, qa, qq0); qq1 = MFMA32(qb, qb, qq1);
            }
            const float nlo = rsqrtf(g1_diag(qq0, r, hh) + 1e-6f), nhi = rsqrtf(g1_diag(qq1, r, hh) + 1e-6f);
            if (hh == 0) { sm[64 + r] = nlo; sm[96 + r] = nhi; }
        }
        f32x16 q00, q10, q11;
#pragma unroll
        for (int i = 0; i < 16; ++i) { q00[i] = 0.f; q10[i] = 0.f; q11[i] = 0.f; }
#pragma unroll 1
        for (int s4 = 0; s4 < 2; ++s4) {
            bf16x8 kf0[4], kf1[4];
#pragma unroll
            for (int s = 0; s < 4; ++s) {
                kf0[s] = *(const bf16x8*)(KA + (row0 + r) * 1024 + h * 128 + 16 * (4 * s4 + s) + 8 * hh);
                kf1[s] = *(const bf16x8*)(KA + (row0 + 32 + r) * 1024 + h * 128 + 16 * (4 * s4 + s) + 8 * hh);
            }
#pragma unroll
            for (int s = 0; s < 4; ++s) {
                const bf16x8 qa = *(const LAS bf16x8*)(img + (r) * G1_ROWB + (16 * (4 * s4 + s) + 8 * hh) * 2), qb = *(const LAS bf16x8*)(img + (32 + r) * G1_ROWB + (16 * (4 * s4 + s) + 8 * hh) * 2);
                q00 = MFMA32(qa, kf0[s], q00); q10 = MFMA32(qb, kf0[s], q10); q11 = MFMA32(qb, kf1[s], q11);
            }
        }
        __syncthreads();
        g1_store_norm(QA, img, sm + 64, 0.08838834764831845f, b, n, h, lane);
        __syncthreads();
        g1_conv<1>(VA, STASH + (size_t)2 * 256 * 3 * 1024, conv_w + 2048, img, b, n, h, lane);
        bf16_t* tp = (bf16_t*)(os + OO_TPATT + (size_t)u * 12288);
        LAS float* Am = (LAS float*)img;
#pragma unroll
        for (int blk = 0; blk < 3; ++blk) {
            __builtin_amdgcn_sched_barrier(0);
            const int bi = (blk == 0) ? 0 : 1, bj = (blk == 2) ? 1 : 0;
            const f32x16& gk = (blk == 0) ? g00 : (blk == 1) ? g10 : g11;
            const f32x16& gq = (blk == 0) ? q00 : (blk == 1) ? q10 : q11;
            const int j = 32 * bj + r; const float nkj = sm[j], dj = sm[128 + j];
#pragma unroll
            for (int g4 = 0; g4 < 4; ++g4) {
                const int ib = 32 * bi + 8 * g4 + 4 * hh;
                const f32x4 nki = *(const LAS f32x4*)(sm + ib), nqi = *(const LAS f32x4*)(sm + 64 + ib), di = *(const LAS f32x4*)(sm + 128 + ib), bti = *(const LAS f32x4*)(sm + 192 + ib);
#pragma unroll
                for (int e = 0; e < 4; ++e) {
                    const int i = ib + e, reg = 4 * g4 + e;
                    const float gam = __expf(di[e] - dj);
                    const float av = (i > j) ? gk[reg] * nki[e] * nkj * bti[e] * gam : 0.f;
                    const float tv = (i >= j) ? gq[reg] * (nqi[e] * 0.08838834764831845f) * gam : 0.f;
                    Am[i * 64 + j] = av;
                    if (blk == 0) Am[i * 64 + 32 + j] = 0.f;
                    tp[(3 + blk) * 1024 + (i & 31) * 32 + r] = f2bf(tv);
                }
            }
        }
        __syncthreads();
        for (int i = 0; i < 64; ++i) {
            float t0 = (lane == i) ? 1.f : 0.f, t1 = 0.f;
            for (int j4 = 0; j4 < i; j4 += 4) {
                const f32x4 a = *(const LAS f32x4*)(Am + i * 64 + j4);
                t0 -= a[0] * Am[(j4 + 0) * 64 + lane]; t1 -= a[1] * Am[(j4 + 1) * 64 + lane];
                t0 -= a[2] * Am[(j4 + 2) * 64 + lane]; t1 -= a[3] * Am[(j4 + 3) * 64 + lane];
            }
            Am[i * 64 + lane] = t0 + t1;
        }
        for (int i = 0; i < 64; ++i) {
            const bf16_t v = f2bf(Am[i * 64 + lane] * beta);
            if (i < 32) { if (lane < 32) tp[0 * 1024 + i * 32 + lane] = v; }
            else { tp[(lane < 32 ? 1 : 2) * 1024 + (i - 32) * 32 + (lane & 31)] = v; }
        }
        __syncthreads();
    }
}


typedef short s16x4 __attribute__((ext_vector_type(4)));
typedef __bf16 bf16x8_t __attribute__((ext_vector_type(8)));
typedef float f32x8 __attribute__((ext_vector_type(8)));
constexpr int G2_RB = 264, G2_IMG = 64 * G2_RB, G2_BRB = 72, G2_BLK = 32 * G2_BRB;
constexpr int G2_K = 0, G2_Q = G2_IMG, G2_V = 2 * G2_IMG, G2_TP = 3 * G2_IMG, G2_AT = G2_TP + 3 * G2_BLK, G2_DE = G2_AT + 3 * G2_BLK, G2_CB = G2_DE + 512;
constexpr int G2_OB = 2 * G2_CB, G2_OBSZ = 64 * 256;
static_assert(G2_CB % 16 == 0 && G2_OB + 2 * G2_OBSZ <= LDSCTL_OFF, "GDN scan LDS map");
__device__ __forceinline__ bf16x8 pack_step(const f32x16& x, const int s) {
    f32x8 v;
#pragma unroll
    for (int j = 0; j < 8; ++j) v[j] = x[8 * s + j];
    return __builtin_bit_cast(bf16x8, __builtin_convertvector(v, bf16x8_t));
}
__device__ __forceinline__ bf16x8 perm_frag(const LAS unsigned char* img, const int rowb, const int row, const int kc, const int hh) {
    const s16x4 lo = *(const LAS s16x4*)(img + row * rowb + (kc + 4 * hh) * 2), hi = *(const LAS s16x4*)(img + row * rowb + (kc + 8 + 4 * hh) * 2);
    return __builtin_shufflevector(lo, hi, 0, 1, 2, 3, 4, 5, 6, 7);
}
__device__ __forceinline__ s16x4 tr4(const LAS unsigned char* img, const int rowb, const int row0, const int c0, const int lane) {
    const int q = (lane & 15) >> 2, pq = lane & 3, blk = (lane >> 4) & 1;
    return __builtin_amdgcn_ds_read_tr16_b64_v4i16((LAS s16x4*)(img + (row0 + q) * rowb + (c0 + 16 * blk + 4 * pq) * 2));
}
__device__ __forceinline__ void g2_load_chunk(const Params& p, LAS unsigned char* cb, const int b, const int h, const int n, const int lt) {
    char* ws = p.ws; const char* os = (const char*)p.out;
    const size_t row0 = (size_t)b * NT + n * 64; const int u = (b * 8 + h) * 32 + n;
    u32x4 v[16];
#pragma unroll
    for (int t3 = 0; t3 < 3; ++t3) {
        const bf16_t* X = (const bf16_t*)(ws + OFF_QA + (size_t)(t3 == 0 ? 1 : t3 == 1 ? 0 : 2) * (32 * MiB));
#pragma unroll
        for (int k = 0; k < 4; ++k) { const int pi = lt + 256 * k, row = pi >> 4, c16 = pi & 15; v[t3 * 4 + k] = *(const u32x4*)(X + (row0 + row) * 1024 + h * 128 + 8 * c16); }
    }
    const u32x4* tpg = (const u32x4*)(os + OO_TPATT + (size_t)u * 12288);
#pragma unroll
    for (int k = 0; k < 3; ++k) v[12 + k] = tpg[lt + 256 * k];
    if (lt < 32) v[15] = ((const u32x4*)(os + OO_DEC + (size_t)u * 1024))[lt];
#pragma unroll
    for (int t3 = 0; t3 < 3; ++t3)
#pragma unroll
        for (int k = 0; k < 4; ++k) { const int pi = lt + 256 * k, row = pi >> 4, c16 = pi & 15; LAS u32x2* d = (LAS u32x2*)(cb + t3 * G2_IMG + row * G2_RB + 16 * c16);
            d[0] = (u32x2){v[t3 * 4 + k].x, v[t3 * 4 + k].y}; d[1] = (u32x2){v[t3 * 4 + k].z, v[t3 * 4 + k].w}; }
#pragma unroll
    for (int k = 0; k < 3; ++k) { const int pi = lt + 256 * k, blk = pi >> 7, row = (pi & 127) >> 2, c16 = pi & 3; LAS u32x2* d = (LAS u32x2*)(cb + G2_TP + blk * G2_BLK + row * G2_BRB + 16 * c16);
        d[0] = (u32x2){v[12 + k].x, v[12 + k].y}; d[1] = (u32x2){v[12 + k].z, v[12 + k].w}; }
    if (lt < 32) *(LAS u32x4*)(cb + G2_DE + 16 * lt) = v[15];
}
__device__ __forceinline__ void g2_epilogue(const Params& p, const LAS unsigned char* ob, const int b, const int h, const int n, const int lw  , const int lane) {
    bf16_t* ZA = (bf16_t*)(p.ws + OFF_ZA); const float* gg = p.in[9];
    const float g0 = gg[2 * lane], g1 = gg[2 * lane + 1];
    const size_t row0 = (size_t)b * NT + n * 64;
#pragma unroll 4
    for (int rr = 0; rr < 16; ++rr) {
        const int t = lw * 16 + rr;
        const unsigned w = *(const LAS unsigned*)(ob + t * 256 + 4 * lane);
        const float o0 = bflo(w), o1 = bfhi(w);
        const float ss = wave_sum(o0 * o0 + o1 * o1);
        const float rs = rsqrtf(ss * (1.f / 128.f) + 1e-6f);
        unsigned* zp = (unsigned*)(ZA + (row0 + t) * 1024 + h * 128 + 2 * lane);
        const unsigned z = *zp;
        *zp = cvt_pk_bf16(o0 * rs * g0 * silu_f(bflo(z)), o1 * rs * g1 * silu_f(bfhi(z)));
    }
}
__device__ __forceinline__ void g2_phase(const Params& p, LAS unsigned char* lds) {
    const int tid = threadIdx.x, wave = __builtin_amdgcn_readfirstlane(tid >> 6), G = gridDim.x;
    for (int bh = blockIdx.x; bh < NB * 8; bh += G) {
        int lane = tid & 63; asm volatile("" : "+v"(lane));
        const int r = lane & 31, hh = lane >> 5, b = bh >> 3, h = bh & 7;
        f32x16 S[4];
#pragma unroll
        for (int i = 0; i < 4; ++i)
#pragma unroll
            for (int e = 0; e < 16; ++e) S[i][e] = 0.f;
        if (wave >= 4) g2_load_chunk(p, lds, b, h, 0, tid - 256);
        __syncthreads();
#pragma unroll 1
        for (int n = 0; n < 32; ++n) {
            LAS unsigned char* cb = lds + (n & 1) * G2_CB;
            if (wave < 4) {
                const int j = wave;
                const LAS unsigned char* KI = cb + G2_K; const LAS unsigned char* QI = cb + G2_Q; const LAS unsigned char* VI = cb + G2_V;
                const LAS float* ED = (const LAS float*)(cb + G2_DE); const LAS float* EDL = ED + 64;
                f32x16 ks[2], qs[2];
#pragma unroll
                for (int tb = 0; tb < 2; ++tb)
#pragma unroll
                    for (int e = 0; e < 16; ++e) { ks[tb][e] = 0.f; qs[tb][e] = 0.f; }
#pragma unroll
                for (int i = 0; i < 4; ++i)
#pragma unroll
                    for (int s = 0; s < 2; ++s) {
                        const bf16x8 xs = pack_step(S[i], s);
#pragma unroll
                        for (int tb = 0; tb < 2; ++tb) {
                            ks[tb] = MFMA32(perm_frag(KI, G2_RB, 32 * tb + r, 32 * i + 16 * s, hh), xs, ks[tb]);
                            qs[tb] = MFMA32(perm_frag(QI, G2_RB, 32 * tb + r, 32 * i + 16 * s, hh), xs, qs[tb]);
                        }
                    }
                f32x16 R[2], O[2];
#pragma unroll
                for (int tb = 0; tb < 2; ++tb)
#pragma unroll
                    for (int g4 = 0; g4 < 4; ++g4) {
                        const int t0 = 32 * tb + 8 * g4 + 4 * hh;
                        const s16x4 vv = tr4(VI, G2_RB, t0, 32 * j, lane);
                        const f32x4 ed = *(const LAS f32x4*)(ED + t0);
#pragma unroll
                        for (int e = 0; e < 4; ++e) { R[tb][4 * g4 + e] = bf2f((bf16_t)vv[e]) - ed[e] * ks[tb][4 * g4 + e]; O[tb][4 * g4 + e] = ed[e] * qs[tb][4 * g4 + e]; }
                    }
                f32x16 vn[2];
#pragma unroll
                for (int e = 0; e < 16; ++e) { vn[0][e] = 0.f; vn[1][e] = 0.f; }
#pragma unroll
                for (int s = 0; s < 2; ++s) {
                    const bf16x8 x0 = pack_step(R[0], s), x1 = pack_step(R[1], s);
                    vn[0] = MFMA32(perm_frag(cb + G2_TP + 0 * G2_BLK, G2_BRB, r, 16 * s, hh), x0, vn[0]);
                    vn[1] = MFMA32(perm_frag(cb + G2_TP + 1 * G2_BLK, G2_BRB, r, 16 * s, hh), x0, vn[1]);
                    vn[1] = MFMA32(perm_frag(cb + G2_TP + 2 * G2_BLK, G2_BRB, r, 16 * s, hh), x1, vn[1]);
                }
                f32x16 vs[2];
#pragma unroll
                for (int tb = 0; tb < 2; ++tb)
#pragma unroll
                    for (int g4 = 0; g4 < 4; ++g4) {
                        const f32x4 el = *(const LAS f32x4*)(EDL + 32 * tb + 8 * g4 + 4 * hh);
#pragma unroll
                        for (int e = 0; e < 4; ++e) vs[tb][4 * g4 + e] = el[e] * vn[tb][4 * g4 + e];
                    }
#pragma unroll
                for (int s = 0; s < 2; ++s) {
                    const bf16x8 x0 = pack_step(vn[0], s), x1 = pack_step(vn[1], s);
                    O[0] = MFMA32(perm_frag(cb + G2_AT + 0 * G2_BLK, G2_BRB, r, 16 * s, hh), x0, O[0]);
                    O[1] = MFMA32(perm_frag(cb + G2_AT + 1 * G2_BLK, G2_BRB, r, 16 * s, hh), x0, O[1]);
                    O[1] = MFMA32(perm_frag(cb + G2_AT + 2 * G2_BLK, G2_BRB, r, 16 * s, hh), x1, O[1]);
                }
                const float edl_all = ED[63];
#pragma unroll
                for (int i = 0; i < 4; ++i) {
#pragma unroll
                    for (int e = 0; e < 16; ++e) S[i][e] *= edl_all;
#pragma unroll
                    for (int tb = 0; tb < 2; ++tb)
#pragma unroll
                        for (int s = 0; s < 2; ++s) {
                            const int t0 = 32 * tb + 16 * s + 4 * hh;
                            const s16x4 lo = tr4(KI, G2_RB, t0, 32 * i, lane), hi = tr4(KI, G2_RB, t0 + 8, 32 * i, lane);
                            const bf16x8 a = __builtin_shufflevector(lo, hi, 0, 1, 2, 3, 4, 5, 6, 7);
                            S[i] = MFMA32(a, pack_step(vs[tb], s), S[i]);
                        }
                }
                LAS unsigned char* ob = lds + G2_OB + (n & 1) * G2_OBSZ;
#pragma unroll
                for (int tb = 0; tb < 2; ++tb)
#pragma unroll
                    for (int e = 0; e < 16; ++e) *(LAS bf16_t*)(ob + (32 * tb + crow(e, hh)) * 256 + (32 * j + r) * 2) = f2bf(O[tb][e]);
            } else {
                const int lt = tid - 256;
                if (n + 1 < 32) g2_load_chunk(p, lds + ((n + 1) & 1) * G2_CB, b, h, n + 1, lt);
                if (n > 0) g2_epilogue(p, lds + G2_OB + ((n - 1) & 1) * G2_OBSZ, b, h, n - 1, wave - 4, lane);
            }
            __syncthreads();
        }
        if (wave >= 4) g2_epilogue(p, lds + G2_OB + 1 * G2_OBSZ, b, h, 31, wave - 4, lane);
        __syncthreads();
    }
}

__device__ const unsigned char T5_BUCKET[128] = {
    0, 1, 2, 3, 4, 5, 6, 7, 8, 9, 10, 11, 12, 13, 14, 15, 16, 16, 16, 17, 17, 18, 18, 18, 19, 19, 19, 20, 20, 20, 20, 21,
    21, 21, 21, 22, 22, 22, 22, 22, 23, 23, 23, 23, 23, 23, 24, 24, 24, 24, 24, 24, 25, 25, 25, 25, 25, 25, 25, 26, 26, 26, 26, 26,
    26, 26, 26, 27, 27, 27, 27, 27, 27, 27, 27, 27, 27, 28, 28, 28, 28, 28, 28, 28, 28, 28, 28, 29, 29, 29, 29, 29, 29, 29, 29, 29,
    29, 29, 29, 30, 30, 30, 30, 30, 30, 30, 30, 30, 30, 30, 30, 30, 30, 31, 31, 31, 31, 31, 31, 31, 31, 31, 31, 31, 31, 31, 31, 31};
__device__ __forceinline__ int t5_bucket(int n) { return n >= 128 ? 31 : (int)T5_BUCKET[n]; }

constexpr size_t OFF_QL = OFF_QA;
typedef unsigned short u16_t;
#define MFMA16(a, b, c) __builtin_amdgcn_mfma_f32_16x16x32_bf16((a), (b), (c), 0, 0, 0)

template <int NTL, int KS>
__device__ __forceinline__ void sg_tile(const bf16_t* __restrict__ A, const int lda, const bf16_t* __restrict__ Bt, const int ldb, f32x16 (&acc)[NTL], const int r, const int hh) {
#pragma unroll 2
    for (int s = 0; s < KS; ++s) {
        const bf16x8 a = *(const bf16x8*)(A + (size_t)r * lda + 16 * s + 8 * hh);
#pragma unroll
        for (int nt = 0; nt < NTL; ++nt) { const bf16x8 bb = *(const bf16x8*)(Bt + (size_t)(32 * nt + r) * ldb + 16 * s + 8 * hh); acc[nt] = MFMA32(a, bb, acc[nt]); }
    }
}
__device__ __forceinline__ void qlat_phase(const Params& p) {
    const int tid = threadIdx.x, wave = tid >> 6, G = gridDim.x, wm = wave & 3, wn = wave >> 2;
    const bf16_t* QB = (const bf16_t*)(p.ws + OFF_QB); const bf16_t* WUK = (const bf16_t*)((const char*)p.out + OO_WUK_B); bf16_t* QL = (bf16_t*)(p.ws + OFF_QL);
    for (int unit = blockIdx.x; unit < 1024; unit += G) {
        int lane = tid & 63; asm volatile("" : "+v"(lane));
        const int r = lane & 31, hh = lane >> 5, h = unit & 7, mt = unit >> 3, m0 = mt * 128 + wm * 32, n0 = wn * 128;
        f32x16 acc[4];
#pragma unroll
        for (int i = 0; i < 4; ++i)
#pragma unroll
            for (int e = 0; e < 16; ++e) acc[i][e] = 0.f;
        sg_tile<4, 8>(QB + (size_t)m0 * 1024 + h * 128, 1024, WUK + (size_t)n0 * 1024 + h * 128, 1024, acc, r, hh);
#pragma unroll
        for (int nt = 0; nt < 4; ++nt)
#pragma unroll
            for (int e = 0; e < 16; ++e) QL[(size_t)(m0 + crow(e, hh)) * 2048 + h * 256 + n0 + 32 * nt + r] = f2bf(acc[nt][e] * 0.08838834764831845f);
    }
}
__device__ __forceinline__ void wuv_phase(const Params& p) {
    const int tid = threadIdx.x, wave = tid >> 6, G = gridDim.x, wm = wave & 3, wn = wave >> 2;
    const bf16_t* OL = (const bf16_t*)(p.ws + OFF_QL); const bf16_t* WUV = (const bf16_t*)((const char*)p.out + OO_WUV_T); bf16_t* OB = (bf16_t*)(p.ws + OFF_QB); const bf16_t* ZB = (const bf16_t*)(p.ws + OFF_ZB);
    for (int unit = blockIdx.x; unit < 1024; unit += G) {
        int lane = tid & 63; asm volatile("" : "+v"(lane));
        const int r = lane & 31, hh = lane >> 5, h = unit & 7, mt = unit >> 3, m0 = mt * 128 + wm * 32, n0 = wn * 64;
        f32x16 acc[2];
#pragma unroll
        for (int i = 0; i < 2; ++i)
#pragma unroll
            for (int e = 0; e < 16; ++e) acc[i][e] = 0.f;
        sg_tile<2, 16>(OL + (size_t)m0 * 2048 + h * 256, 2048, WUV + (size_t)(h * 128 + n0) * 256, 256, acc, r, hh);
#pragma unroll
        for (int nt = 0; nt < 2; ++nt)
#pragma unroll
            for (int e = 0; e < 16; ++e) { const size_t o = (size_t)(m0 + crow(e, hh)) * 1024 + h * 128 + n0 + 32 * nt + r; OB[o] = f2bf(acc[nt][e] * silu_f(bf2f(ZB[o]))); }
    }
}

constexpr int D2_RB = 528, D2_KB = 32 * D2_RB, D2_BIAS = 8 * D2_KB;
static_assert(D2_BIAS + 1024 <= LDSCTL_OFF, "DSA attention LDS map");
__device__ __forceinline__ void d2_phase(const Params& p, LAS unsigned char* lds) {
    const int tid = threadIdx.x, wave = __builtin_amdgcn_readfirstlane(tid >> 6), G = gridDim.x;
    const bf16_t* CKV = (const bf16_t*)(p.ws + OFF_CKV); bf16_t* QL = (bf16_t*)(p.ws + OFF_QL); const u16_t* IDX = (const u16_t*)((const char*)p.out + OO_IDX);
    LAS unsigned char* kb = lds + wave * D2_KB; LAS float* sbias = (LAS float*)(lds + D2_BIAS);
    if (tid < 256) sbias[tid] = p.in[16][tid];
    __syncthreads();
    for (int it = blockIdx.x; it < 2048; it += G) {
        int lane = tid & 63; asm volatile("" : "+v"(lane));
        const int c16 = lane & 15, q = lane >> 4, b = it & 7, c8 = (it >> 3) & 31, kk = it >> 8, t = kk * 256 + c8 * 8 + wave;
        const size_t token = (size_t)b * NT + t;
        const int n_sel = (t + 1 < 256) ? (t + 1) : 256, nch = (n_sel + 31) >> 5;
        bf16x8 bq[8];
#pragma unroll
        for (int s = 0; s < 8; ++s) {
            u32x4 v = (u32x4){0u, 0u, 0u, 0u};
            if (c16 < 8) v = *(const u32x4*)(QL + token * 2048 + c16 * 256 + 32 * s + 8 * q);
            bq[s] = __builtin_bit_cast(bf16x8, v);
        }
        f32x4 O[16];
#pragma unroll
        for (int i = 0; i < 16; ++i) O[i] = (f32x4){0.f, 0.f, 0.f, 0.f};
        float mrun = -1.0e30f, lrun = 0.f;
#pragma unroll 1
        for (int ch = 0; ch < nch; ++ch) {
            int keyreg = 0;
            { const int slot = ch * 32 + (lane & 31); if (slot < n_sel) keyreg = (t < 256) ? slot : (int)IDX[token * 256 + slot]; }
            u32x4 g[16];
#pragma unroll
            for (int i = 0; i < 16; ++i) { const int key = __shfl(keyreg, 2 * i + (lane >> 5)); g[i] = *(const u32x4*)(CKV + ((size_t)b * NT + key) * 256 + 8 * (lane & 31)); }
#pragma unroll
            for (int i = 0; i < 16; ++i) *(LAS u32x4*)(kb + (2 * i + (lane >> 5)) * D2_RB + 16 * (lane & 31)) = g[i];
            f32x4 sc[2];
#pragma unroll
            for (int kt = 0; kt < 2; ++kt) { sc[kt] = (f32x4){0.f, 0.f, 0.f, 0.f};
#pragma unroll
                for (int s = 0; s < 8; ++s) sc[kt] = MFMA16(*(const LAS bf16x8*)(kb + (16 * kt + c16) * D2_RB + (32 * s + 8 * q) * 2), bq[s], sc[kt]); }
            float cmax = -1.0e30f;
#pragma unroll
            for (int kt = 0; kt < 2; ++kt)
#pragma unroll
                for (int e = 0; e < 4; ++e) {
                    const int sl = 16 * kt + 4 * q + e; const int key = __shfl(keyreg, sl);
                    const float bias = sbias[t5_bucket(t - key) * 8 + (c16 & 7)];
                    const float v = (ch * 32 + sl < n_sel) ? sc[kt][e] + bias : -1.0e30f;
                    sc[kt][e] = v; cmax = fmaxf(cmax, v);
                }
            cmax = fmaxf(cmax, __shfl_xor(cmax, 16)); cmax = fmaxf(cmax, __shfl_xor(cmax, 32));
            const float mnew = fmaxf(mrun, cmax), alpha = __expf(mrun - mnew);
            float psum = 0.f;
#pragma unroll
            for (int kt = 0; kt < 2; ++kt)
#pragma unroll
                for (int e = 0; e < 4; ++e) { const float pv = __expf(sc[kt][e] - mnew); sc[kt][e] = pv; psum += pv; }
            lrun = lrun * alpha + psum; mrun = mnew;
            f32x8 pf;
#pragma unroll
            for (int e = 0; e < 4; ++e) { pf[e] = sc[0][e]; pf[4 + e] = sc[1][e]; }
            const bf16x8 pb = __builtin_bit_cast(bf16x8, __builtin_convertvector(pf, bf16x8_t));
#pragma unroll
            for (int mt = 0; mt < 16; ++mt) {
                const s16x4 lo = __builtin_amdgcn_ds_read_tr16_b64_v4i16((LAS s16x4*)(kb + (4 * q + (c16 >> 2)) * D2_RB + (16 * mt + 4 * (lane & 3)) * 2));
                const s16x4 hi = __builtin_amdgcn_ds_read_tr16_b64_v4i16((LAS s16x4*)(kb + (16 + 4 * q + (c16 >> 2)) * D2_RB + (16 * mt + 4 * (lane & 3)) * 2));
                const bf16x8 a = __builtin_shufflevector(lo, hi, 0, 1, 2, 3, 4, 5, 6, 7);
                O[mt] = MFMA16(a, pb, O[mt] * alpha);
            }
        }
        float lt = lrun + __shfl_xor(lrun, 16); lt += __shfl_xor(lt, 32);
        const float inv = 1.f / lt;
        if (c16 < 8) {
#pragma unroll
            for (int mt = 0; mt < 16; ++mt) { u32x2 w; w.x = cvt_pk_bf16(O[mt][0] * inv, O[mt][1] * inv); w.y = cvt_pk_bf16(O[mt][2] * inv, O[mt][3] * inv);
                *(u32x2*)(QL + token * 2048 + c16 * 256 + 16 * mt + 4 * q) = w; }
        }
    }
}

__device__ __forceinline__ void ckvnorm_phase(const Params& p) {
    const int tid = threadIdx.x, lane = tid & 63, wave = tid >> 6, G = gridDim.x;
    bf16_t* CKV = (bf16_t*)(p.ws + OFF_CKV); const float* g = p.in[11];
    const f32x4 gv = *(const f32x4*)(g + 4 * lane);
    for (int row = blockIdx.x * NWAVES + wave; row < MROWS; row += G * NWAVES) {
        u32x2* rp = (u32x2*)(CKV + (size_t)row * 256 + 4 * lane);
        const u32x2 w = *rp; const float v0 = bflo(w.x), v1 = bfhi(w.x), v2 = bflo(w.y), v3 = bfhi(w.y);
        const float ss = wave_sum(v0 * v0 + v1 * v1 + v2 * v2 + v3 * v3);
        const float rs = rsqrtf(ss * (1.f / 256.f) + 1e-6f);
        u32x2 o; o.x = cvt_pk_bf16(v0 * rs * gv[0], v1 * rs * gv[1]); o.y = cvt_pk_bf16(v2 * rs * gv[2], v3 * rs * gv[3]);
        *rp = o;
    }
}
__device__ __forceinline__ void topk_naive_phase(const Params& p, LAS unsigned char* lds) {
    const int tid = threadIdx.x, G = gridDim.x;
    const bf16_t* QI = (const bf16_t*)(p.ws + OFF_QI); const bf16_t* KI = (const bf16_t*)(p.ws + OFF_KI); const float* SMALL = (const float*)(p.ws + OFF_SMALL);
    u16_t* IDX = (u16_t*)((char*)p.out + OO_IDX);
    LAS float* s_score = (LAS float*)lds; LAS float* s_qi = s_score + 2048; LAS float* s_wi = s_qi + 512; LAS int* s_cnt = (LAS int*)(s_wi + 8);
    for (int row = blockIdx.x; row < MROWS; row += G) {
        const int b = row >> 11, t = row & 2047;
        if (t < 256) continue;
        for (int i = tid; i < 512; i += NTHR) s_qi[i] = bf2f(QI[(size_t)row * 512 + i]);
        if (tid < 8) s_wi[tid] = SMALL[(size_t)row * 32 + 16 + tid] * 0.04419417382415922f;
        if (tid == 0) *s_cnt = 0;
        __syncthreads();
        const int nvalid = t + 1;
        for (int s = tid; s < nvalid; s += NTHR) {
            const bf16_t* kr = KI + ((size_t)b * NT + s) * 64;
            float acc[8];
#pragma unroll
            for (int hh = 0; hh < 8; ++hh) acc[hh] = 0.f;
            for (int d = 0; d < 64; ++d) { const float kd = bf2f(kr[d]);
#pragma unroll
                for (int hh = 0; hh < 8; ++hh) acc[hh] += s_qi[hh * 64 + d] * kd; }
            float sc = 0.f;
#pragma unroll
            for (int hh = 0; hh < 8; ++hh) sc += s_wi[hh] * fmaxf(acc[hh], 0.f);
            s_score[s] = sc;
        }
        __syncthreads();
        for (int s = tid; s < nvalid; s += NTHR) {
            const float v = s_score[s]; int rank = 0;
            for (int s2 = 0; s2 < nvalid; ++s2) { const float v2 = s_score[s2]; rank += (v2 > v || (v2 == v && s2 < s)) ? 1 : 0; }
            if (rank < 256) { const int pos = atomicAdd((int*)s_cnt, 1); IDX[(size_t)row * 256 + pos] = (u16_t)s; }
        }
        __syncthreads();
    }
}

__global__ void __launch_bounds__(NTHR, 2) fwd(Params p) {
    extern __shared__ __attribute__((aligned(16))) unsigned char lds_raw[];
    LAS unsigned char* lds = (LAS unsigned char*)lds_raw;
    const int tid = threadIdx.x;
    for (int u = tid; u < (LDS_BYTES - LDSCTL_OFF) / 4; u += NTHR) ((LAS unsigned*)(lds + LDSCTL_OFF))[u] = 0u;
    __syncthreads();
    const Bufs B = make_bufs(p.ws, (char*)p.out);
    const int lo = p.ph_lo, hi = p.ph_hi;
    unsigned* barw = (unsigned*)(p.ws + OFF_CTL) + CW_BAR + p.li * XCD_BAR_WORDS;
    XcdBarrier bar; bar.bar = barw; bar.x = 0; bar.st = nullptr;
    if (hi - lo > 1) bar = xcd_barrier_post(barw, (volatile LAS unsigned*)(lds + LDSCTL_OFF + 64));
#define IN(k) (lo <= (k) && (k) < hi)
#define SEAM(k) do { if (IN(k) && IN((k) + 1)) xcd_barrier(bar); } while (0)
    if (IN(0)) { p0_prologue(p, B, lds); SEAM(0); }
    if (IN(1)) { p1_h(p, B); SEAM(1); }
    if (IN(2)) {
        SchedProj S; S.so.init(MROWS, NPAD, gridDim.x, blockIdx.x); S.A = (const char*)B.H; S.Bt = (const char*)B.WT;
        EpiProj E{p.ws, (char*)p.out};
        pg8::gemm_phase<EpiProj, SchedProj, true, true>(lds + RING_OFF, DM, DM, DM, S, E);
        SEAM(2);
    }
    if (IN(3)) { g1_phase(p, lds); ckvnorm_phase(p); topk_naive_phase(p, lds); SEAM(3); }
    if (IN(4)) { g2_phase(p, lds); SEAM(4); }
    if (IN(5)) { qlat_phase(p); SEAM(5); }
    if (IN(6)) { d2_phase(p, lds); SEAM(6); }
    if (IN(7)) { wuv_phase(p); SEAM(7); }
    if (IN(8)) {
        SchedMerge S; S.so.init(MROWS, DM, gridDim.x, blockIdx.x); S.ws = p.ws; S.os = (const char*)p.out;
        EpiMerge E{B.MERGED, B.PARK};
        pg8::gemm_phase<EpiMerge, SchedMerge, true, true>(lds + RING_OFF, DM, DM, DM, S, E);
        SEAM(8);
    }
    if (IN(9)) {
        SchedProj S; S.so.init(MROWS, DM, gridDim.x, blockIdx.x); S.A = (const char*)B.MERGED; S.Bt = (const char*)B.WOUT_T;
        EpiOut E{p.in[0], B.MOD, B.XNEW};
        pg8::gemm_phase<EpiOut, SchedProj, true, true>(lds + RING_OFF, DM, DM, DM, S, E);
        SEAM(9);
    }
    if (IN(10)) { p8_final(p, B); }
#undef IN
#undef SEAM
}

__global__ void k_ckvnorm(bf16_t* __restrict__ CKV, const float* __restrict__ g) {
    const int row = blockIdx.x * 4 + (threadIdx.x >> 6), lane = threadIdx.x & 63;
    bf16_t* r = CKV + (size_t)row * 256; float v[4]; float ss = 0.f;
#pragma unroll
    for (int i = 0; i < 4; ++i) { v[i] = bf2f(r[lane + 64 * i]); ss += v[i] * v[i]; }
    ss = wave_sum(ss);
    const float rs = rsqrtf(ss * (1.f / 256.f) + 1e-6f);
#pragma unroll
    for (int i = 0; i < 4; ++i) r[lane + 64 * i] = f2bf(v[i] * rs * g[lane + 64 * i]);
}

__global__ void __launch_bounds__(256) k_gdn_naive(Bufs B, const float* __restrict__ conv_w, const float* __restrict__ a_log, const float* __restrict__ dt_bias,
                                                   const float* __restrict__ gdn_norm_g) {
    const int b = blockIdx.x >> 3, h = blockIdx.x & 7, tid = threadIdx.x, dv = tid & 127, half = tid >> 7, wv = tid >> 6;
    __shared__ float sq[128], sk[128], sv[128], part[2][128], part2[2][128], sred[4], sred2[2];
    float S[64];
#pragma unroll
    for (int i = 0; i < 64; ++i) S[i] = 0.f;
    const int ch0 = (half == 0 ? 0 : 1024) + h * 128 + dv, ch1 = 2048 + h * 128 + dv;
    float w0[4], w1[4];
#pragma unroll
    for (int j = 0; j < 4; ++j) { w0[j] = conv_w[j * 3072 + ch0]; w1[j] = conv_w[j * 3072 + ch1]; }
    float h0a = 0.f, h0b = 0.f, h0c = 0.f, h1a = 0.f, h1b = 0.f, h1c = 0.f;
    const float Aexp = __expf(a_log[h]), dtb = dt_bias[h], gn = gdn_norm_g[dv];
    const bf16_t* src0 = (half == 0 ? B.QA : B.KA);
    for (int t = 0; t < NT; ++t) {
        const size_t row = (size_t)b * NT + t;
        const float raw0 = bf2f(src0[row * 1024 + h * 128 + dv]);
        const float y0 = silu_f(w0[0] * h0a + w0[1] * h0b + w0[2] * h0c + w0[3] * raw0);
        h0a = h0b; h0b = h0c; h0c = raw0;
        if (half == 0) {
            const float raw1 = bf2f(B.VA[row * 1024 + h * 128 + dv]);
            const float y1 = silu_f(w1[0] * h1a + w1[1] * h1b + w1[2] * h1c + w1[3] * raw1);
            h1a = h1b; h1b = h1c; h1c = raw1;
            sq[dv] = y0; sv[dv] = y1;
        } else sk[dv] = y0;
        const float s2 = wave_sum(y0 * y0);
        if ((tid & 63) == 0) sred[wv] = s2;
        __syncthreads();
        const float qn = rsqrtf(sred[0] + sred[1] + 1e-6f) * 0.08838834764831845f, kn = rsqrtf(sred[2] + sred[3] + 1e-6f);
        const float beta = sigmoid_f(B.SMALL[row * 32 + 8 + h]);
        const float xg = B.SMALL[row * 32 + h] + dtb;
        const float sp = xg > 20.f ? xg : log1pf(__expf(xg));
        const float a = __expf(-Aexp * sp);
        float p = 0.f;
#pragma unroll
        for (int i = 0; i < 64; ++i) p += sk[half * 64 + i] * S[i];
        part[half][dv] = p * kn;
        __syncthreads();
        const float kS = part[0][dv] + part[1][dv];
        const float vnew = beta * (sv[dv] - a * kS);
        float o = 0.f;
#pragma unroll
        for (int i = 0; i < 64; ++i) { S[i] = a * S[i] + (sk[half * 64 + i] * kn) * vnew; o += sq[half * 64 + i] * S[i]; }
        part2[half][dv] = o * qn;
        __syncthreads();
        float ov = 0.f;
        if (half == 0) {
            ov = part2[0][dv] + part2[1][dv];
            const float o2 = wave_sum(ov * ov);
            if ((tid & 63) == 0) sred2[wv] = o2;
        }
        __syncthreads();
        if (half == 0) {
            const float rs = rsqrtf((sred2[0] + sred2[1]) * (1.f / 128.f) + 1e-6f);
            const size_t zi = row * 1024 + h * 128 + dv;
            const float z = bf2f(B.ZA[zi]);
            B.ZA[zi] = f2bf(ov * rs * gn * silu_f(z));
        }
    }
}


__global__ void __launch_bounds__(256) k_gdn_naive2(Bufs B, const float* __restrict__ DEC, const float* __restrict__ gdn_norm_g) {
    const int b = blockIdx.x >> 3, h = blockIdx.x & 7, tid = threadIdx.x, dv = tid & 127, half = tid >> 7, wv = tid >> 6;
    __shared__ float sq[128], sk[128], sv[128], part[2][128], part2[2][128], sred2[2];
    float S[64];
#pragma unroll
    for (int i = 0; i < 64; ++i) S[i] = 0.f;
    const float gn = gdn_norm_g[dv];
    for (int t = 0; t < NT; ++t) {
        const size_t row = (size_t)b * NT + t;
        if (half == 0) { sq[dv] = bf2f(B.QA[row * 1024 + h * 128 + dv]); sv[dv] = bf2f(B.VA[row * 1024 + h * 128 + dv]); }
        else sk[dv] = bf2f(B.KA[row * 1024 + h * 128 + dv]);
        const float* dec = DEC + (size_t)((b * 8 + h) * 32 + (t >> 6)) * 256;
        const float a = __expf(dec[128 + (t & 63)]), beta = dec[192 + (t & 63)];
        __syncthreads();
        float pp = 0.f;
#pragma unroll
        for (int i = 0; i < 64; ++i) pp += sk[half * 64 + i] * S[i];
        part[half][dv] = pp;
        __syncthreads();
        const float kS = part[0][dv] + part[1][dv];
        const float vnew = beta * (sv[dv] - a * kS);
        float o = 0.f;
#pragma unroll
        for (int i = 0; i < 64; ++i) { S[i] = a * S[i] + sk[half * 64 + i] * vnew; o += sq[half * 64 + i] * S[i]; }
        part2[half][dv] = o;
        __syncthreads();
        float ov = 0.f;
        if (half == 0) { ov = part2[0][dv] + part2[1][dv]; const float o2 = wave_sum(ov * ov); if ((tid & 63) == 0) sred2[wv] = o2; }
        __syncthreads();
        if (half == 0) {
            const float rs = rsqrtf((sred2[0] + sred2[1]) * (1.f / 128.f) + 1e-6f);
            const size_t zi = row * 1024 + h * 128 + dv;
            B.ZA[zi] = f2bf(ov * rs * gn * silu_f(bf2f(B.ZA[zi])));
        }
    }
}

__global__ void __launch_bounds__(256) k_topk_naive(Bufs B, u16_t* __restrict__ IDX) {
    const int row = blockIdx.x, b = row >> 11, t = row & 2047, tid = threadIdx.x;
    if (t < 256) return;
    __shared__ float s_score[2048], s_qi[512], s_wi[8];
    __shared__ int s_cnt;
    for (int i = tid; i < 512; i += 256) s_qi[i] = bf2f(B.QI[(size_t)row * 512 + i]);
    if (tid < 8) s_wi[tid] = B.SMALL[(size_t)row * 32 + 16 + tid] * 0.04419417382415922f;
    if (tid == 0) s_cnt = 0;
    __syncthreads();
    const int nvalid = t + 1;
    for (int s = tid; s < nvalid; s += 256) {
        const bf16_t* kr = B.KI + ((size_t)b * NT + s) * 64;
        float acc[8];
#pragma unroll
        for (int hh = 0; hh < 8; ++hh) acc[hh] = 0.f;
        for (int d = 0; d < 64; ++d) { const float kd = bf2f(kr[d]);
#pragma unroll
            for (int hh = 0; hh < 8; ++hh) acc[hh] += s_qi[hh * 64 + d] * kd; }
        float sc = 0.f;
#pragma unroll
        for (int hh = 0; hh < 8; ++hh) sc += s_wi[hh] * fmaxf(acc[hh], 0.f);
        s_score[s] = sc;
    }
    __syncthreads();
    for (int s = tid; s < nvalid; s += 256) {
        const float v = s_score[s]; int rank = 0;
        for (int s2 = 0; s2 < nvalid; ++s2) { const float v2 = s_score[s2]; rank += (v2 > v || (v2 == v && s2 < s)) ? 1 : 0; }
        if (rank < 256) { const int pos = atomicAdd(&s_cnt, 1); IDX[(size_t)row * 256 + pos] = (u16_t)s; }
    }
}
__global__ void __launch_bounds__(256) k_dsa_naive(Bufs B, const float* __restrict__ w_uk, const float* __restrict__ w_uv, const float* __restrict__ rel_bias) {
    const int row = blockIdx.x, b = row >> 11, t = row & 2047, tid = threadIdx.x, lane = tid & 63, wv = tid >> 6;
    __shared__ float s_score[2048], s_qi[512], s_wi[8], s_q[1024], s_qlat[2048], s_p[2048], s_ol[2048];
    __shared__ int s_sel[256]; __shared__ int s_cnt;
    for (int i = tid; i < 512; i += 256) s_qi[i] = bf2f(B.QI[(size_t)row * 512 + i]);
    for (int i = tid; i < 1024; i += 256) s_q[i] = bf2f(B.QB[(size_t)row * 1024 + i]);
    if (tid < 8) s_wi[tid] = B.SMALL[(size_t)row * 32 + 16 + tid] * 0.04419417382415922f;
    if (tid == 0) s_cnt = 0;
    __syncthreads();
    const int nvalid = t + 1;
    for (int s = tid; s < nvalid; s += 256) {
        const bf16_t* kr = B.KI + ((size_t)b * NT + s) * 64;
        float acc[8];
#pragma unroll
        for (int hh = 0; hh < 8; ++hh) acc[hh] = 0.f;
        for (int d = 0; d < 64; ++d) { const float kd = bf2f(kr[d]);
#pragma unroll
            for (int hh = 0; hh < 8; ++hh) acc[hh] += s_qi[hh * 64 + d] * kd; }
        float sc = 0.f;
#pragma unroll
        for (int hh = 0; hh < 8; ++hh) sc += s_wi[hh] * fmaxf(acc[hh], 0.f);
        s_score[s] = sc;
    }
    __syncthreads();
    int nsel;
    if (nvalid <= 256) { for (int s = tid; s < nvalid; s += 256) s_sel[s] = s; nsel = nvalid; }
    else {
        for (int s = tid; s < nvalid; s += 256) {
            const float v = s_score[s]; int rank = 0;
            for (int s2 = 0; s2 < nvalid; ++s2) { const float v2 = s_score[s2]; rank += (v2 > v || (v2 == v && s2 < s)) ? 1 : 0; }
            if (rank < 256) { const int pos = atomicAdd(&s_cnt, 1); s_sel[pos] = s; }
        }
        nsel = 256;
    }
    for (int o = tid; o < 2048; o += 256) {
        const int hh = o >> 8, c = o & 255; const float* wr = w_uk + (size_t)c * 1024 + hh * 128; float d = 0.f;
        for (int k = 0; k < 128; ++k) d += s_q[hh * 128 + k] * wr[k];
        s_qlat[o] = d * 0.08838834764831845f;
    }
    __syncthreads();
    for (int o = tid; o < 2048; o += 256) {
        const int hh = o >> 8, k = o & 255;
        if (k < nsel) {
            const int s = s_sel[k]; const bf16_t* cr = B.CKV + ((size_t)b * NT + s) * 256; float d = 0.f;
            for (int c = 0; c < 256; ++c) d += s_qlat[hh * 256 + c] * bf2f(cr[c]);
            s_p[o] = d + rel_bias[t5_bucket(t - s) * 8 + hh];
        }
    }
    __syncthreads();
    for (int hh = wv; hh < 8; hh += 4) {
        float m = -3.0e38f;
        for (int k = lane; k < nsel; k += 64) m = fmaxf(m, s_p[hh * 256 + k]);
        m = wave_max(m);
        float sum = 0.f;
        for (int k = lane; k < nsel; k += 64) { const float e = __expf(s_p[hh * 256 + k] - m); s_p[hh * 256 + k] = e; sum += e; }
        sum = wave_sum(sum);
        const float inv = 1.f / sum;
        for (int k = lane; k < nsel; k += 64) s_p[hh * 256 + k] *= inv;
    }
    __syncthreads();
    for (int o = tid; o < 2048; o += 256) {
        const int hh = o >> 8, c = o & 255; float d = 0.f;
        for (int k = 0; k < nsel; ++k) d += s_p[hh * 256 + k] * bf2f(B.CKV[((size_t)b * NT + s_sel[k]) * 256 + c]);
        s_ol[o] = d;
    }
    __syncthreads();
    for (int o = tid; o < 1024; o += 256) {
        const int hh = o >> 7, d = o & 127; float acc = 0.f;
        for (int c = 0; c < 256; ++c) acc += s_ol[hh * 256 + c] * w_uv[(size_t)c * 1024 + hh * 128 + d];
        const float z = bf2f(B.ZB[(size_t)row * 1024 + o]);
        B.QB[(size_t)row * 1024 + o] = f2bf(acc * silu_f(z));
    }
}

#ifndef MK_SPLIT
#define MK_SPLIT 0
#endif

extern "C" void kernel_launch(void* const* d_in, const int* in_sizes, int n_in, void* d_out, int out_size, void* d_ws, size_t ws_size, hipStream_t stream) {
    static int grid = 0;
    if (grid == 0) {
        if (n_in != 18 || ws_size < WS_NEED || out_size != MROWS * DM) { fprintf(stderr, "kernel_launch: unexpected shapes (n_in %d, ws %zu, out %d)\n", n_in, ws_size, out_size); grid = -1; return; }
        int dev = 0, cus = 0;
        if (hipGetDevice(&dev) != hipSuccess || hipDeviceGetAttribute(&cus, hipDeviceAttributeMultiprocessorCount, dev) != hipSuccess) { grid = -1; return; }
        if (hipFuncSetAttribute((const void*)fwd, hipFuncAttributeMaxDynamicSharedMemorySize, LDS_BYTES) != hipSuccess) { fprintf(stderr, "kernel_launch: hipFuncSetAttribute failed\n"); grid = -1; return; }
        int per_cu = 0;
        if (hipOccupancyMaxActiveBlocksPerMultiprocessor(&per_cu, (const void*)fwd, NTHR, LDS_BYTES) != hipSuccess || per_cu < 1) fprintf(stderr, "kernel_launch: occupancy query says %d\n", per_cu);
        (void)hipGetLastError();
        grid = cus > 0 ? cus : 256;
    }
    if (grid < 0) return;
    const float* conv_w = (const float*)d_in[6]; const float* a_log = (const float*)d_in[7]; const float* dt_bias = (const float*)d_in[8];
    const float* gdn_norm_g = (const float*)d_in[9]; const float* kv_norm_g = (const float*)d_in[11];
    const float* w_uk = (const float*)d_in[12]; const float* w_uv = (const float*)d_in[13]; const float* rel_bias = (const float*)d_in[16];
    (void)hipMemsetAsync((char*)d_ws + OFF_CTL, 0, CTL_ZERO_BYTES, stream);
    Params p{};
    for (int i = 0; i < 18; ++i) p.in[i] = (const float*)d_in[i];
    p.out = (float*)d_out; p.ws = (char*)d_ws;
    const Bufs B = make_bufs((char*)d_ws, (char*)d_out);
    int li = 0;
#define FWD(lo_, hi_) do { p.ph_lo = (lo_); p.ph_hi = (hi_); p.li = li++; hipLaunchKernelGGL(fwd, dim3(grid), dim3(NTHR), LDS_BYTES, stream, p); } while (0)
    FWD(0, 11);
#undef FWD
}
```

```cpp
#include <hip/hip_runtime.h>
#include <stdint.h>
#include <stdio.h>

#define LAS __attribute__((address_space(3)))
typedef unsigned short bf16_t;
typedef short bf16x8 __attribute__((ext_vector_type(8)));
typedef float f32x4 __attribute__((ext_vector_type(4)));
typedef unsigned u32x4 __attribute__((ext_vector_type(4)));
typedef unsigned u32x2 __attribute__((ext_vector_type(2)));
__device__ __forceinline__ float bf2f(bf16_t v) { return __uint_as_float(((unsigned)v) << 16); }
__device__ __forceinline__ bf16_t f2bf(float f) { unsigned u = __float_as_uint(f); u += 0x7FFFu + ((u >> 16) & 1u); return (bf16_t)(u >> 16); }
__device__ __forceinline__ float bflo(unsigned w) { return __uint_as_float(w << 16); }
__device__ __forceinline__ float bfhi(unsigned w) { return __uint_as_float(w & 0xFFFF0000u); }
__device__ __forceinline__ unsigned cvt_pk_bf16(float lo, float hi) { unsigned r; asm volatile("v_cvt_pk_bf16_f32 %0, %1, %2" : "=v"(r) : "v"(lo), "v"(hi)); return r; }
__device__ __forceinline__ float silu_f(float x) { return x / (1.f + __expf(-x)); }
__device__ __forceinline__ float sigmoid_f(float x) { return 1.f / (1.f + __expf(-x)); }
__device__ __forceinline__ float wave_sum(float v) {
#pragma unroll
    for (int o = 32; o > 0; o >>= 1) v += __shfl_xor(v, o);
    return v;
}
__device__ __forceinline__ float wave_max(float v) {
#pragma unroll
    for (int o = 32; o > 0; o >>= 1) v = fmaxf(v, __shfl_xor(v, o));
    return v;
}

constexpr int NB = 8, NT = 2048, DM = 1024, MROWS = NB * NT;
constexpr int NPAD = 7168;
constexpr int NWT = 9216;
constexpr size_t MiB = 1ull << 20;
constexpr size_t OFF_CTL = 0, CTL_ZERO_BYTES = 64 * 1024, OFF_MOD = 64 * 1024, OFF_SMALL = 1 * MiB, OFF_KI = 3 * MiB, OFF_CKV = 5 * MiB, OFF_QI = 13 * MiB,
                 OFF_QA = 29 * MiB, OFF_KA = 61 * MiB, OFF_VA = 93 * MiB, OFF_ZA = 125 * MiB, OFF_QB = 157 * MiB, OFF_ZB = 189 * MiB,
                 OFF_H = 221 * MiB, OFF_WOUT_T = 253 * MiB, WS_NEED = 255 * MiB;
constexpr size_t OFF_XNEW = OFF_QA, OFF_MERGED = OFF_VA, OFF_PARK = OFF_KA;
constexpr size_t OO_WT = 0, OO_WOG_T = 18 * MiB, OO_WOD_T = 20 * MiB;
constexpr size_t OO_TPATT = 31 * MiB;
constexpr size_t OO_STASH = 55 * MiB;
constexpr size_t OO_DEC = 60 * MiB;
constexpr size_t OO_WUK_B = 22 * MiB;
constexpr size_t OO_WUV_T = 22 * MiB + 512 * 1024;
constexpr size_t OO_IDX = 23 * MiB;
constexpr int CW_BAR = 1024;

__host__ __device__ __forceinline__ int wt_col(int n) {
    if (n < 4096) return n;
    if (n < 5120) return 4112 + (n - 4096);
    if (n < 6144) return 5392 + (n - 5120);
    if (n < 6400) return 5136 + (n - 6144);
    if (n < 6912) return 6416 + (n - 6400);
    if (n < 6976) return 6928 + (n - 6912);
    if (n < 6984) return 4096 + (n - 6976);
    if (n < 6992) return 4104 + (n - 6984);
    if (n < 7000) return 6992 + (n - 6992);
    if (n < 7168) return -1;
    return 7000 + (n - 7168);
}

struct Bufs {
    bf16_t *QA, *KA, *VA, *ZA, *QB, *ZB, *CKV, *QI, *KI, *H, *WT, *WOG_T, *WOD_T, *WOUT_T, *MERGED, *PARK;
    float *SMALL, *MOD, *XNEW;
};
__host__ __device__ __forceinline__ Bufs make_bufs(char* ws, char* os) {
    Bufs B;
    B.QA = (bf16_t*)(ws + OFF_QA); B.KA = (bf16_t*)(ws + OFF_KA); B.VA = (bf16_t*)(ws + OFF_VA); B.ZA = (bf16_t*)(ws + OFF_ZA);
    B.QB = (bf16_t*)(ws + OFF_QB); B.ZB = (bf16_t*)(ws + OFF_ZB); B.CKV = (bf16_t*)(ws + OFF_CKV); B.QI = (bf16_t*)(ws + OFF_QI);
    B.KI = (bf16_t*)(ws + OFF_KI); B.H = (bf16_t*)(ws + OFF_H); B.WT = (bf16_t*)(os + OO_WT); B.WOG_T = (bf16_t*)(os + OO_WOG_T);
    B.WOD_T = (bf16_t*)(os + OO_WOD_T); B.WOUT_T = (bf16_t*)(ws + OFF_WOUT_T); B.MERGED = (bf16_t*)(ws + OFF_MERGED); B.PARK = (bf16_t*)(ws + OFF_PARK);
    B.SMALL = (float*)(ws + OFF_SMALL); B.MOD = (float*)(ws + OFF_MOD); B.XNEW = (float*)(ws + OFF_XNEW);
    return B;
}

namespace pg8 {
#define PG8_LAS __attribute__((address_space(3)))
constexpr int BM = 256, BK = 64, HALF = 128, HTB = HALF * BK * 2  , STAGE_BYTES = 8 * HTB, NXCD = 8, WGM = 8;
__host__ __device__ __forceinline__ int lds_byte(int r, int c) { const int st = (r >> 4) * 2 + (c >> 5), rr = r & 15, cc = c & 31, ob = rr * 64 + cc * 2; return st * 1024 + (ob ^ (((ob >> 9) & 1) << 5)); }
__host__ __device__ __forceinline__ void stage_rc(int b, int& R, int& C) { const int st = b / 1024, sb = b % 1024, swz = sb ^ (((sb >> 9) & 1) << 5); R = (st >> 1) * 16 + swz / 64; C = (st & 1) * 32 + (swz % 64) / 2; }
__host__ __device__ __forceinline__ int perm32(int rho) { const int n = rho >> 4, i = rho & 15; return 8 * (i >> 2) + 4 * n + (i & 3); }
struct Unit { int pm, pn, st; };
struct StaticOrder {
    int nM, nN, nwg, G, c;
    __host__ __device__ void init(int M, int N, int G_, int c_) { nM = M / BM; nN = N / BM; nwg = nM * nN; G = G_; c = c_; }
    __host__ __device__ bool tile(int i, int& pm, int& pn) const {
        const long L = (long)i * G + c; if (L >= nwg) return false;
        int wgid = (int)L; { const int q = nwg / NXCD, r = nwg % NXCD, xcd = wgid % NXCD, off = wgid / NXCD; wgid = (xcd < r ? xcd * (q + 1) : r * (q + 1) + (xcd - r) * q) + off; }
        const int nig = WGM * nN, gid = wgid / nig, fm = gid * WGM, gsz = (nM - fm) < WGM ? (nM - fm) : WGM;
        pm = fm + ((wgid % nig) % gsz); pn = (wgid % nig) / gsz; return true;
    }
};
template <class Epi, class Sched, bool ALIGN_EPI = false, bool SP2 = false>
__device__ __forceinline__ void gemm_phase(PG8_LAS unsigned char* lds, const int K, const int lda, const int ldb, const Sched& S, const Epi& E) {
    const int tid = threadIdx.x, wid = __builtin_amdgcn_readfirstlane(tid >> 6), lane = tid & 63, wr = wid >> 2, wc = wid & 3, fr = lane & 15, fq = lane >> 4;
    const int nt = K / BK;
    unsigned voffA[2], voffB[2];
#pragma unroll
    for (int i = 0; i < 2; ++i) { int R, C; stage_rc(tid * 16 + i * 8192, R, C); const int Rb = Epi::PERM ? ((R & ~31) + perm32(R & 31)) : R;
        voffA[i] = (unsigned)(R * lda + C) * 2u; voffB[i] = (unsigned)(Rb * ldb + C) * 2u; }
    const size_t kstep = (size_t)(BK * 2);
    const size_t hstepA = (size_t)HALF * lda * 2, hstepB = (size_t)HALF * ldb * 2;
    const unsigned ldsw = (unsigned)wid * 1024u;
    const int aoff = lds_byte(wr * 64 + fr, fq * 8), boff = lds_byte(wc * 32 + fr, fq * 8);
#define PG8_SA(b, h) (((b) * 2 + (h)) * HTB)
#define PG8_SB(b, h) ((4 + (b) * 2 + (h)) * HTB)
#define PG8_STAGE(bufoff, gbase, voff) do { _Pragma("unroll") for (int _i = 0; _i < 2; ++_i) \
        __builtin_amdgcn_global_load_lds((const unsigned*)((const char*)(gbase) + (voff)[_i]), (PG8_LAS unsigned*)(lds + (bufoff) + ldsw + _i * 8192), 16, 0, 0); } while (0)
#define PG8_LDA(dst, b, h) do { _Pragma("unroll") for (int m = 0; m < 4; ++m) _Pragma("unroll") for (int k = 0; k < 2; ++k) dst[m][k] = *(const PG8_LAS bf16x8*)(lds + PG8_SA(b, h) + aoff + m * 2048 + k * 1024); } while (0)
#define PG8_LDB(dst, b, h) do { _Pragma("unroll") for (int n = 0; n < 2; ++n) _Pragma("unroll") for (int k = 0; k < 2; ++k) dst[n][k] = *(const PG8_LAS bf16x8*)(lds + PG8_SB(b, h) + boff + n * 2048 + k * 1024); } while (0)
#define PG8_MMA(ai, bj, At, Bt) do { __builtin_amdgcn_s_setprio(1); _Pragma("unroll") for (int m = 0; m < 4; ++m) _Pragma("unroll") for (int n = 0; n < 2; ++n) _Pragma("unroll") for (int k = 0; k < 2; ++k) \
        acc[ai][bj][m][n] = __builtin_amdgcn_mfma_f32_16x16x32_bf16(Bt[n][k], At[m][k], acc[ai][bj][m][n], 0, 0, 0); __builtin_amdgcn_s_setprio(0); } while (0)
#define PG8_WAIT_V(n) asm volatile("s_waitcnt vmcnt(" #n ")" ::: "memory")
#define PG8_WAIT_L(n) asm volatile("s_waitcnt lgkmcnt(" #n ")" ::: "memory")
#define PG8_BAR __builtin_amdgcn_s_barrier()
#define PG8_SCHED __builtin_amdgcn_sched_barrier(0)
    Unit cur, nxt; int ui = 0;
    if (!S.next(0, cur)) return;
    f32x4 acc[2][2][4][2];
#pragma unroll
    for (int a = 0; a < 2; ++a)
#pragma unroll
        for (int b = 0; b < 2; ++b)
#pragma unroll
            for (int m = 0; m < 4; ++m)
#pragma unroll
                for (int n = 0; n < 2; ++n) acc[a][b][m][n] = (f32x4){0.f, 0.f, 0.f, 0.f};
    bf16x8 At[4][2], B0[2][2], B1[2][2];
    const char* cA = S.a_ptr(cur); const char* cB = S.b_ptr(cur);
    S.a_ready(cur);
    if constexpr (SP2) {
        PG8_STAGE(PG8_SB(0, 0), cB, voffB); PG8_STAGE(PG8_SB(0, 1), cB + hstepB, voffB); PG8_STAGE(PG8_SA(0, 0), cA, voffA); PG8_STAGE(PG8_SA(0, 1), cA + hstepA, voffA);
        if (wr == 1) PG8_BAR;
        PG8_WAIT_V(2); PG8_BAR;
        PG8_STAGE(PG8_SB(1, 0), cB + kstep, voffB); PG8_STAGE(PG8_SA(1, 0), cA + kstep, voffA); PG8_STAGE(PG8_SB(1, 1), cB + hstepB + kstep, voffB);
        PG8_WAIT_V(6); PG8_BAR;
    } else {
        PG8_STAGE(PG8_SB(0, 0), cB, voffB); PG8_STAGE(PG8_SA(0, 0), cA, voffA); PG8_STAGE(PG8_SB(0, 1), cB + hstepB, voffB); PG8_STAGE(PG8_SA(0, 1), cA + hstepA, voffA);
        if (wr == 1) PG8_BAR;
        PG8_WAIT_V(4); PG8_BAR;
        PG8_STAGE(PG8_SB(1, 0), cB + kstep, voffB); PG8_STAGE(PG8_SA(1, 0), cA + kstep, voffA); PG8_STAGE(PG8_SB(1, 1), cB + hstepB + kstep, voffB);
        PG8_WAIT_V(6); PG8_BAR;
    }
    for (;;) {
        const bool has_next = S.next(ui + 1, nxt);
        const char* nA = has_next ? S.a_ptr(nxt) : cA; const char* nB = has_next ? S.b_ptr(nxt) : cB;
        for (int t = 0; t < nt; t += 2) {
            const bool last = (t == nt - 2);
            const char* a1 = cA + (size_t)(t + 1) * kstep;
            const char* a2 = last ? nA : cA + (size_t)(t + 2) * kstep; const char* b2 = last ? nB : cB + (size_t)(t + 2) * kstep;
            const char* a3 = a2 + kstep; const char* b3 = b2 + kstep;
            if (last && has_next) S.a_ready(nxt);
            if constexpr (SP2) {
            PG8_LDB(B0, 0, 0); PG8_LDB(B1, 0, 1); PG8_SCHED; PG8_LDA(At, 0, 0); PG8_STAGE(PG8_SA(1, 1), a1 + hstepA, voffA);
            PG8_WAIT_V(8); PG8_WAIT_L(0); PG8_BAR; PG8_MMA(0, 0, At, B0); PG8_MMA(0, 1, At, B1); PG8_BAR; PG8_SCHED;
            PG8_LDA(At, 0, 1); PG8_STAGE(PG8_SB(0, 0), b2, voffB); PG8_STAGE(PG8_SB(0, 1), b2 + hstepB, voffB); PG8_STAGE(PG8_SA(0, 0), a2, voffA);
            PG8_WAIT_V(8); PG8_WAIT_L(0); PG8_BAR; PG8_MMA(1, 0, At, B0); PG8_MMA(1, 1, At, B1); PG8_BAR; PG8_SCHED;
            PG8_LDB(B0, 1, 0); PG8_LDB(B1, 1, 1); PG8_SCHED; PG8_LDA(At, 1, 0); PG8_STAGE(PG8_SA(0, 1), a2 + hstepA, voffA);
            PG8_WAIT_V(8); PG8_WAIT_L(0); PG8_BAR; PG8_MMA(0, 0, At, B0); PG8_MMA(0, 1, At, B1); PG8_BAR; PG8_SCHED;
            PG8_LDA(At, 1, 1); PG8_STAGE(PG8_SB(1, 0), b3, voffB); PG8_STAGE(PG8_SB(1, 1), b3 + hstepB, voffB); PG8_STAGE(PG8_SA(1, 0), a3, voffA);
            PG8_WAIT_V(8); PG8_WAIT_L(0); PG8_BAR; PG8_MMA(1, 0, At, B0); PG8_MMA(1, 1, At, B1); PG8_BAR; PG8_SCHED;
            } else {
            PG8_LDB(B0, 0, 0); PG8_SCHED; PG8_LDA(At, 0, 0); PG8_STAGE(PG8_SA(1, 1), a1 + hstepA, voffA);
            PG8_WAIT_L(8); PG8_BAR; PG8_WAIT_L(0); PG8_MMA(0, 0, At, B0); PG8_BAR; PG8_SCHED;
            PG8_LDB(B1, 0, 1); PG8_STAGE(PG8_SB(0, 0), b2, voffB);
            PG8_BAR; PG8_WAIT_L(0); PG8_MMA(0, 1, At, B1); PG8_BAR;
            PG8_LDA(At, 0, 1); PG8_STAGE(PG8_SA(0, 0), a2, voffA);
            PG8_BAR; PG8_WAIT_L(0); PG8_MMA(1, 0, At, B0); PG8_BAR; PG8_SCHED;
            PG8_STAGE(PG8_SB(0, 1), b2 + hstepB, voffB);
            PG8_WAIT_V(6); PG8_BAR; PG8_MMA(1, 1, At, B1); PG8_BAR;
            PG8_LDB(B0, 1, 0); PG8_SCHED; PG8_LDA(At, 1, 0); PG8_STAGE(PG8_SA(0, 1), a2 + hstepA, voffA);
            PG8_WAIT_L(8); PG8_BAR; PG8_WAIT_L(0); PG8_MMA(0, 0, At, B0); PG8_BAR; PG8_SCHED;
            PG8_LDB(B1, 1, 1); PG8_STAGE(PG8_SB(1, 0), b3, voffB);
            PG8_BAR; PG8_WAIT_L(0); PG8_MMA(0, 1, At, B1); PG8_BAR;
            PG8_LDA(At, 1, 1); PG8_STAGE(PG8_SA(1, 0), a3, voffA);
            PG8_BAR; PG8_WAIT_L(0); PG8_MMA(1, 0, At, B0); PG8_BAR; PG8_SCHED;
            PG8_STAGE(PG8_SB(1, 1), b3 + hstepB, voffB);
            PG8_WAIT_V(6); PG8_BAR; PG8_MMA(1, 1, At, B1); PG8_BAR;
            }
        }
        if constexpr (ALIGN_EPI) { if (wr == 0) PG8_BAR; }
        if constexpr (!Epi::AFTER_DRAIN) { E(acc, cur, wr, wc, fr, fq); S.done(cur); }
        if (!has_next) break;
#pragma unroll
        for (int a = 0; a < 2; ++a)
#pragma unroll
            for (int b = 0; b < 2; ++b)
#pragma unroll
                for (int m = 0; m < 4; ++m)
#pragma unroll
                    for (int n = 0; n < 2; ++n) acc[a][b][m][n] = (f32x4){0.f, 0.f, 0.f, 0.f};
        cur = nxt; cA = nA; cB = nB; ++ui;
        if constexpr (ALIGN_EPI) { if (wr == 1) PG8_BAR; }
    }
    PG8_WAIT_V(0);
    if constexpr (!ALIGN_EPI) { if (wr == 0) PG8_BAR; }
    PG8_BAR;
    if constexpr (Epi::AFTER_DRAIN) { E.fused(acc, cur, wr, wc, fr, fq, lds, wid, lane); S.done(cur); }
#undef PG8_SA
#undef PG8_SB
#undef PG8_STAGE
#undef PG8_LDA
#undef PG8_LDB
#undef PG8_MMA
#undef PG8_WAIT_V
#undef PG8_WAIT_L
#undef PG8_BAR
#undef PG8_SCHED
}
}

struct SchedProj {
    pg8::StaticOrder so; const char* A; const char* Bt;
    __device__ __forceinline__ bool next(int i, pg8::Unit& u) const { u.st = 0; return so.tile(i, u.pm, u.pn); }
    __device__ __forceinline__ const char* a_ptr(const pg8::Unit& u) const { return A + (size_t)u.pm * (256 * DM * 2); }
    __device__ __forceinline__ const char* b_ptr(const pg8::Unit& u) const { return Bt + (size_t)u.pn * (256 * DM * 2); }
    __device__ __forceinline__ void a_ready(const pg8::Unit&) const {}
    __device__ __forceinline__ void done(const pg8::Unit&) const {}
};
struct SchedMerge {
    pg8::StaticOrder so; const char* ws; const char* os;
    __device__ __forceinline__ bool next(int i, pg8::Unit& u) const { u.st = i & 3; return so.tile(i >> 2, u.pm, u.pn); }
    __device__ __forceinline__ const char* a_ptr(const pg8::Unit& u) const {
        const size_t off = (u.st == 1) ? OFF_ZA : (u.st == 3) ? OFF_QB : OFF_H;
        return ws + off + (size_t)u.pm * (256 * DM * 2); }
    __device__ __forceinline__ const char* b_ptr(const pg8::Unit& u) const {
        const size_t off = (u.st == 0) ? (OO_WT + (size_t)7168 * DM * 2) : (u.st == 1) ? OO_WOG_T : (u.st == 2) ? (OO_WT + (size_t)8192 * DM * 2) : OO_WOD_T;
        return os + off + (size_t)u.pn * (256 * DM * 2); }
    __device__ __forceinline__ void a_ready(const pg8::Unit&) const {}
    __device__ __forceinline__ void done(const pg8::Unit&) const {}
};

__device__ __forceinline__ u32x4 pack8(const f32x4 v0, const f32x4 v1) { u32x4 w; w.x = cvt_pk_bf16(v0[0], v0[1]); w.y = cvt_pk_bf16(v0[2], v0[3]); w.z = cvt_pk_bf16(v1[0], v1[1]); w.w = cvt_pk_bf16(v1[2], v1[3]); return w; }
struct EpiProj {
    static constexpr bool PERM = true, AFTER_DRAIN = false;
    char* ws; char* os;
    __device__ __forceinline__ void operator()(const f32x4 (&acc)[2][2][4][2], const pg8::Unit& u, int wr, int wc, int fr, int fq) const {
        const int row0 = u.pm * 256 + wr * 64 + fr, lc0 = wc * 32 + 8 * fq, pn = u.pn;
        bf16_t* const KI = (bf16_t*)(ws + OFF_KI); float* const SMALL = (float*)(ws + OFF_SMALL);
        if (pn < 27) {
            bf16_t* base; int ldc, cb;
            if (pn < 24) { base = (bf16_t*)(ws + OFF_QA + (size_t)(pn >> 2) * (32 * MiB)); ldc = 1024; cb = (pn & 3) * 256; }
            else if (pn == 24) { base = (bf16_t*)(ws + OFF_CKV); ldc = 256; cb = 0; }
            else { base = (bf16_t*)(ws + OFF_QI); ldc = 512; cb = (pn - 25) * 256; }
#pragma unroll
            for (int ai = 0; ai < 2; ++ai)
#pragma unroll
                for (int m = 0; m < 4; ++m) { bf16_t* rowp = base + (size_t)(row0 + ai * 128 + m * 16) * ldc + cb + lc0;
#pragma unroll
                    for (int bj = 0; bj < 2; ++bj) *(u32x4*)(rowp + bj * 128) = pack8(acc[ai][bj][m][0], acc[ai][bj][m][1]); }
            if (pn < 12 && fr >= 13) {
                bf16_t* st = (bf16_t*)(os + OO_STASH) + (size_t)(pn >> 2) * (256 * 3 * 1024);
#pragma unroll
                for (int ai = 0; ai < 2; ++ai) { const int row = row0 + ai * 128 + 48; bf16_t* sp = st + ((size_t)(row >> 6) * 3 + ((row & 63) - 61)) * 1024 + cb + lc0;
#pragma unroll
                    for (int bj = 0; bj < 2; ++bj) *(u32x4*)(sp + bj * 128) = pack8(acc[ai][bj][3][0], acc[ai][bj][3][1]); }
            }
        } else {
#pragma unroll
            for (int ai = 0; ai < 2; ++ai)
#pragma unroll
                for (int m = 0; m < 4; ++m) { const size_t row = (size_t)(row0 + ai * 128 + m * 16);
                    if (lc0 < 64) *(u32x4*)(KI + row * 64 + lc0) = pack8(acc[ai][0][m][0], acc[ai][0][m][1]);
                    else if (lc0 < 88) { *(f32x4*)(SMALL + row * 32 + (lc0 - 64)) = acc[ai][0][m][0]; *(f32x4*)(SMALL + row * 32 + (lc0 - 64) + 4) = acc[ai][0][m][1]; } }
        }
    }
};
__device__ __forceinline__ f32x4 sig4(const f32x4 v) { f32x4 r; r[0] = sigmoid_f(v[0]); r[1] = sigmoid_f(v[1]); r[2] = sigmoid_f(v[2]); r[3] = sigmoid_f(v[3]); return r; }
__device__ __forceinline__ void unpack8(const u32x4 w, f32x4& a, f32x4& b) { a[0] = bflo(w.x); a[1] = bfhi(w.x); a[2] = bflo(w.y); a[3] = bfhi(w.y); b[0] = bflo(w.z); b[1] = bfhi(w.z); b[2] = bflo(w.w); b[3] = bfhi(w.w); }
struct EpiMerge {
    static constexpr bool PERM = true, AFTER_DRAIN = false;
    bf16_t* MERGED; bf16_t* PARK;
    __device__ __forceinline__ void operator()(const f32x4 (&acc)[2][2][4][2], const pg8::Unit& u, int wr, int wc, int fr, int fq) const {
        const int row0 = u.pm * 256 + wr * 64 + fr, col0 = u.pn * 256 + wc * 32 + 8 * fq, st = u.st;
#pragma unroll
        for (int ai = 0; ai < 2; ++ai)
#pragma unroll
            for (int m = 0; m < 4; ++m) { const size_t off = (size_t)(row0 + ai * 128 + m * 16) * 1024 + col0;
#pragma unroll
                for (int bj = 0; bj < 2; ++bj) {
                    const f32x4 v0 = acc[ai][bj][m][0], v1 = acc[ai][bj][m][1];
                    u32x4* pm_ = (u32x4*)(MERGED + off + bj * 128); u32x4* pp_ = (u32x4*)(PARK + off + bj * 128);
                    if (st == 0) *pm_ = pack8(sig4(v0), sig4(v1));
                    else if (st == 1) { f32x4 g0, g1; unpack8(*pm_, g0, g1); *pm_ = pack8(g0 * v0, g1 * v1); }
                    else if (st == 2) *pp_ = pack8(sig4(v0), sig4(v1));
                    else { f32x4 a0, a1, g0, g1; unpack8(*pm_, a0, a1); unpack8(*pp_, g0, g1); *pm_ = pack8(a0 + g0 * v0, a1 + g1 * v1); }
                } }
    }
};
struct EpiOut {
    static constexpr bool PERM = false, AFTER_DRAIN = false;
    const float* x; const float* MOD; float* XNEW;
    __device__ __forceinline__ void operator()(const f32x4 (&acc)[2][2][4][2], const pg8::Unit& u, int wr, int wc, int fr, int fq) const {
        const int row0 = u.pm * 256 + wr * 64 + fr, col0 = u.pn * 256 + wc * 32 + 4 * fq; const int b = u.pm >> 3;
        f32x4 gv[2][2];
#pragma unroll
        for (int bj = 0; bj < 2; ++bj)
#pragma unroll
            for (int n = 0; n < 2; ++n) gv[bj][n] = *(const f32x4*)(MOD + b * 3072 + 2048 + col0 + bj * 128 + n * 16);
#pragma unroll
        for (int ai = 0; ai < 2; ++ai)
#pragma unroll
            for (int m = 0; m < 4; ++m) { const size_t off = (size_t)(row0 + ai * 128 + m * 16) * 1024 + col0;
#pragma unroll
                for (int bj = 0; bj < 2; ++bj)
#pragma unroll
                    for (int n = 0; n < 2; ++n) { const f32x4 xv = *(const f32x4*)(x + off + bj * 128 + n * 16); *(f32x4*)(XNEW + off + bj * 128 + n * 16) = xv + gv[bj][n] * acc[ai][bj][m][n]; } }
    }
};

#define XB_TMO      128
#define XB_XCNT(j)  (256  + 64 * (j))
#define XB_XSUB(j)  (1280 + 64 * (j))
#define XB_XGEN(j)  (2304 + 64 * (j))
#define XB_TOP      3328
#define XB_TOPGEN   3392
#define XCD_BAR_WORDS 3456
#define XB_SPIN_CAP (1u << 18)

__device__ __forceinline__ unsigned xb_ld(unsigned* p)              { return __hip_atomic_load(p, __ATOMIC_RELAXED, __HIP_MEMORY_SCOPE_AGENT); }
__device__ __forceinline__ unsigned xb_add(unsigned* p, unsigned v) { return __hip_atomic_fetch_add(p, v, __ATOMIC_RELAXED, __HIP_MEMORY_SCOPE_AGENT); }
__device__ __forceinline__ unsigned xb_xcc_id() { return (unsigned)__builtin_amdgcn_s_getreg((3 << 11) | 20) & 0xFu; }
#define XB_SPIN(cond, bar) do { unsigned _sp = 0; while (cond) { __builtin_amdgcn_s_sleep(1); \
    if ((++_sp & 255u) == 0u) { if (xb_ld(&(bar)[XB_TMO])) break; if (_sp > XB_SPIN_CAP) { atomicAdd(&(bar)[XB_TMO], 1u); break; } } } } while (0)

struct XcdBarrier {
    unsigned* bar; unsigned x;
    volatile LAS unsigned* st;
};

__device__ __forceinline__ XcdBarrier xcd_barrier_post(unsigned* bar, volatile LAS unsigned* st) {
    XcdBarrier b; b.bar = bar; b.x = xb_xcc_id(); b.st = st;
    if (threadIdx.x == 0) (void)xb_add(&bar[XB_XCNT(b.x)], 1u);
    return b;
}
__device__ __forceinline__ void xcd_barrier_complete(unsigned* bar, unsigned x, unsigned& nloc, unsigned& nx) {
    const unsigned G = gridDim.x * gridDim.y * gridDim.z;
    unsigned sum, cnt, mine, sp = 0u;
    for (;;) {
        sum = 0u; cnt = 0u; mine = 0u;
#pragma unroll
        for (unsigned j = 0; j < 16; ++j) { const unsigned c = xb_ld(&bar[XB_XCNT(j)]); sum += c; cnt += (c > 0u) ? 1u : 0u; mine = (j == x) ? c : mine; }
        if (sum == G) break;
        __builtin_amdgcn_s_sleep(1);
        if ((++sp & 255u) == 0u) { if (xb_ld(&bar[XB_TMO])) break; if (sp > XB_SPIN_CAP) { atomicAdd(&bar[XB_TMO], 1u); break; } }
    }
    nloc = mine > 0u ? mine : 1u; nx = cnt > 0u ? cnt : 1u;
}

__device__ __forceinline__ void xcd_barrier(const XcdBarrier& b) {
    asm volatile("s_waitcnt vmcnt(0)" ::: "memory");
    __syncthreads();
    if (threadIdx.x == 0) {
        unsigned* bar = b.bar;
        __builtin_amdgcn_s_waitcnt(0);
        unsigned nloc = b.st[0], nx = b.st[1];
        if (nloc == 0u) { xcd_barrier_complete(bar, b.x, nloc, nx); b.st[0] = nloc; b.st[1] = nx; }
        const unsigned old = xb_add(&bar[XB_XSUB(b.x)], 1u);
        const unsigned gen = old / nloc;
        if (old + 1u == (gen + 1u) * nloc) {
            __builtin_amdgcn_fence(__ATOMIC_RELEASE, "agent");
            asm volatile("s_waitcnt vmcnt(0)" ::: "memory");
            const unsigned og = xb_add(&bar[XB_TOP], 1u);
            const unsigned tg = og / nx;
            if (og + 1u == (tg + 1u) * nx) xb_add(&bar[XB_TOPGEN], 1u);
            else XB_SPIN(xb_ld(&bar[XB_TOPGEN]) == tg, bar);
            __builtin_amdgcn_fence(__ATOMIC_ACQUIRE, "agent");
            xb_add(&bar[XB_XGEN(b.x)], 1u);
            asm volatile("s_waitcnt vmcnt(0)" ::: "memory");
        } else {
            XB_SPIN(xb_ld(&bar[XB_XGEN(b.x)]) == gen, bar);
            __builtin_amdgcn_fence(__ATOMIC_ACQUIRE, "agent");
            asm volatile("s_waitcnt vmcnt(0)" ::: "memory");
        }
    }
    __syncthreads();
}

constexpr int NWAVES = 8, NTHR = 512;
constexpr int RING_OFF = 0, RING_BYTES = 131072, LDS_BYTES = 163840, LDSCTL_OFF = LDS_BYTES - 256;
struct Params { const float* in[18]; float* out; char* ws; int ph_lo, ph_hi, li, pad; };

__device__ __forceinline__ void tr_tiles(const float* __restrict__ src, const int ld_src, bf16_t* __restrict__ dst, const int mode, const int ntn, LAS unsigned char* lds, const int nkt = 32, const int dstld = DM) {
    const int tid = threadIdx.x, G = gridDim.x, sub = tid >> 8, t = tid & 255, tx = t & 31, ty = t >> 5;
    LAS float* tile = (LAS float*)lds + sub * (32 * 33);
    const int NTILES = ntn * nkt;
    for (int base = blockIdx.x * 2; base < NTILES; base += G * 2) {
        const int id = base + sub, tn = id / nkt, tk = id % nkt, n0 = tn * 32, k0 = tk * 32;
        if (id < NTILES) {
#pragma unroll
            for (int i = 0; i < 4; ++i) { const int k = k0 + ty + i * 8, n = n0 + tx; const int col = mode ? wt_col(n) : n; tile[(ty + i * 8) * 33 + tx] = (col >= 0) ? src[(size_t)k * ld_src + col] : 0.f; }
        }
        __syncthreads();
        if (id < NTILES) {
#pragma unroll
            for (int i = 0; i < 4; ++i) { const int n = n0 + ty + i * 8, k = k0 + tx; dst[(size_t)n * dstld + k] = f2bf(tile[tx * 33 + ty + i * 8]); }
        }
        __syncthreads();
    }
}
__device__ __forceinline__ void p0_prologue(const Params& p, const Bufs& B, LAS unsigned char* lds) {
    const int tid = threadIdx.x, G = gridDim.x;
    tr_tiles(p.in[5], 9048, B.WT, 1, NWT / 32, lds);
    tr_tiles(p.in[10], 1024, B.WOG_T, 0, 32, lds);
    tr_tiles(p.in[14], 1024, B.WOD_T, 0, 32, lds);
    tr_tiles(p.in[15], 1024, B.WOUT_T, 0, 32, lds);
    tr_tiles(p.in[13], 1024, (bf16_t*)((char*)p.out + OO_WUV_T), 0, 32, lds, 8, 256);
    { bf16_t* wk = (bf16_t*)((char*)p.out + OO_WUK_B); const float* src = p.in[12]; for (int i = blockIdx.x * NTHR + threadIdx.x; i < 256 * 1024; i += G * NTHR) wk[i] = f2bf(src[i]); }
    {
        LAS float* sc = (LAS float*)(lds + 16384);
        LAS float* part = (LAS float*)(lds + 16384 + 32768);
        const float* c = p.in[1]; const float* w_ada = p.in[3]; const float* b_ada = p.in[4];
        for (int jb = blockIdx.x; jb < 192; jb += G) {
            for (int i = tid; i < 8192; i += NTHR) sc[i] = silu_f(c[i]);
            __syncthreads();
            const int jj = tid & 15, sl = tid >> 4, j = jb * 16 + jj;
            float acc[8];
#pragma unroll
            for (int b = 0; b < 8; ++b) acc[b] = 0.f;
            for (int ii = 0; ii < 32; ++ii) { const int i = sl * 32 + ii; const float w = w_ada[(size_t)i * 3072 + j];
#pragma unroll
                for (int b = 0; b < 8; ++b) acc[b] += sc[b * 1024 + i] * w; }
#pragma unroll
            for (int b = 0; b < 8; ++b) part[(sl * 8 + b) * 16 + jj] = acc[b];
            __syncthreads();
            if (tid < 128) { const int b = tid >> 4, j2 = tid & 15; float s = 0.f;
                for (int s2 = 0; s2 < 32; ++s2) s += part[(s2 * 8 + b) * 16 + j2];
                B.MOD[b * 3072 + jb * 16 + j2] = s + b_ada[jb * 16 + j2]; }
            __syncthreads();
        }
    }
}
__device__ __forceinline__ void p1_h(const Params& p, const Bufs& B) {
    const int tid = threadIdx.x, lane = tid & 63, wave = tid >> 6, G = gridDim.x;
    const float* x = p.in[0]; const float* ng = p.in[2];
    for (int row = blockIdx.x * NWAVES + wave; row < MROWS; row += G * NWAVES) {
        const int b = row >> 11; const float* xr = x + (size_t)row * DM; f32x4 v[4]; float ss = 0.f;
#pragma unroll
        for (int i = 0; i < 4; ++i) { v[i] = *(const f32x4*)(xr + 4 * lane + 256 * i); ss += v[i][0] * v[i][0] + v[i][1] * v[i][1] + v[i][2] * v[i][2] + v[i][3] * v[i][3]; }
        ss = wave_sum(ss);
        const float r = rsqrtf(ss * (1.f / DM) + 1e-6f);
#pragma unroll
        for (int i = 0; i < 4; ++i) { const int col = 4 * lane + 256 * i;
            const f32x4 g = *(const f32x4*)(ng + col), sc = *(const f32x4*)(B.MOD + b * 3072 + 1024 + col), sh = *(const f32x4*)(B.MOD + b * 3072 + col);
            const f32x4 y = (v[i] * r * g) * (sc + 1.0f) + sh;
            u32x2 w; w.x = cvt_pk_bf16(y[0], y[1]); w.y = cvt_pk_bf16(y[2], y[3]);
            *(u32x2*)(B.H + (size_t)row * DM + col) = w; }
    }
}
__device__ __forceinline__ void p8_final(const Params& p, const Bufs& B) {
    const int tid = threadIdx.x, lane = tid & 63, wave = tid >> 6, G = gridDim.x;
    const float* fg = p.in[17];
    for (int row = blockIdx.x * NWAVES + wave; row < MROWS; row += G * NWAVES) {
        const float* xr = B.XNEW + (size_t)row * DM; f32x4 v[4]; float ss = 0.f;
#pragma unroll
        for (int i = 0; i < 4; ++i) { v[i] = *(const f32x4*)(xr + 4 * lane + 256 * i); ss += v[i][0] * v[i][0] + v[i][1] * v[i][1] + v[i][2] * v[i][2] + v[i][3] * v[i][3]; }
        ss = wave_sum(ss);
        const float r = rsqrtf(ss * (1.f / DM) + 1e-6f);
#pragma unroll
        for (int i = 0; i < 4; ++i) { const int col = 4 * lane + 256 * i; const f32x4 g = *(const f32x4*)(fg + col); *(f32x4*)(p.out + (size_t)row * DM + col) = v[i] * r * g; }
    }
}


typedef float f32x16 __attribute__((ext_vector_type(16)));
#define MFMA32(a, b, c) __builtin_amdgcn_mfma_f32_32x32x16_bf16((a), (b), (c), 0, 0, 0)
__device__ __forceinline__ int crow(int reg, int h) { return (reg & 3) + 8 * (reg >> 2) + 4 * h; }
constexpr int G1_ROWB = 272, G1_IMG = 64 * G1_ROWB, G1_WAVE = G1_IMG + 2048;

template <int MODE>
__device__ __forceinline__ void g1_conv(const bf16_t* __restrict__ X, const bf16_t* __restrict__ stash  , const float* __restrict__ cw  ,
                                        LAS unsigned char* img, int b, int n, int h, int lane) {
    const int col = h * 128 + 2 * lane; const unsigned row0 = (unsigned)(b * NT + n * 64);
    const __amdgpu_buffer_rsrc_t rs = __builtin_amdgcn_make_buffer_rsrc((void*)X, 0, MROWS * 1024 * 2, 0x00020000);
    const unsigned voff = (unsigned)col * 2u;
    float w[4][2];
#pragma unroll
    for (int j = 0; j < 4; ++j) { w[j][0] = cw[j * 3072 + col]; w[j][1] = cw[j * 3072 + col + 1]; }
    float h0[2] = {0.f, 0.f}, h1[2] = {0.f, 0.f}, h2[2] = {0.f, 0.f};
    if (n > 0) {
        const bf16_t* sp = stash + ((size_t)(b * 32 + n - 1) * 3) * 1024 + col;
        const unsigned a0 = *(const unsigned*)(sp), a1 = *(const unsigned*)(sp + 1024), a2 = *(const unsigned*)(sp + 2048);
        h0[0] = bflo(a0); h0[1] = bfhi(a0); h1[0] = bflo(a1); h1[1] = bfhi(a1); h2[0] = bflo(a2); h2[1] = bfhi(a2);
    }
#pragma unroll 1
    for (int q4 = 0; q4 < 4; ++q4) {
        unsigned raw[16];
        const unsigned rb = (row0 + q4 * 16) * 2048u;
#pragma unroll
        for (int t = 0; t < 16; ++t) raw[t] = __builtin_amdgcn_raw_buffer_load_b32(rs, voff, rb + t * 2048u, 0);
#pragma unroll
        for (int t = 0; t < 16; ++t) {
            const float x0 = bflo(raw[t]), x1 = bfhi(raw[t]);
            const float y0 = silu_f(w[0][0] * h0[0] + w[1][0] * h1[0] + w[2][0] * h2[0] + w[3][0] * x0);
            const float y1 = silu_f(w[0][1] * h0[1] + w[1][1] * h1[1] + w[2][1] * h2[1] + w[3][1] * x1);
            h0[0] = h1[0]; h1[0] = h2[0]; h2[0] = x0; h0[1] = h1[1]; h1[1] = h2[1]; h2[1] = x1;
            const unsigned pk = cvt_pk_bf16(y0, y1);
            if (MODE == 0) *(LAS unsigned*)(img + (q4 * 16 + t) * G1_ROWB + 4 * lane) = pk;
            else __builtin_amdgcn_raw_buffer_store_b32(pk, rs, voff, rb + t * 2048u, 0);
        }
    }
}
__device__ __forceinline__ float g1_diag(const f32x16& g, int r, int hh) {
    float d = 0.f;
#pragma unroll
    for (int reg = 0; reg < 16; ++reg) d = (crow(reg, hh) == r) ? g[reg] : d;
    return d + __shfl_xor(d, 32);
}
__device__ __forceinline__ void g1_store_norm(bf16_t* __restrict__ Xout, const LAS unsigned char* img, const LAS float* scl, float mul, int b, int n, int h, int lane) {
    const size_t row0 = (size_t)b * NT + n * 64;
#pragma unroll 4
    for (int ps = 0; ps < 16; ++ps) {
        const int row = ps * 4 + (lane >> 4), c16 = lane & 15;
        const u32x4 v = *(const LAS u32x4*)(img + row * G1_ROWB + 16 * c16);
        const float s = scl[row] * mul;
        u32x4 o; o.x = cvt_pk_bf16(bflo(v.x) * s, bfhi(v.x) * s); o.y = cvt_pk_bf16(bflo(v.y) * s, bfhi(v.y) * s); o.z = cvt_pk_bf16(bflo(v.z) * s, bfhi(v.z) * s); o.w = cvt_pk_bf16(bflo(v.w) * s, bfhi(v.w) * s);
        *(u32x4*)(Xout + (row0 + row) * 1024 + h * 128 + 8 * c16) = o;
    }
}
__device__ __forceinline__ void g1_phase(const Params& p, LAS unsigned char* lds) {
    const int tid = threadIdx.x, lane0 = tid & 63, h = tid >> 6, G = gridDim.x;
    char* ws = p.ws; char* os = (char*)p.out;
    bf16_t* QA = (bf16_t*)(ws + OFF_QA); bf16_t* KA = (bf16_t*)(ws + OFF_KA); bf16_t* VA = (bf16_t*)(ws + OFF_VA);
    const float* SMALL = (const float*)(ws + OFF_SMALL);
    const bf16_t* STASH = (const bf16_t*)(os + OO_STASH);
    const float* conv_w = p.in[6];
    LAS unsigned char* img = lds + h * G1_WAVE;
    LAS float* sm = (LAS float*)(img + G1_IMG);
    const float Aexp = __expf(p.in[7][h]), dtb = p.in[8][h];
    for (int unit = blockIdx.x; unit < NB * 32; unit += G) {
        int lane = lane0; asm volatile("" : "+v"(lane));
        const int r = lane & 31, hh = lane >> 5;
        const int b = unit >> 5, n = unit & 31; const size_t row0 = (size_t)b * NT + n * 64;
        const int u = (b * 8 + h) * 32 + n;
        float gi, beta, d;
        {
            const float xg = SMALL[(row0 + lane) * 32 + h] + dtb;
            const float sp = xg > 20.f ? xg : log1pf(__expf(xg));
            gi = -Aexp * sp; beta = sigmoid_f(SMALL[(row0 + lane) * 32 + 8 + h]);
            d = gi;
#pragma unroll
            for (int o = 1; o < 64; o <<= 1) { const float v = __shfl_up(d, o); if (lane >= o) d += v; }
            const float dl = __shfl(d, 63);
            float* dec = (float*)(os + OO_DEC) + (size_t)u * 256;
            dec[lane] = __expf(d); dec[64 + lane] = __expf(dl - d); dec[128 + lane] = gi; dec[192 + lane] = beta;
            sm[128 + lane] = d; sm[192 + lane] = beta;
        }
        g1_conv<0>(KA, STASH + (size_t)1 * 256 * 3 * 1024, conv_w + 1024, img, b, n, h, lane);
        __syncthreads();
        f32x16 g00, g10, g11;
#pragma unroll
        for (int i = 0; i < 16; ++i) { g00[i] = 0.f; g10[i] = 0.f; g11[i] = 0.f; }
#pragma unroll 2
        for (int s = 0; s < 8; ++s) {
            const bf16x8 k0 = *(const LAS bf16x8*)(img + (r) * G1_ROWB + (16 * s + 8 * hh) * 2), k1 = *(const LAS bf16x8*)(img + (32 + r) * G1_ROWB + (16 * s + 8 * hh) * 2);
            g00 = MFMA32(k0, k0, g00); g10 = MFMA32(k1, k0, g10); g11 = MFMA32(k1, k1, g11);
        }
        {
            const float nlo = rsqrtf(g1_diag(g00, r, hh) + 1e-6f), nhi = rsqrtf(g1_diag(g11, r, hh) + 1e-6f);
            if (hh == 0) { sm[r] = nlo; sm[32 + r] = nhi; }
        }
        __syncthreads();
        g1_store_norm(KA, img, sm, 1.0f, b, n, h, lane);
        asm volatile("s_waitcnt vmcnt(0)" ::: "memory");
        __syncthreads();
        g1_conv<0>(QA, STASH, conv_w, img, b, n, h, lane);
        __syncthreads();
        {
            f32x16 qq0, qq1;
#pragma unroll
            for (int i = 0; i < 16; ++i) { qq0[i] = 0.f; qq1[i] = 0.f; }
#pragma unroll 2
            for (int s = 0; s < 8; ++s) {
                const bf16x8 qa = *(const LAS bf16x8*)(img + (r) * G1_ROWB + (16 * s + 8 * hh) * 2), qb = *(const LAS bf16x8*)(img + (32 + r) * G1_ROWB + (16 * s + 8 * hh) * 2);
                qq0 = MFMA32(qa, qa, qq0); qq1 = MFMA32(qb, qb, qq1);
            }
            const float nlo = rsqrtf(g1_diag(qq0, r, hh) + 1e-6f), nhi = rsqrtf(g1_diag(qq1, r, hh) + 1e-6f);
            if (hh == 0) { sm[64 + r] = nlo; sm[96 + r] = nhi; }
        }
        f32x16 q00, q10, q11;
#pragma unroll
        for (int i = 0; i < 16; ++i) { q00[i] = 0.f; q10[i] = 0.f; q11[i] = 0.f; }
#pragma unroll 1
        for (int s4 = 0; s4 < 2; ++s4) {
            bf16x8 kf0[4], kf1[4];
#pragma unroll
            for (int s = 0; s < 4; ++s) {
                kf0[s] = *(const bf16x8*)(KA + (row0 + r) * 1024 + h * 128 + 16 * (4 * s4 + s) + 8 * hh);
                kf1[s] = *(const bf16x8*)(KA + (row0 + 32 + r) * 1024 + h * 128 + 16 * (4 * s4 + s) + 8 * hh);
            }
#pragma unroll
            for (int s = 0; s < 4; ++s) {
                const bf16x8 qa = *(const LAS bf16x8*)(img + (r) * G1_ROWB + (16 * (4 * s4 + s) + 8 * hh) * 2), qb = *(const LAS bf16x8*)(img + (32 + r) * G1_ROWB + (16 * (4 * s4 + s) + 8 * hh) * 2);
                q00 = MFMA32(qa, kf0[s], q00); q10 = MFMA32(qb, kf0[s], q10); q11 = MFMA32(qb, kf1[s], q11);
            }
        }
        __syncthreads();
        g1_store_norm(QA, img, sm + 64, 0.08838834764831845f, b, n, h, lane);
        __syncthreads();
        g1_conv<1>(VA, STASH + (size_t)2 * 256 * 3 * 1024, conv_w + 2048, img, b, n, h, lane);
        bf16_t* tp = (bf16_t*)(os + OO_TPATT + (size_t)u * 12288);
        LAS float* Am = (LAS float*)img;
#pragma unroll
        for (int blk = 0; blk < 3; ++blk) {
            __builtin_amdgcn_sched_barrier(0);
            const int bi = (blk == 0) ? 0 : 1, bj = (blk == 2) ? 1 : 0;
            const f32x16& gk = (blk == 0) ? g00 : (blk == 1) ? g10 : g11;
            const f32x16& gq = (blk == 0) ? q00 : (blk == 1) ? q10 : q11;
            const int j = 32 * bj + r; const float nkj = sm[j], dj = sm[128 + j];
#pragma unroll
            for (int g4 = 0; g4 < 4; ++g4) {
                const int ib = 32 * bi + 8 * g4 + 4 * hh;
                const f32x4 nki = *(const LAS f32x4*)(sm + ib), nqi = *(const LAS f32x4*)(sm + 64 + ib), di = *(const LAS f32x4*)(sm + 128 + ib), bti = *(const LAS f32x4*)(sm + 192 + ib);
#pragma unroll
                for (int e = 0; e < 4; ++e) {
                    const int i = ib + e, reg = 4 * g4 + e;
                    const float gam = __expf(di[e] - dj);
                    const float av = (i > j) ? gk[reg] * nki[e] * nkj * bti[e] * gam : 0.f;
                    const float tv = (i >= j) ? gq[reg] * (nqi[e] * 0.08838834764831845f) * gam : 0.f;
                    Am[i * 64 + j] = av;
                    if (blk == 0) Am[i * 64 + 32 + j] = 0.f;
                    tp[(3 + blk) * 1024 + (i & 31) * 32 + r] = f2bf(tv);
                }
            }
        }
        __syncthreads();
        for (int i = 0; i < 64; ++i) {
            float t0 = (lane == i) ? 1.f : 0.f, t1 = 0.f;
            for (int j4 = 0; j4 < i; j4 += 4) {
                const f32x4 a = *(const LAS f32x4*)(Am + i * 64 + j4);
                t0 -= a[0] * Am[(j4 + 0) * 64 + lane]; t1 -= a[1] * Am[(j4 + 1) * 64 + lane];
                t0 -= a[2] * Am[(j4 + 2) * 64 + lane]; t1 -= a[3] * Am[(j4 + 3) * 64 + lane];
            }
            Am[i * 64 + lane] = t0 + t1;
        }
        for (int i = 0; i < 64; ++i) {
            const bf16_t v = f2bf(Am[i * 64 + lane] * beta);
            if (i < 32) { if (lane < 32) tp[0 * 1024 + i * 32 + lane] = v; }
            else { tp[(lane < 32 ? 1 : 2) * 1024 + (i - 32) * 32 + (lane & 31)] = v; }
        }
        __syncthreads();
    }
}


typedef short s16x4 __attribute__((ext_vector_type(4)));
typedef __bf16 bf16x8_t __attribute__((ext_vector_type(8)));
typedef float f32x8 __attribute__((ext_vector_type(8)));
constexpr int G2_RB = 264, G2_IMG = 64 * G2_RB, G2_BRB = 72, G2_BLK = 32 * G2_BRB;
constexpr int G2_K = 0, G2_Q = G2_IMG, G2_V = 2 * G2_IMG, G2_TP = 3 * G2_IMG, G2_AT = G2_TP + 3 * G2_BLK, G2_DE = G2_AT + 3 * G2_BLK, G2_CB = G2_DE + 512;
constexpr int G2_OB = 2 * G2_CB, G2_OBSZ = 64 * 256;
static_assert(G2_CB % 16 == 0 && G2_OB + 2 * G2_OBSZ <= LDSCTL_OFF, "GDN scan LDS map");
__device__ __forceinline__ bf16x8 pack_step(const f32x16& x, const int s) {
    f32x8 v;
#pragma unroll
    for (int j = 0; j < 8; ++j) v[j] = x[8 * s + j];
    return __builtin_bit_cast(bf16x8, __builtin_convertvector(v, bf16x8_t));
}
__device__ __forceinline__ bf16x8 perm_frag(const LAS unsigned char* img, const int rowb, const int row, const int kc, const int hh) {
    const s16x4 lo = *(const LAS s16x4*)(img + row * rowb + (kc + 4 * hh) * 2), hi = *(const LAS s16x4*)(img + row * rowb + (kc + 8 + 4 * hh) * 2);
    return __builtin_shufflevector(lo, hi, 0, 1, 2, 3, 4, 5, 6, 7);
}
__device__ __forceinline__ s16x4 tr4(const LAS unsigned char* img, const int rowb, const int row0, const int c0, const int lane) {
    const int q = (lane & 15) >> 2, pq = lane & 3, blk = (lane >> 4) & 1;
    return __builtin_amdgcn_ds_read_tr16_b64_v4i16((LAS s16x4*)(img + (row0 + q) * rowb + (c0 + 16 * blk + 4 * pq) * 2));
}
__device__ __forceinline__ void g2_load_chunk(const Params& p, LAS unsigned char* cb, const int b, const int h, const int n, const int lt) {
    char* ws = p.ws; const char* os = (const char*)p.out;
    const size_t row0 = (size_t)b * NT + n * 64; const int u = (b * 8 + h) * 32 + n;
    u32x4 v[16];
#pragma unroll
    for (int t3 = 0; t3 < 3; ++t3) {
        const bf16_t* X = (const bf16_t*)(ws + OFF_QA + (size_t)(t3 == 0 ? 1 : t3 == 1 ? 0 : 2) * (32 * MiB));
#pragma unroll
        for (int k = 0; k < 4; ++k) { const int pi = lt + 256 * k, row = pi >> 4, c16 = pi & 15; v[t3 * 4 + k] = *(const u32x4*)(X + (row0 + row) * 1024 + h * 128 + 8 * c16); }
    }
    const u32x4* tpg = (const u32x4*)(os + OO_TPATT + (size_t)u * 12288);
#pragma unroll
    for (int k = 0; k < 3; ++k) v[12 + k] = tpg[lt + 256 * k];
    if (lt < 32) v[15] = ((const u32x4*)(os + OO_DEC + (size_t)u * 1024))[lt];
#pragma unroll
    for (int t3 = 0; t3 < 3; ++t3)
#pragma unroll
        for (int k = 0; k < 4; ++k) { const int pi = lt + 256 * k, row = pi >> 4, c16 = pi & 15; LAS u32x2* d = (LAS u32x2*)(cb + t3 * G2_IMG + row * G2_RB + 16 * c16);
            d[0] = (u32x2){v[t3 * 4 + k].x, v[t3 * 4 + k].y}; d[1] = (u32x2){v[t3 * 4 + k].z, v[t3 * 4 + k].w}; }
#pragma unroll
    for (int k = 0; k < 3; ++k) { const int pi = lt + 256 * k, blk = pi >> 7, row = (pi & 127) >> 2, c16 = pi & 3; LAS u32x2* d = (LAS u32x2*)(cb + G2_TP + blk * G2_BLK + row * G2_BRB + 16 * c16);
        d[0] = (u32x2){v[12 + k].x, v[12 + k].y}; d[1] = (u32x2){v[12 + k].z, v[12 + k].w}; }
    if (lt < 32) *(LAS u32x4*)(cb + G2_DE + 16 * lt) = v[15];
}
__device__ __forceinline__ void g2_epilogue(const Params& p, const LAS unsigned char* ob, const int b, const int h, const int n, const int lw  , const int lane) {
    bf16_t* ZA = (bf16_t*)(p.ws + OFF_ZA); const float* gg = p.in[9];
    const float g0 = gg[2 * lane], g1 = gg[2 * lane + 1];
    const size_t row0 = (size_t)b * NT + n * 64;
#pragma unroll 4
    for (int rr = 0; rr < 16; ++rr) {
        const int t = lw * 16 + rr;
        const unsigned w = *(const LAS unsigned*)(ob + t * 256 + 4 * lane);
        const float o0 = bflo(w), o1 = bfhi(w);
        const float ss = wave_sum(o0 * o0 + o1 * o1);
        const float rs = rsqrtf(ss * (1.f / 128.f) + 1e-6f);
        unsigned* zp = (unsigned*)(ZA + (row0 + t) * 1024 + h * 128 + 2 * lane);
        const unsigned z = *zp;
        *zp = cvt_pk_bf16(o0 * rs * g0 * silu_f(bflo(z)), o1 * rs * g1 * silu_f(bfhi(z)));
    }
}
__device__ __forceinline__ void g2_phase(const Params& p, LAS unsigned char* lds) {
    const int tid = threadIdx.x, wave = __builtin_amdgcn_readfirstlane(tid >> 6), G = gridDim.x;
    for (int bh = blockIdx.x; bh < NB * 8; bh += G) {
        int lane = tid & 63; asm volatile("" : "+v"(lane));
        const int r = lane & 31, hh = lane >> 5, b = bh >> 3, h = bh & 7;
        f32x16 S[4];
#pragma unroll
        for (int i = 0; i < 4; ++i)
#pragma unroll
            for (int e = 0; e < 16; ++e) S[i][e] = 0.f;
        if (wave >= 4) g2_load_chunk(p, lds, b, h, 0, tid - 256);
        __syncthreads();
#pragma unroll 1
        for (int n = 0; n < 32; ++n) {
            LAS unsigned char* cb = lds + (n & 1) * G2_CB;
            if (wave < 4) {
                const int j = wave;
                const LAS unsigned char* KI = cb + G2_K; const LAS unsigned char* QI = cb + G2_Q; const LAS unsigned char* VI = cb + G2_V;
                const LAS float* ED = (const LAS float*)(cb + G2_DE); const LAS float* EDL = ED + 64;
                f32x16 ks[2], qs[2];
#pragma unroll
                for (int tb = 0; tb < 2; ++tb)
#pragma unroll
                    for (int e = 0; e < 16; ++e) { ks[tb][e] = 0.f; qs[tb][e] = 0.f; }
#pragma unroll
                for (int i = 0; i < 4; ++i)
#pragma unroll
                    for (int s = 0; s < 2; ++s) {
                        const bf16x8 xs = pack_step(S[i], s);
#pragma unroll
                        for (int tb = 0; tb < 2; ++tb) {
                            ks[tb] = MFMA32(perm_frag(KI, G2_RB, 32 * tb + r, 32 * i + 16 * s, hh), xs, ks[tb]);
                            qs[tb] = MFMA32(perm_frag(QI, G2_RB, 32 * tb + r, 32 * i + 16 * s, hh), xs, qs[tb]);
                        }
                    }
                f32x16 R[2], O[2];
#pragma unroll
                for (int tb = 0; tb < 2; ++tb)
#pragma unroll
                    for (int g4 = 0; g4 < 4; ++g4) {
                        const int t0 = 32 * tb + 8 * g4 + 4 * hh;
                        const s16x4 vv = tr4(VI, G2_RB, t0, 32 * j, lane);
                        const f32x4 ed = *(const LAS f32x4*)(ED + t0);
#pragma unroll
                        for (int e = 0; e < 4; ++e) { R[tb][4 * g4 + e] = bf2f((bf16_t)vv[e]) - ed[e] * ks[tb][4 * g4 + e]; O[tb][4 * g4 + e] = ed[e] * qs[tb][4 * g4 + e]; }
                    }
                f32x16 vn[2];
#pragma unroll
                for (int e = 0; e < 16; ++e) { vn[0][e] = 0.f; vn[1][e] = 0.f; }
#pragma unroll
                for (int s = 0; s < 2; ++s) {
                    const bf16x8 x0 = pack_step(R[0], s), x1 = pack_step(R[1], s);
                    vn[0] = MFMA32(perm_frag(cb + G2_TP + 0 * G2_BLK, G2_BRB, r, 16 * s, hh), x0, vn[0]);
                    vn[1] = MFMA32(perm_frag(cb + G2_TP + 1 * G2_BLK, G2_BRB, r, 16 * s, hh), x0, vn[1]);
                    vn[1] = MFMA32(perm_frag(cb + G2_TP + 2 * G2_BLK, G2_BRB, r, 16 * s, hh), x1, vn[1]);
                }
                f32x16 vs[2];
#pragma unroll
                for (int tb = 0; tb < 2; ++tb)
#pragma unroll
                    for (int g4 = 0; g4 < 4; ++g4) {
                        const f32x4 el = *(const LAS f32x4*)(EDL + 32 * tb + 8 * g4 + 4 * hh);
#pragma unroll
                        for (int e = 0; e < 4; ++e) vs[tb][4 * g4 + e] = el[e] * vn[tb][4 * g4 + e];
                    }
#pragma unroll
                for (int s = 0; s < 2; ++s) {
                    const bf16x8 x0 = pack_step(vn[0], s), x1 = pack_step(vn[1], s);
                    O[0] = MFMA32(perm_frag(cb + G2_AT + 0 * G2_BLK, G2_BRB, r, 16 * s, hh), x0, O[0]);
                    O[1] = MFMA32(perm_frag(cb + G2_AT + 1 * G2_BLK, G2_BRB, r, 16 * s, hh), x0, O[1]);
                    O[1] = MFMA32(perm_frag(cb + G2_AT + 2 * G2_BLK, G2_BRB, r, 16 * s, hh), x1, O[1]);
                }
                const float edl_all = ED[63];
#pragma unroll
                for (int i = 0; i < 4; ++i) {
#pragma unroll
                    for (int e = 0; e < 16; ++e) S[i][e] *= edl_all;
#pragma unroll
                    for (int tb = 0; tb < 2; ++tb)
#pragma unroll
                        for (int s = 0; s < 2; ++s) {
                            const int t0 = 32 * tb + 16 * s + 4 * hh;
                            const s16x4 lo = tr4(KI, G2_RB, t0, 32 * i, lane), hi = tr4(KI, G2_RB, t0 + 8, 32 * i, lane);
                            const bf16x8 a = __builtin_shufflevector(lo, hi, 0, 1, 2, 3, 4, 5, 6, 7);
                            S[i] = MFMA32(a, pack_step(vs[tb], s), S[i]);
                        }
                }
                LAS unsigned char* ob = lds + G2_OB + (n & 1) * G2_OBSZ;
#pragma unroll
                for (int tb = 0; tb < 2; ++tb)
#pragma unroll
                    for (int e = 0; e < 16; ++e) *(LAS bf16_t*)(ob + (32 * tb + crow(e, hh)) * 256 + (32 * j + r) * 2) = f2bf(O[tb][e]);
            } else {
                const int lt = tid - 256;
                if (n + 1 < 32) g2_load_chunk(p, lds + ((n + 1) & 1) * G2_CB, b, h, n + 1, lt);
                if (n > 0) g2_epilogue(p, lds + G2_OB + ((n - 1) & 1) * G2_OBSZ, b, h, n - 1, wave - 4, lane);
            }
            __syncthreads();
        }
        if (wave >= 4) g2_epilogue(p, lds + G2_OB + 1 * G2_OBSZ, b, h, 31, wave - 4, lane);
        __syncthreads();
    }
}

__device__ const unsigned char T5_BUCKET[128] = {
    0, 1, 2, 3, 4, 5, 6, 7, 8, 9, 10, 11, 12, 13, 14, 15, 16, 16, 16, 17, 17, 18, 18, 18, 19, 19, 19, 20, 20, 20, 20, 21,
    21, 21, 21, 22, 22, 22, 22, 22, 23, 23, 23, 23, 23, 23, 24, 24, 24, 24, 24, 24, 25, 25, 25, 25, 25, 25, 25, 26, 26, 26, 26, 26,
    26, 26, 26, 27, 27, 27, 27, 27, 27, 27, 27, 27, 27, 28, 28, 28, 28, 28, 28, 28, 28, 28, 28, 29, 29, 29, 29, 29, 29, 29, 29, 29,
    29, 29, 29, 30, 30, 30, 30, 30, 30, 30, 30, 30, 30, 30, 30, 30, 30, 31, 31, 31, 31, 31, 31, 31, 31, 31, 31, 31, 31, 31, 31, 31};
__device__ __forceinline__ int t5_bucket(int n) { return n >= 128 ? 31 : (int)T5_BUCKET[n]; }

constexpr size_t OFF_QL = OFF_QA;
typedef unsigned short u16_t;
#define MFMA16(a, b, c) __builtin_amdgcn_mfma_f32_16x16x32_bf16((a), (b), (c), 0, 0, 0)

template <int NTL, int KS>
__device__ __forceinline__ void sg_tile(const bf16_t* __restrict__ A, const int lda, const bf16_t* __restrict__ Bt, const int ldb, f32x16 (&acc)[NTL], const int r, const int hh) {
#pragma unroll 2
    for (int s = 0; s < KS; ++s) {
        const bf16x8 a = *(const bf16x8*)(A + (size_t)r * lda + 16 * s + 8 * hh);
#pragma unroll
        for (int nt = 0; nt < NTL; ++nt) { const bf16x8 bb = *(const bf16x8*)(Bt + (size_t)(32 * nt + r) * ldb + 16 * s + 8 * hh); acc[nt] = MFMA32(a, bb, acc[nt]); }
    }
}
__device__ __forceinline__ void qlat_phase(const Params& p) {
    const int tid = threadIdx.x, wave = tid >> 6, G = gridDim.x, wm = wave & 3, wn = wave >> 2;
    const bf16_t* QB = (const bf16_t*)(p.ws + OFF_QB); const bf16_t* WUK = (const bf16_t*)((const char*)p.out + OO_WUK_B); bf16_t* QL = (bf16_t*)(p.ws + OFF_QL);
    for (int unit = blockIdx.x; unit < 1024; unit += G) {
        int lane = tid & 63; asm volatile("" : "+v"(lane));
        const int r = lane & 31, hh = lane >> 5, h = unit & 7, mt = unit >> 3, m0 = mt * 128 + wm * 32, n0 = wn * 128;
        f32x16 acc[4];
#pragma unroll
        for (int i = 0; i < 4; ++i)
#pragma unroll
            for (int e = 0; e < 16; ++e) acc[i][e] = 0.f;
        sg_tile<4, 8>(QB + (size_t)m0 * 1024 + h * 128, 1024, WUK + (size_t)n0 * 1024 + h * 128, 1024, acc, r, hh);
#pragma unroll
        for (int nt = 0; nt < 4; ++nt)
#pragma unroll
            for (int e = 0; e < 16; ++e) QL[(size_t)(m0 + crow(e, hh)) * 2048 + h * 256 + n0 + 32 * nt + r] = f2bf(acc[nt][e] * 0.08838834764831845f);
    }
}
__device__ __forceinline__ void wuv_phase(const Params& p) {
    const int tid = threadIdx.x, wave = tid >> 6, G = gridDim.x, wm = wave & 3, wn = wave >> 2;
    const bf16_t* OL = (const bf16_t*)(p.ws + OFF_QL); const bf16_t* WUV = (const bf16_t*)((const char*)p.out + OO_WUV_T); bf16_t* OB = (bf16_t*)(p.ws + OFF_QB); const bf16_t* ZB = (const bf16_t*)(p.ws + OFF_ZB);
    for (int unit = blockIdx.x; unit < 1024; unit += G) {
        int lane = tid & 63; asm volatile("" : "+v"(lane));
        const int r = lane & 31, hh = lane >> 5, h = unit & 7, mt = unit >> 3, m0 = mt * 128 + wm * 32, n0 = wn * 64;
        f32x16 acc[2];
#pragma unroll
        for (int i = 0; i < 2; ++i)
#pragma unroll
            for (int e = 0; e < 16; ++e) acc[i][e] = 0.f;
        sg_tile<2, 16>(OL + (size_t)m0 * 2048 + h * 256, 2048, WUV + (size_t)(h * 128 + n0) * 256, 256, acc, r, hh);
#pragma unroll
        for (int nt = 0; nt < 2; ++nt)
#pragma unroll
            for (int e = 0; e < 16; ++e) { const size_t o = (size_t)(m0 + crow(e, hh)) * 1024 + h * 128 + n0 + 32 * nt + r; OB[o] = f2bf(acc[nt][e] * silu_f(bf2f(ZB[o]))); }
    }
}

constexpr int D2_RB = 528, D2_KB = 32 * D2_RB, D2_BIAS = 8 * D2_KB;
static_assert(D2_BIAS + 1024 <= LDSCTL_OFF, "DSA attention LDS map");
__device__ __forceinline__ void d2_phase(const Params& p, LAS unsigned char* lds) {
    const int tid = threadIdx.x, wave = __builtin_amdgcn_readfirstlane(tid >> 6), G = gridDim.x;
    const bf16_t* CKV = (const bf16_t*)(p.ws + OFF_CKV); bf16_t* QL = (bf16_t*)(p.ws + OFF_QL); const u16_t* IDX = (const u16_t*)((const char*)p.out + OO_IDX);
    LAS unsigned char* kb = lds + wave * D2_KB; LAS float* sbias = (LAS float*)(lds + D2_BIAS);
    if (tid < 256) sbias[tid] = p.in[16][tid];
    __syncthreads();
    for (int it = blockIdx.x; it < 2048; it += G) {
        int lane = tid & 63; asm volatile("" : "+v"(lane));
        const int c16 = lane & 15, q = lane >> 4, b = it & 7, c8 = (it >> 3) & 31, kk = it >> 8, t = kk * 256 + c8 * 8 + wave;
        const size_t token = (size_t)b * NT + t;
        const int n_sel = (t + 1 < 256) ? (t + 1) : 256, nch = (n_sel + 31) >> 5;
        bf16x8 bq[8];
#pragma unroll
        for (int s = 0; s < 8; ++s) {
            u32x4 v = (u32x4){0u, 0u, 0u, 0u};
            if (c16 < 8) v = *(const u32x4*)(QL + token * 2048 + c16 * 256 + 32 * s + 8 * q);
            bq[s] = __builtin_bit_cast(bf16x8, v);
        }
        f32x4 O[16];
#pragma unroll
        for (int i = 0; i < 16; ++i) O[i] = (f32x4){0.f, 0.f, 0.f, 0.f};
        float mrun = -1.0e30f, lrun = 0.f;
#pragma unroll 1
        for (int ch = 0; ch < nch; ++ch) {
            int keyreg = 0;
            { const int slot = ch * 32 + (lane & 31); if (slot < n_sel) keyreg = (t < 256) ? slot : (int)IDX[token * 256 + slot]; }
            u32x4 g[16];
#pragma unroll
            for (int i = 0; i < 16; ++i) { const int key = __shfl(keyreg, 2 * i + (lane >> 5)); g[i] = *(const u32x4*)(CKV + ((size_t)b * NT + key) * 256 + 8 * (lane & 31)); }
#pragma unroll
            for (int i = 0; i < 16; ++i) *(LAS u32x4*)(kb + (2 * i + (lane >> 5)) * D2_RB + 16 * (lane & 31)) = g[i];
            f32x4 sc[2];
#pragma unroll
            for (int kt = 0; kt < 2; ++kt) { sc[kt] = (f32x4){0.f, 0.f, 0.f, 0.f};
#pragma unroll
                for (int s = 0; s < 8; ++s) sc[kt] = MFMA16(*(const LAS bf16x8*)(kb + (16 * kt + c16) * D2_RB + (32 * s + 8 * q) * 2), bq[s], sc[kt]); }
            float cmax = -1.0e30f;
#pragma unroll
            for (int kt = 0; kt < 2; ++kt)
#pragma unroll
                for (int e = 0; e < 4; ++e) {
                    const int sl = 16 * kt + 4 * q + e; const int key = __shfl(keyreg, sl);
                    const float bias = sbias[t5_bucket(t - key) * 8 + (c16 & 7)];
                    const float v = (ch * 32 + sl < n_sel) ? sc[kt][e] + bias : -1.0e30f;
                    sc[kt][e] = v; cmax = fmaxf(cmax, v);
                }
            cmax = fmaxf(cmax, __shfl_xor(cmax, 16)); cmax = fmaxf(cmax, __shfl_xor(cmax, 32));
            const float mnew = fmaxf(mrun, cmax), alpha = __expf(mrun - mnew);
            float psum = 0.f;
#pragma unroll
            for (int kt = 0; kt < 2; ++kt)
#pragma unroll
                for (int e = 0; e < 4; ++e) { const float pv = __expf(sc[kt][e] - mnew); sc[kt][e] = pv; psum += pv; }
            lrun = lrun * alpha + psum; mrun = mnew;
            f32x8 pf;
#pragma unroll
            for (int e = 0; e < 4; ++e) { pf[e] = sc[0][e]; pf[4 + e] = sc[1][e]; }
            const bf16x8 pb = __builtin_bit_cast(bf16x8, __builtin_convertvector(pf, bf16x8_t));
#pragma unroll
            for (int mt = 0; mt < 16; ++mt) {
                const s16x4 lo = __builtin_amdgcn_ds_read_tr16_b64_v4i16((LAS s16x4*)(kb + (4 * q + (c16 >> 2)) * D2_RB + (16 * mt + 4 * (lane & 3)) * 2));
                const s16x4 hi = __builtin_amdgcn_ds_read_tr16_b64_v4i16((LAS s16x4*)(kb + (16 + 4 * q + (c16 >> 2)) * D2_RB + (16 * mt + 4 * (lane & 3)) * 2));
                const bf16x8 a = __builtin_shufflevector(lo, hi, 0, 1, 2, 3, 4, 5, 6, 7);
                O[mt] = MFMA16(a, pb, O[mt] * alpha);
            }
        }
        float lt = lrun + __shfl_xor(lrun, 16); lt += __shfl_xor(lt, 32);
        const float inv = 1.f / lt;
        if (c16 < 8) {
#pragma unroll
            for (int mt = 0; mt < 16; ++mt) { u32x2 w; w.x = cvt_pk_bf16(O[mt][0] * inv, O[mt][1] * inv); w.y = cvt_pk_bf16(O[mt][2] * inv, O[mt][3] * inv);
                *(u32x2*)(QL + token * 2048 + c16 * 256 + 16 * mt + 4 * q) = w; }
        }
    }
}

constexpr int D1_SC = 0, D1_WI = 16 * 2048 * 4;
static_assert(D1_WI + 512 <= LDSCTL_OFF, "indexer LDS map");
__device__ __forceinline__ void d1_phase(const Params& p, LAS unsigned char* lds) {
    const int tid = threadIdx.x, wave = __builtin_amdgcn_readfirstlane(tid >> 6), G = gridDim.x;
    const bf16_t* QI = (const bf16_t*)(p.ws + OFF_QI); const bf16_t* KI = (const bf16_t*)(p.ws + OFF_KI); const float* SMALL = (const float*)(p.ws + OFF_SMALL);
    u16_t* IDX = (u16_t*)((char*)p.out + OO_IDX);
    LAS float* sc = (LAS float*)(lds + D1_SC); LAS float* swi = (LAS float*)(lds + D1_WI);
    for (int unit = blockIdx.x; unit < 896; unit += G) {
        int lane = tid & 63; asm volatile("" : "+v"(lane));
        const int r = lane & 31, hh = lane >> 5;
        const int b = unit & 7, t0 = 256 + 16 * (111 - (unit >> 3));
        const size_t tok0 = (size_t)b * NT + t0;
        if (tid < 128) swi[tid] = SMALL[(tok0 + (tid >> 3)) * 32 + 16 + (tid & 7)] * 0.04419417382415922f;
        const int tokr = ((r >> 2) & 1) | ((r >> 4) << 1), headr = (r & 3) | (((r >> 3) & 1) << 2);
        bf16x8 af[4][4];
#pragma unroll
        for (int mt = 0; mt < 4; ++mt)
#pragma unroll
            for (int s = 0; s < 4; ++s) af[mt][s] = *(const bf16x8*)(QI + (tok0 + 4 * mt + tokr) * 512 + headr * 64 + 16 * s + 8 * hh);
        __syncthreads();
        const int ntiles = (t0 + 16 + 31) >> 5;
#pragma unroll 1
        for (int nt = wave; nt < ntiles; nt += NWAVES) {
            const int key = 32 * nt + r;
            bf16x8 bfr[4];
#pragma unroll
            for (int s = 0; s < 4; ++s) bfr[s] = *(const bf16x8*)(KI + ((size_t)b * NT + key) * 64 + 16 * s + 8 * hh);
#pragma unroll
            for (int mt = 0; mt < 4; ++mt) {
                f32x16 acc;
#pragma unroll
                for (int e = 0; e < 16; ++e) acc[e] = 0.f;
#pragma unroll
                for (int s = 0; s < 4; ++s) acc = MFMA32(af[mt][s], bfr[s], acc);
                const int ta = 4 * mt + hh, tb = ta + 2;
                const f32x4 wa0 = *(const LAS f32x4*)(swi + ta * 8), wa1 = *(const LAS f32x4*)(swi + ta * 8 + 4), wb0 = *(const LAS f32x4*)(swi + tb * 8), wb1 = *(const LAS f32x4*)(swi + tb * 8 + 4);
                float s0 = 0.f, s1 = 0.f;
#pragma unroll
                for (int e = 0; e < 4; ++e) { s0 += wa0[e] * fmaxf(acc[e], 0.f); s0 += wa1[e] * fmaxf(acc[4 + e], 0.f); s1 += wb0[e] * fmaxf(acc[8 + e], 0.f); s1 += wb1[e] * fmaxf(acc[12 + e], 0.f); }
                sc[ta * 2048 + key] = s0; sc[tb * 2048 + key] = s1;
            }
        }
        __syncthreads();
#pragma unroll 1
        for (int tt = 0; tt < 2; ++tt) {
            const int ti = 2 * wave + tt, t = t0 + ti;
            unsigned u[32];
#pragma unroll
            for (int i = 0; i < 32; ++i) {
                const int key = lane + 64 * i;
                float x = sc[ti * 2048 + key] + 0.0f;
                unsigned v = __float_as_uint(x); v = (v & 0x80000000u) ? ~v : (v | 0x80000000u);
                u[i] = (key <= t) ? v : 0u;
            }
            unsigned P = 0u; bool exact = false;
#pragma unroll 1
            for (int bit = 31; bit >= 0; --bit) {
                const unsigned cand = P | (1u << bit);
                int cnt = 0;
#pragma unroll
                for (int i = 0; i < 32; ++i) cnt += __popcll(__ballot(u[i] >= cand));
                if (cnt >= 256) { P = cand; if (cnt == 256) { exact = true; break; } }
            }
            u16_t* out = IDX + (tok0 + ti) * 256;
            int pos = 0;
            if (exact) {
#pragma unroll
                for (int i = 0; i < 32; ++i) { const bool sel = u[i] >= P; const unsigned long long m = __ballot(sel);
                    if (sel) out[pos + __builtin_amdgcn_mbcnt_hi((unsigned)(m >> 32), __builtin_amdgcn_mbcnt_lo((unsigned)m, 0u))] = (u16_t)(lane + 64 * i);
                    pos += __popcll(m); }
            } else {
#pragma unroll
                for (int i = 0; i < 32; ++i) { const bool sel = u[i] > P; const unsigned long long m = __ballot(sel);
                    if (sel) out[pos + __builtin_amdgcn_mbcnt_hi((unsigned)(m >> 32), __builtin_amdgcn_mbcnt_lo((unsigned)m, 0u))] = (u16_t)(lane + 64 * i);
                    pos += __popcll(m); }
                int need = 256 - pos;
#pragma unroll
                for (int i = 0; i < 32; ++i) { const bool eq = u[i] == P; const unsigned long long m = __ballot(eq);
                    const int rk = __builtin_amdgcn_mbcnt_hi((unsigned)(m >> 32), __builtin_amdgcn_mbcnt_lo((unsigned)m, 0u));
                    if (eq && rk < need) out[pos + rk] = (u16_t)(lane + 64 * i);
                    const int c = __popcll(m), take = c < need ? c : need; pos += take; need -= take; }
            }
        }
        __syncthreads();
    }
}
__device__ __forceinline__ void ckvnorm_phase(const Params& p) {
    const int tid = threadIdx.x, lane = tid & 63, wave = tid >> 6, G = gridDim.x;
    bf16_t* CKV = (bf16_t*)(p.ws + OFF_CKV); const float* g = p.in[11];
    const f32x4 gv = *(const f32x4*)(g + 4 * lane);
    for (int row = blockIdx.x * NWAVES + wave; row < MROWS; row += G * NWAVES) {
        u32x2* rp = (u32x2*)(CKV + (size_t)row * 256 + 4 * lane);
        const u32x2 w = *rp; const float v0 = bflo(w.x), v1 = bfhi(w.x), v2 = bflo(w.y), v3 = bfhi(w.y);
        const float ss = wave_sum(v0 * v0 + v1 * v1 + v2 * v2 + v3 * v3);
        const float rs = rsqrtf(ss * (1.f / 256.f) + 1e-6f);
        u32x2 o; o.x = cvt_pk_bf16(v0 * rs * gv[0], v1 * rs * gv[1]); o.y = cvt_pk_bf16(v2 * rs * gv[2], v3 * rs * gv[3]);
        *rp = o;
    }
}
__device__ __forceinline__ void topk_naive_phase(const Params& p, LAS unsigned char* lds) {
    const int tid = threadIdx.x, G = gridDim.x;
    const bf16_t* QI = (const bf16_t*)(p.ws + OFF_QI); const bf16_t* KI = (const bf16_t*)(p.ws + OFF_KI); const float* SMALL = (const float*)(p.ws + OFF_SMALL);
    u16_t* IDX = (u16_t*)((char*)p.out + OO_IDX);
    LAS float* s_score = (LAS float*)lds; LAS float* s_qi = s_score + 2048; LAS float* s_wi = s_qi + 512; LAS int* s_cnt = (LAS int*)(s_wi + 8);
    for (int row = blockIdx.x; row < MROWS; row += G) {
        const int b = row >> 11, t = row & 2047;
        if (t < 256) continue;
        for (int i = tid; i < 512; i += NTHR) s_qi[i] = bf2f(QI[(size_t)row * 512 + i]);
        if (tid < 8) s_wi[tid] = SMALL[(size_t)row * 32 + 16 + tid] * 0.04419417382415922f;
        if (tid == 0) *s_cnt = 0;
        __syncthreads();
        const int nvalid = t + 1;
        for (int s = tid; s < nvalid; s += NTHR) {
            const bf16_t* kr = KI + ((size_t)b * NT + s) * 64;
            float acc[8];
#pragma unroll
            for (int hh = 0; hh < 8; ++hh) acc[hh] = 0.f;
            for (int d = 0; d < 64; ++d) { const float kd = bf2f(kr[d]);
#pragma unroll
                for (int hh = 0; hh < 8; ++hh) acc[hh] += s_qi[hh * 64 + d] * kd; }
            float sc = 0.f;
#pragma unroll
            for (int hh = 0; hh < 8; ++hh) sc += s_wi[hh] * fmaxf(acc[hh], 0.f);
            s_score[s] = sc;
        }
        __syncthreads();
        for (int s = tid; s < nvalid; s += NTHR) {
            const float v = s_score[s]; int rank = 0;
            for (int s2 = 0; s2 < nvalid; ++s2) { const float v2 = s_score[s2]; rank += (v2 > v || (v2 == v && s2 < s)) ? 1 : 0; }
            if (rank < 256) { const int pos = atomicAdd((int*)s_cnt, 1); IDX[(size_t)row * 256 + pos] = (u16_t)s; }
        }
        __syncthreads();
    }
}

__global__ void __launch_bounds__(NTHR, 2) fwd(Params p) {
    extern __shared__ __attribute__((aligned(16))) unsigned char lds_raw[];
    LAS unsigned char* lds = (LAS unsigned char*)lds_raw;
    const int tid = threadIdx.x;
    for (int u = tid; u < (LDS_BYTES - LDSCTL_OFF) / 4; u += NTHR) ((LAS unsigned*)(lds + LDSCTL_OFF))[u] = 0u;
    __syncthreads();
    const Bufs B = make_bufs(p.ws, (char*)p.out);
    const int lo = p.ph_lo, hi = p.ph_hi;
    unsigned* barw = (unsigned*)(p.ws + OFF_CTL) + CW_BAR + p.li * XCD_BAR_WORDS;
    XcdBarrier bar; bar.bar = barw; bar.x = 0; bar.st = nullptr;
    if (hi - lo > 1) bar = xcd_barrier_post(barw, (volatile LAS unsigned*)(lds + LDSCTL_OFF + 64));
#define IN(k) (lo <= (k) && (k) < hi)
#define SEAM(k) do { if (IN(k) && IN((k) + 1)) xcd_barrier(bar); } while (0)
    if (IN(0)) { p0_prologue(p, B, lds); SEAM(0); }
    if (IN(1)) { p1_h(p, B); SEAM(1); }
    if (IN(2)) {
        SchedProj S; S.so.init(MROWS, NPAD, gridDim.x, blockIdx.x); S.A = (const char*)B.H; S.Bt = (const char*)B.WT;
        EpiProj E{p.ws, (char*)p.out};
        pg8::gemm_phase<EpiProj, SchedProj, true, true>(lds + RING_OFF, DM, DM, DM, S, E);
        SEAM(2);
    }
    if (IN(3)) { g1_phase(p, lds); ckvnorm_phase(p); d1_phase(p, lds); SEAM(3); }
    if (IN(4)) { g2_phase(p, lds); SEAM(4); }
    if (IN(5)) { qlat_phase(p); SEAM(5); }
    if (IN(6)) { d2_phase(p, lds); SEAM(6); }
    if (IN(7)) { wuv_phase(p); SEAM(7); }
    if (IN(8)) {
        SchedMerge S; S.so.init(MROWS, DM, gridDim.x, blockIdx.x); S.ws = p.ws; S.os = (const char*)p.out;
        EpiMerge E{B.MERGED, B.PARK};
        pg8::gemm_phase<EpiMerge, SchedMerge, true, true>(lds + RING_OFF, DM, DM, DM, S, E);
        SEAM(8);
    }
    if (IN(9)) {
        SchedProj S; S.so.init(MROWS, DM, gridDim.x, blockIdx.x); S.A = (const char*)B.MERGED; S.Bt = (const char*)B.WOUT_T;
        EpiOut E{p.in[0], B.MOD, B.XNEW};
        pg8::gemm_phase<EpiOut, SchedProj, true, true>(lds + RING_OFF, DM, DM, DM, S, E);
        SEAM(9);
    }
    if (IN(10)) { p8_final(p, B); }
#undef IN
#undef SEAM
}

__global__ void k_ckvnorm(bf16_t* __restrict__ CKV, const float* __restrict__ g) {
    const int row = blockIdx.x * 4 + (threadIdx.x >> 6), lane = threadIdx.x & 63;
    bf16_t* r = CKV + (size_t)row * 256; float v[4]; float ss = 0.f;
#pragma unroll
    for (int i = 0; i < 4; ++i) { v[i] = bf2f(r[lane + 64 * i]); ss += v[i] * v[i]; }
    ss = wave_sum(ss);
    const float rs = rsqrtf(ss * (1.f / 256.f) + 1e-6f);
#pragma unroll
    for (int i = 0; i < 4; ++i) r[lane + 64 * i] = f2bf(v[i] * rs * g[lane + 64 * i]);
}

__global__ void __launch_bounds__(256) k_gdn_naive(Bufs B, const float* __restrict__ conv_w, const float* __restrict__ a_log, const float* __restrict__ dt_bias,
                                                   const float* __restrict__ gdn_norm_g) {
    const int b = blockIdx.x >> 3, h = blockIdx.x & 7, tid = threadIdx.x, dv = tid & 127, half = tid >> 7, wv = tid >> 6;
    __shared__ float sq[128], sk[128], sv[128], part[2][128], part2[2][128], sred[4], sred2[2];
    float S[64];
#pragma unroll
    for (int i = 0; i < 64; ++i) S[i] = 0.f;
    const int ch0 = (half == 0 ? 0 : 1024) + h * 128 + dv, ch1 = 2048 + h * 128 + dv;
    float w0[4], w1[4];
#pragma unroll
    for (int j = 0; j < 4; ++j) { w0[j] = conv_w[j * 3072 + ch0]; w1[j] = conv_w[j * 3072 + ch1]; }
    float h0a = 0.f, h0b = 0.f, h0c = 0.f, h1a = 0.f, h1b = 0.f, h1c = 0.f;
    const float Aexp = __expf(a_log[h]), dtb = dt_bias[h], gn = gdn_norm_g[dv];
    const bf16_t* src0 = (half == 0 ? B.QA : B.KA);
    for (int t = 0; t < NT; ++t) {
        const size_t row = (size_t)b * NT + t;
        const float raw0 = bf2f(src0[row * 1024 + h * 128 + dv]);
        const float y0 = silu_f(w0[0] * h0a + w0[1] * h0b + w0[2] * h0c + w0[3] * raw0);
        h0a = h0b; h0b = h0c; h0c = raw0;
        if (half == 0) {
            const float raw1 = bf2f(B.VA[row * 1024 + h * 128 + dv]);
            const float y1 = silu_f(w1[0] * h1a + w1[1] * h1b + w1[2] * h1c + w1[3] * raw1);
            h1a = h1b; h1b = h1c; h1c = raw1;
            sq[dv] = y0; sv[dv] = y1;
        } else sk[dv] = y0;
        const float s2 = wave_sum(y0 * y0);
        if ((tid & 63) == 0) sred[wv] = s2;
        __syncthreads();
        const float qn = rsqrtf(sred[0] + sred[1] + 1e-6f) * 0.08838834764831845f, kn = rsqrtf(sred[2] + sred[3] + 1e-6f);
        const float beta = sigmoid_f(B.SMALL[row * 32 + 8 + h]);
        const float xg = B.SMALL[row * 32 + h] + dtb;
        const float sp = xg > 20.f ? xg : log1pf(__expf(xg));
        const float a = __expf(-Aexp * sp);
        float p = 0.f;
#pragma unroll
        for (int i = 0; i < 64; ++i) p += sk[half * 64 + i] * S[i];
        part[half][dv] = p * kn;
        __syncthreads();
        const float kS = part[0][dv] + part[1][dv];
        const float vnew = beta * (sv[dv] - a * kS);
        float o = 0.f;
#pragma unroll
        for (int i = 0; i < 64; ++i) { S[i] = a * S[i] + (sk[half * 64 + i] * kn) * vnew; o += sq[half * 64 + i] * S[i]; }
        part2[half][dv] = o * qn;
        __syncthreads();
        float ov = 0.f;
        if (half == 0) {
            ov = part2[0][dv] + part2[1][dv];
            const float o2 = wave_sum(ov * ov);
            if ((tid & 63) == 0) sred2[wv] = o2;
        }
        __syncthreads();
        if (half == 0) {
            const float rs = rsqrtf((sred2[0] + sred2[1]) * (1.f / 128.f) + 1e-6f);
            const size_t zi = row * 1024 + h * 128 + dv;
            const float z = bf2f(B.ZA[zi]);
            B.ZA[zi] = f2bf(ov * rs * gn * silu_f(z));
        }
    }
}


__global__ void __launch_bounds__(256) k_gdn_naive2(Bufs B, const float* __restrict__ DEC, const float* __restrict__ gdn_norm_g) {
    const int b = blockIdx.x >> 3, h = blockIdx.x & 7, tid = threadIdx.x, dv = tid & 127, half = tid >> 7, wv = tid >> 6;
    __shared__ float sq[128], sk[128], sv[128], part[2][128], part2[2][128], sred2[2];
    float S[64];
#pragma unroll
    for (int i = 0; i < 64; ++i) S[i] = 0.f;
    const float gn = gdn_norm_g[dv];
    for (int t = 0; t < NT; ++t) {
        const size_t row = (size_t)b * NT + t;
        if (half == 0) { sq[dv] = bf2f(B.QA[row * 1024 + h * 128 + dv]); sv[dv] = bf2f(B.VA[row * 1024 + h * 128 + dv]); }
        else sk[dv] = bf2f(B.KA[row * 1024 + h * 128 + dv]);
        const float* dec = DEC + (size_t)((b * 8 + h) * 32 + (t >> 6)) * 256;
        const float a = __expf(dec[128 + (t & 63)]), beta = dec[192 + (t & 63)];
        __syncthreads();
        float pp = 0.f;
#pragma unroll
        for (int i = 0; i < 64; ++i) pp += sk[half * 64 + i] * S[i];
        part[half][dv] = pp;
        __syncthreads();
        const float kS = part[0][dv] + part[1][dv];
        const float vnew = beta * (sv[dv] - a * kS);
        float o = 0.f;
#pragma unroll
        for (int i = 0; i < 64; ++i) { S[i] = a * S[i] + sk[half * 64 + i] * vnew; o += sq[half * 64 + i] * S[i]; }
        part2[half][dv] = o;
        __syncthreads();
        float ov = 0.f;
        if (half == 0) { ov = part2[0][dv] + part2[1][dv]; const float o2 = wave_sum(ov * ov); if ((tid & 63) == 0) sred2[wv] = o2; }
        __syncthreads();
        if (half == 0) {
            const float rs = rsqrtf((sred2[0] + sred2[1]) * (1.f / 128.f) + 1e-6f);
            const size_t zi = row * 1024 + h * 128 + dv;
            B.ZA[zi] = f2bf(ov * rs * gn * silu_f(bf2f(B.ZA[zi])));
        }
    }
}

__global__ void __launch_bounds__(256) k_topk_naive(Bufs B, u16_t* __restrict__ IDX) {
    const int row = blockIdx.x, b = row >> 11, t = row & 2047, tid = threadIdx.x;
    if (t < 256) return;
    __shared__ float s_score[2048], s_qi[512], s_wi[8];
    __shared__ int s_cnt;
    for (int i = tid; i < 512; i += 256) s_qi[i] = bf2f(B.QI[(size_t)row * 512 + i]);
    if (tid < 8) s_wi[tid] = B.SMALL[(size_t)row * 32 + 16 + tid] * 0.04419417382415922f;
    if (tid == 0) s_cnt = 0;
    __syncthreads();
    const int nvalid = t + 1;
    for (int s = tid; s < nvalid; s += 256) {
        const bf16_t* kr = B.KI + ((size_t)b * NT + s) * 64;
        float acc[8];
#pragma unroll
        for (int hh = 0; hh < 8; ++hh) acc[hh] = 0.f;
        for (int d = 0; d < 64; ++d) { const float kd = bf2f(kr[d]);
#pragma unroll
            for (int hh = 0; hh < 8; ++hh) acc[hh] += s_qi[hh * 64 + d] * kd; }
        float sc = 0.f;
#pragma unroll
        for (int hh = 0; hh < 8; ++hh) sc += s_wi[hh] * fmaxf(acc[hh], 0.f);
        s_score[s] = sc;
    }
    __syncthreads();
    for (int s = tid; s < nvalid; s += 256) {
        const float v = s_score[s]; int rank = 0;
        for (int s2 = 0; s2 < nvalid; ++s2) { const float v2 = s_score[s2]; rank += (v2 > v || (v2 == v && s2 < s)) ? 1 : 0; }
        if (rank < 256) { const int pos = atomicAdd(&s_cnt, 1); IDX[(size_t)row * 256 + pos] = (u16_t)s; }
    }
}
__global__ void __launch_bounds__(256) k_dsa_naive(Bufs B, const float* __restrict__ w_uk, const float* __restrict__ w_uv, const float* __restrict__ rel_bias) {
    const int row = blockIdx.x, b = row >> 11, t = row & 2047, tid = threadIdx.x, lane = tid & 63, wv = tid >> 6;
    __shared__ float s_score[2048], s_qi[512], s_wi[8], s_q[1024], s_qlat[2048], s_p[2048], s_ol[2048];
    __shared__ int s_sel[256]; __shared__ int s_cnt;
    for (int i = tid; i < 512; i += 256) s_qi[i] = bf2f(B.QI[(size_t)row * 512 + i]);
    for (int i = tid; i < 1024; i += 256) s_q[i] = bf2f(B.QB[(size_t)row * 1024 + i]);
    if (tid < 8) s_wi[tid] = B.SMALL[(size_t)row * 32 + 16 + tid] * 0.04419417382415922f;
    if (tid == 0) s_cnt = 0;
    __syncthreads();
    const int nvalid = t + 1;
    for (int s = tid; s < nvalid; s += 256) {
        const bf16_t* kr = B.KI + ((size_t)b * NT + s) * 64;
        float acc[8];
#pragma unroll
        for (int hh = 0; hh < 8; ++hh) acc[hh] = 0.f;
        for (int d = 0; d < 64; ++d) { const float kd = bf2f(kr[d]);
#pragma unroll
            for (int hh = 0; hh < 8; ++hh) acc[hh] += s_qi[hh * 64 + d] * kd; }
        float sc = 0.f;
#pragma unroll
        for (int hh = 0; hh < 8; ++hh) sc += s_wi[hh] * fmaxf(acc[hh], 0.f);
        s_score[s] = sc;
    }
    __syncthreads();
    int nsel;
    if (nvalid <= 256) { for (int s = tid; s < nvalid; s += 256) s_sel[s] = s; nsel = nvalid; }
    else {
        for (int s = tid; s < nvalid; s += 256) {
            const float v = s_score[s]; int rank = 0;
            for (int s2 = 0; s2 < nvalid; ++s2) { const float v2 = s_score[s2]; rank += (v2 > v || (v2 == v && s2 < s)) ? 1 : 0; }
            if (rank < 256) { const int pos = atomicAdd(&s_cnt, 1); s_sel[pos] = s; }
        }
        nsel = 256;
    }
    for (int o = tid; o < 2048; o += 256) {
        const int hh = o >> 8, c = o & 255; const float* wr = w_uk + (size_t)c * 1024 + hh * 128; float d = 0.f;
        for (int k = 0; k < 128; ++k) d += s_q[hh * 128 + k] * wr[k];
        s_qlat[o] = d * 0.08838834764831845f;
    }
    __syncthreads();
    for (int o = tid; o < 2048; o += 256) {
        const int hh = o >> 8, k = o & 255;
        if (k < nsel) {
            const int s = s_sel[k]; const bf16_t* cr = B.CKV + ((size_t)b * NT + s) * 256; float d = 0.f;
            for (int c = 0; c < 256; ++c) d += s_qlat[hh * 256 + c] * bf2f(cr[c]);
            s_p[o] = d + rel_bias[t5_bucket(t - s) * 8 + hh];
        }
    }
    __syncthreads();
    for (int hh = wv; hh < 8; hh += 4) {
        float m = -3.0e38f;
        for (int k = lane; k < nsel; k += 64) m = fmaxf(m, s_p[hh * 256 + k]);
        m = wave_max(m);
        float sum = 0.f;
        for (int k = lane; k < nsel; k += 64) { const float e = __expf(s_p[hh * 256 + k] - m); s_p[hh * 256 + k] = e; sum += e; }
        sum = wave_sum(sum);
        const float inv = 1.f / sum;
        for (int k = lane; k < nsel; k += 64) s_p[hh * 256 + k] *= inv;
    }
    __syncthreads();
    for (int o = tid; o < 2048; o += 256) {
        const int hh = o >> 8, c = o & 255; float d = 0.f;
        for (int k = 0; k < nsel; ++k) d += s_p[hh * 256 + k] * bf2f(B.CKV[((size_t)b * NT + s_sel[k]) * 256 + c]);
        s_ol[o] = d;
    }
    __syncthreads();
    for (int o = tid; o < 1024; o += 256) {
        const int hh = o >> 7, d = o & 127; float acc = 0.f;
        for (int c = 0; c < 256; ++c) acc += s_ol[hh * 256 + c] * w_uv[(size_t)c * 1024 + hh * 128 + d];
        const float z = bf2f(B.ZB[(size_t)row * 1024 + o]);
        B.QB[(size_t)row * 1024 + o] = f2bf(acc * silu_f(z));
    }
}

#ifndef MK_SPLIT
#define MK_SPLIT 0
#endif

extern "C" void kernel_launch(void* const* d_in, const int* in_sizes, int n_in, void* d_out, int out_size, void* d_ws, size_t ws_size, hipStream_t stream) {
    static int grid = 0;
    if (grid == 0) {
        if (n_in != 18 || ws_size < WS_NEED || out_size != MROWS * DM) { fprintf(stderr, "kernel_launch: unexpected shapes (n_in %d, ws %zu, out %d)\n", n_in, ws_size, out_size); grid = -1; return; }
        int dev = 0, cus = 0;
        if (hipGetDevice(&dev) != hipSuccess || hipDeviceGetAttribute(&cus, hipDeviceAttributeMultiprocessorCount, dev) != hipSuccess) { grid = -1; return; }
        if (hipFuncSetAttribute((const void*)fwd, hipFuncAttributeMaxDynamicSharedMemorySize, LDS_BYTES) != hipSuccess) { fprintf(stderr, "kernel_launch: hipFuncSetAttribute failed\n"); grid = -1; return; }
        int per_cu = 0;
        if (hipOccupancyMaxActiveBlocksPerMultiprocessor(&per_cu, (const void*)fwd, NTHR, LDS_BYTES) != hipSuccess || per_cu < 1) fprintf(stderr, "kernel_launch: occupancy query says %d\n", per_cu);
        (void)hipGetLastError();
        grid = cus > 0 ? cus : 256;
    }
    if (grid < 0) return;
    const float* conv_w = (const float*)d_in[6]; const float* a_log = (const float*)d_in[7]; const float* dt_bias = (const float*)d_in[8];
    const float* gdn_norm_g = (const float*)d_in[9]; const float* kv_norm_g = (const float*)d_in[11];
    const float* w_uk = (const float*)d_in[12]; const float* w_uv = (const float*)d_in[13]; const float* rel_bias = (const float*)d_in[16];
    (void)hipMemsetAsync((char*)d_ws + OFF_CTL, 0, CTL_ZERO_BYTES, stream);
    Params p{};
    for (int i = 0; i < 18; ++i) p.in[i] = (const float*)d_in[i];
    p.out = (float*)d_out; p.ws = (char*)d_ws;
    const Bufs B = make_bufs((char*)d_ws, (char*)d_out);
    int li = 0;
#define FWD(lo_, hi_) do { p.ph_lo = (lo_); p.ph_hi = (hi_); p.li = li++; hipLaunchKernelGGL(fwd, dim3(grid), dim3(NTHR), LDS_BYTES, stream, p); } while (0)
    FWD(0, 11);
#undef FWD
}
```

```cpp
#include <hip/hip_runtime.h>
#include <stdint.h>
#include <stdio.h>

#define LAS __attribute__((address_space(3)))
typedef unsigned short bf16_t;
typedef short bf16x8 __attribute__((ext_vector_type(8)));
typedef float f32x4 __attribute__((ext_vector_type(4)));
typedef unsigned u32x4 __attribute__((ext_vector_type(4)));
typedef unsigned u32x2 __attribute__((ext_vector_type(2)));
__device__ __forceinline__ float bf2f(bf16_t v) { return __uint_as_float(((unsigned)v) << 16); }
__device__ __forceinline__ bf16_t f2bf(float f) { unsigned u = __float_as_uint(f); u += 0x7FFFu + ((u >> 16) & 1u); return (bf16_t)(u >> 16); }
__device__ __forceinline__ float bflo(unsigned w) { return __uint_as_float(w << 16); }
__device__ __forceinline__ float bfhi(unsigned w) { return __uint_as_float(w & 0xFFFF0000u); }
__device__ __forceinline__ unsigned cvt_pk_bf16(float lo, float hi) { unsigned r; asm volatile("v_cvt_pk_bf16_f32 %0, %1, %2" : "=v"(r) : "v"(lo), "v"(hi)); return r; }
__device__ __forceinline__ float silu_f(float x) { return x / (1.f + __expf(-x)); }
__device__ __forceinline__ float sigmoid_f(float x) { return 1.f / (1.f + __expf(-x)); }
__device__ __forceinline__ float wave_sum(float v) {
#pragma unroll
    for (int o = 32; o > 0; o >>= 1) v += __shfl_xor(v, o);
    return v;
}
__device__ __forceinline__ float wave_max(float v) {
#pragma unroll
    for (int o = 32; o > 0; o >>= 1) v = fmaxf(v, __shfl_xor(v, o));
    return v;
}

constexpr int NB = 8, NT = 2048, DM = 1024, MROWS = NB * NT;
constexpr int NPAD = 7168;
constexpr int NWT = 9216;
constexpr size_t MiB = 1ull << 20;
constexpr size_t OFF_CTL = 0, CTL_ZERO_BYTES = 64 * 1024, OFF_MOD = 64 * 1024, OFF_SMALL = 1 * MiB, OFF_KI = 3 * MiB, OFF_CKV = 5 * MiB, OFF_QI = 13 * MiB,
                 OFF_QA = 29 * MiB, OFF_KA = 61 * MiB, OFF_VA = 93 * MiB, OFF_ZA = 125 * MiB, OFF_QB = 157 * MiB, OFF_ZB = 189 * MiB,
                 OFF_H = 221 * MiB, OFF_WOUT_T = 253 * MiB, WS_NEED = 255 * MiB;
constexpr size_t OFF_XNEW = OFF_QA, OFF_MERGED = OFF_VA, OFF_PARK = OFF_KA;
constexpr size_t OO_WT = 0, OO_WOG_T = 18 * MiB, OO_WOD_T = 20 * MiB;
constexpr size_t OO_TPATT = 31 * MiB;
constexpr size_t OO_STASH = 55 * MiB;
constexpr size_t OO_DEC = 60 * MiB;
constexpr size_t OO_WUK_B = 22 * MiB;
constexpr size_t OO_WUV_T = 22 * MiB + 512 * 1024;
constexpr size_t OO_IDX = 23 * MiB;
constexpr int CW_BAR = 1024, CW_D1Q = 64;

__host__ __device__ __forceinline__ int wt_col(int n) {
    if (n < 4096) return n;
    if (n < 5120) return 4112 + (n - 4096);
    if (n < 6144) return 5392 + (n - 5120);
    if (n < 6400) return 5136 + (n - 6144);
    if (n < 6912) return 6416 + (n - 6400);
    if (n < 6976) return 6928 + (n - 6912);
    if (n < 6984) return 4096 + (n - 6976);
    if (n < 6992) return 4104 + (n - 6984);
    if (n < 7000) return 6992 + (n - 6992);
    if (n < 7168) return -1;
    return 7000 + (n - 7168);
}

struct Bufs {
    bf16_t *QA, *KA, *VA, *ZA, *QB, *ZB, *CKV, *QI, *KI, *H, *WT, *WOG_T, *WOD_T, *WOUT_T, *MERGED, *PARK;
    float *SMALL, *MOD, *XNEW;
};
__host__ __device__ __forceinline__ Bufs make_bufs(char* ws, char* os) {
    Bufs B;
    B.QA = (bf16_t*)(ws + OFF_QA); B.KA = (bf16_t*)(ws + OFF_KA); B.VA = (bf16_t*)(ws + OFF_VA); B.ZA = (bf16_t*)(ws + OFF_ZA);
    B.QB = (bf16_t*)(ws + OFF_QB); B.ZB = (bf16_t*)(ws + OFF_ZB); B.CKV = (bf16_t*)(ws + OFF_CKV); B.QI = (bf16_t*)(ws + OFF_QI);
    B.KI = (bf16_t*)(ws + OFF_KI); B.H = (bf16_t*)(ws + OFF_H); B.WT = (bf16_t*)(os + OO_WT); B.WOG_T = (bf16_t*)(os + OO_WOG_T);
    B.WOD_T = (bf16_t*)(os + OO_WOD_T); B.WOUT_T = (bf16_t*)(ws + OFF_WOUT_T); B.MERGED = (bf16_t*)(ws + OFF_MERGED); B.PARK = (bf16_t*)(ws + OFF_PARK);
    B.SMALL = (float*)(ws + OFF_SMALL); B.MOD = (float*)(ws + OFF_MOD); B.XNEW = (float*)(ws + OFF_XNEW);
    return B;
}

namespace pg8 {
#define PG8_LAS __attribute__((address_space(3)))
constexpr int BM = 256, BK = 64, HALF = 128, HTB = HALF * BK * 2  , STAGE_BYTES = 8 * HTB, NXCD = 8, WGM = 8;
__host__ __device__ __forceinline__ int lds_byte(int r, int c) { const int st = (r >> 4) * 2 + (c >> 5), rr = r & 15, cc = c & 31, ob = rr * 64 + cc * 2; return st * 1024 + (ob ^ (((ob >> 9) & 1) << 5)); }
__host__ __device__ __forceinline__ void stage_rc(int b, int& R, int& C) { const int st = b / 1024, sb = b % 1024, swz = sb ^ (((sb >> 9) & 1) << 5); R = (st >> 1) * 16 + swz / 64; C = (st & 1) * 32 + (swz % 64) / 2; }
__host__ __device__ __forceinline__ int perm32(int rho) { const int n = rho >> 4, i = rho & 15; return 8 * (i >> 2) + 4 * n + (i & 3); }
struct Unit { int pm, pn, st; };
struct StaticOrder {
    int nM, nN, nwg, G, c;
    __host__ __device__ void init(int M, int N, int G_, int c_) { nM = M / BM; nN = N / BM; nwg = nM * nN; G = G_; c = c_; }
    __host__ __device__ bool tile(int i, int& pm, int& pn) const {
        const long L = (long)i * G + c; if (L >= nwg) return false;
        int wgid = (int)L; { const int q = nwg / NXCD, r = nwg % NXCD, xcd = wgid % NXCD, off = wgid / NXCD; wgid = (xcd < r ? xcd * (q + 1) : r * (q + 1) + (xcd - r) * q) + off; }
        const int nig = WGM * nN, gid = wgid / nig, fm = gid * WGM, gsz = (nM - fm) < WGM ? (nM - fm) : WGM;
        pm = fm + ((wgid % nig) % gsz); pn = (wgid % nig) / gsz; return true;
    }
};
template <class Epi, class Sched, bool ALIGN_EPI = false, bool SP2 = false>
__device__ __forceinline__ void gemm_phase(PG8_LAS unsigned char* lds, const int K, const int lda, const int ldb, const Sched& S, const Epi& E) {
    const int tid = threadIdx.x, wid = __builtin_amdgcn_readfirstlane(tid >> 6), lane = tid & 63, wr = wid >> 2, wc = wid & 3, fr = lane & 15, fq = lane >> 4;
    const int nt = K / BK;
    unsigned voffA[2], voffB[2];
#pragma unroll
    for (int i = 0; i < 2; ++i) { int R, C; stage_rc(tid * 16 + i * 8192, R, C); const int Rb = Epi::PERM ? ((R & ~31) + perm32(R & 31)) : R;
        voffA[i] = (unsigned)(R * lda + C) * 2u; voffB[i] = (unsigned)(Rb * ldb + C) * 2u; }
    const size_t kstep = (size_t)(BK * 2);
    const size_t hstepA = (size_t)HALF * lda * 2, hstepB = (size_t)HALF * ldb * 2;
    const unsigned ldsw = (unsigned)wid * 1024u;
    const int aoff = lds_byte(wr * 64 + fr, fq * 8), boff = lds_byte(wc * 32 + fr, fq * 8);
#define PG8_SA(b, h) (((b) * 2 + (h)) * HTB)
#define PG8_SB(b, h) ((4 + (b) * 2 + (h)) * HTB)
#define PG8_STAGE(bufoff, gbase, voff) do { _Pragma("unroll") for (int _i = 0; _i < 2; ++_i) \
        __builtin_amdgcn_global_load_lds((const unsigned*)((const char*)(gbase) + (voff)[_i]), (PG8_LAS unsigned*)(lds + (bufoff) + ldsw + _i * 8192), 16, 0, 0); } while (0)
#define PG8_LDA(dst, b, h) do { _Pragma("unroll") for (int m = 0; m < 4; ++m) _Pragma("unroll") for (int k = 0; k < 2; ++k) dst[m][k] = *(const PG8_LAS bf16x8*)(lds + PG8_SA(b, h) + aoff + m * 2048 + k * 1024); } while (0)
#define PG8_LDB(dst, b, h) do { _Pragma("unroll") for (int n = 0; n < 2; ++n) _Pragma("unroll") for (int k = 0; k < 2; ++k) dst[n][k] = *(const PG8_LAS bf16x8*)(lds + PG8_SB(b, h) + boff + n * 2048 + k * 1024); } while (0)
#define PG8_MMA(ai, bj, At, Bt) do { __builtin_amdgcn_s_setprio(1); _Pragma("unroll") for (int m = 0; m < 4; ++m) _Pragma("unroll") for (int n = 0; n < 2; ++n) _Pragma("unroll") for (int k = 0; k < 2; ++k) \
        acc[ai][bj][m][n] = __builtin_amdgcn_mfma_f32_16x16x32_bf16(Bt[n][k], At[m][k], acc[ai][bj][m][n], 0, 0, 0); __builtin_amdgcn_s_setprio(0); } while (0)
#define PG8_WAIT_V(n) asm volatile("s_waitcnt vmcnt(" #n ")" ::: "memory")
#define PG8_WAIT_L(n) asm volatile("s_waitcnt lgkmcnt(" #n ")" ::: "memory")
#define PG8_BAR __builtin_amdgcn_s_barrier()
#define PG8_SCHED __builtin_amdgcn_sched_barrier(0)
    Unit cur, nxt; int ui = 0;
    if (!S.next(0, cur)) return;
    f32x4 acc[2][2][4][2];
#pragma unroll
    for (int a = 0; a < 2; ++a)
#pragma unroll
        for (int b = 0; b < 2; ++b)
#pragma unroll
            for (int m = 0; m < 4; ++m)
#pragma unroll
                for (int n = 0; n < 2; ++n) acc[a][b][m][n] = (f32x4){0.f, 0.f, 0.f, 0.f};
    bf16x8 At[4][2], B0[2][2], B1[2][2];
    const char* cA = S.a_ptr(cur); const char* cB = S.b_ptr(cur);
    S.a_ready(cur);
    if constexpr (SP2) {
        PG8_STAGE(PG8_SB(0, 0), cB, voffB); PG8_STAGE(PG8_SB(0, 1), cB + hstepB, voffB); PG8_STAGE(PG8_SA(0, 0), cA, voffA); PG8_STAGE(PG8_SA(0, 1), cA + hstepA, voffA);
        if (wr == 1) PG8_BAR;
        PG8_WAIT_V(2); PG8_BAR;
        PG8_STAGE(PG8_SB(1, 0), cB + kstep, voffB); PG8_STAGE(PG8_SA(1, 0), cA + kstep, voffA); PG8_STAGE(PG8_SB(1, 1), cB + hstepB + kstep, voffB);
        PG8_WAIT_V(6); PG8_BAR;
    } else {
        PG8_STAGE(PG8_SB(0, 0), cB, voffB); PG8_STAGE(PG8_SA(0, 0), cA, voffA); PG8_STAGE(PG8_SB(0, 1), cB + hstepB, voffB); PG8_STAGE(PG8_SA(0, 1), cA + hstepA, voffA);
        if (wr == 1) PG8_BAR;
        PG8_WAIT_V(4); PG8_BAR;
        PG8_STAGE(PG8_SB(1, 0), cB + kstep, voffB); PG8_STAGE(PG8_SA(1, 0), cA + kstep, voffA); PG8_STAGE(PG8_SB(1, 1), cB + hstepB + kstep, voffB);
        PG8_WAIT_V(6); PG8_BAR;
    }
    for (;;) {
        const bool has_next = S.next(ui + 1, nxt);
        const char* nA = has_next ? S.a_ptr(nxt) : cA; const char* nB = has_next ? S.b_ptr(nxt) : cB;
        for (int t = 0; t < nt; t += 2) {
            const bool last = (t == nt - 2);
            const char* a1 = cA + (size_t)(t + 1) * kstep;
            const char* a2 = last ? nA : cA + (size_t)(t + 2) * kstep; const char* b2 = last ? nB : cB + (size_t)(t + 2) * kstep;
            const char* a3 = a2 + kstep; const char* b3 = b2 + kstep;
            if (last && has_next) S.a_ready(nxt);
            if constexpr (SP2) {
            PG8_LDB(B0, 0, 0); PG8_LDB(B1, 0, 1); PG8_SCHED; PG8_LDA(At, 0, 0); PG8_STAGE(PG8_SA(1, 1), a1 + hstepA, voffA);
            PG8_WAIT_V(8); PG8_WAIT_L(0); PG8_BAR; PG8_MMA(0, 0, At, B0); PG8_MMA(0, 1, At, B1); PG8_BAR; PG8_SCHED;
            PG8_LDA(At, 0, 1); PG8_STAGE(PG8_SB(0, 0), b2, voffB); PG8_STAGE(PG8_SB(0, 1), b2 + hstepB, voffB); PG8_STAGE(PG8_SA(0, 0), a2, voffA);
            PG8_WAIT_V(8); PG8_WAIT_L(0); PG8_BAR; PG8_MMA(1, 0, At, B0); PG8_MMA(1, 1, At, B1); PG8_BAR; PG8_SCHED;
            PG8_LDB(B0, 1, 0); PG8_LDB(B1, 1, 1); PG8_SCHED; PG8_LDA(At, 1, 0); PG8_STAGE(PG8_SA(0, 1), a2 + hstepA, voffA);
            PG8_WAIT_V(8); PG8_WAIT_L(0); PG8_BAR; PG8_MMA(0, 0, At, B0); PG8_MMA(0, 1, At, B1); PG8_BAR; PG8_SCHED;
            PG8_LDA(At, 1, 1); PG8_STAGE(PG8_SB(1, 0), b3, voffB); PG8_STAGE(PG8_SB(1, 1), b3 + hstepB, voffB); PG8_STAGE(PG8_SA(1, 0), a3, voffA);
            PG8_WAIT_V(8); PG8_WAIT_L(0); PG8_BAR; PG8_MMA(1, 0, At, B0); PG8_MMA(1, 1, At, B1); PG8_BAR; PG8_SCHED;
            } else {
            PG8_LDB(B0, 0, 0); PG8_SCHED; PG8_LDA(At, 0, 0); PG8_STAGE(PG8_SA(1, 1), a1 + hstepA, voffA);
            PG8_WAIT_L(8); PG8_BAR; PG8_WAIT_L(0); PG8_MMA(0, 0, At, B0); PG8_BAR; PG8_SCHED;
            PG8_LDB(B1, 0, 1); PG8_STAGE(PG8_SB(0, 0), b2, voffB);
            PG8_BAR; PG8_WAIT_L(0); PG8_MMA(0, 1, At, B1); PG8_BAR;
            PG8_LDA(At, 0, 1); PG8_STAGE(PG8_SA(0, 0), a2, voffA);
            PG8_BAR; PG8_WAIT_L(0); PG8_MMA(1, 0, At, B0); PG8_BAR; PG8_SCHED;
            PG8_STAGE(PG8_SB(0, 1), b2 + hstepB, voffB);
            PG8_WAIT_V(6); PG8_BAR; PG8_MMA(1, 1, At, B1); PG8_BAR;
            PG8_LDB(B0, 1, 0); PG8_SCHED; PG8_LDA(At, 1, 0); PG8_STAGE(PG8_SA(0, 1), a2 + hstepA, voffA);
            PG8_WAIT_L(8); PG8_BAR; PG8_WAIT_L(0); PG8_MMA(0, 0, At, B0); PG8_BAR; PG8_SCHED;
            PG8_LDB(B1, 1, 1); PG8_STAGE(PG8_SB(1, 0), b3, voffB);
            PG8_BAR; PG8_WAIT_L(0); PG8_MMA(0, 1, At, B1); PG8_BAR;
            PG8_LDA(At, 1, 1); PG8_STAGE(PG8_SA(1, 0), a3, voffA);
            PG8_BAR; PG8_WAIT_L(0); PG8_MMA(1, 0, At, B0); PG8_BAR; PG8_SCHED;
            PG8_STAGE(PG8_SB(1, 1), b3 + hstepB, voffB);
            PG8_WAIT_V(6); PG8_BAR; PG8_MMA(1, 1, At, B1); PG8_BAR;
            }
        }
        if constexpr (ALIGN_EPI) { if (wr == 0) PG8_BAR; }
        if constexpr (!Epi::AFTER_DRAIN) { E(acc, cur, wr, wc, fr, fq); S.done(cur); }
        if (!has_next) break;
#pragma unroll
        for (int a = 0; a < 2; ++a)
#pragma unroll
            for (int b = 0; b < 2; ++b)
#pragma unroll
                for (int m = 0; m < 4; ++m)
#pragma unroll
                    for (int n = 0; n < 2; ++n) acc[a][b][m][n] = (f32x4){0.f, 0.f, 0.f, 0.f};
        cur = nxt; cA = nA; cB = nB; ++ui;
        if constexpr (ALIGN_EPI) { if (wr == 1) PG8_BAR; }
    }
    PG8_WAIT_V(0);
    if constexpr (!ALIGN_EPI) { if (wr == 0) PG8_BAR; }
    PG8_BAR;
    if constexpr (Epi::AFTER_DRAIN) { E.fused(acc, cur, wr, wc, fr, fq, lds, wid, lane); S.done(cur); }
#undef PG8_SA
#undef PG8_SB
#undef PG8_STAGE
#undef PG8_LDA
#undef PG8_LDB
#undef PG8_MMA
#undef PG8_WAIT_V
#undef PG8_WAIT_L
#undef PG8_BAR
#undef PG8_SCHED
}
}

struct SchedProj {
    pg8::StaticOrder so; const char* A; const char* Bt;
    __device__ __forceinline__ bool next(int i, pg8::Unit& u) const { u.st = 0; return so.tile(i, u.pm, u.pn); }
    __device__ __forceinline__ const char* a_ptr(const pg8::Unit& u) const { return A + (size_t)u.pm * (256 * DM * 2); }
    __device__ __forceinline__ const char* b_ptr(const pg8::Unit& u) const { return Bt + (size_t)u.pn * (256 * DM * 2); }
    __device__ __forceinline__ void a_ready(const pg8::Unit&) const {}
    __device__ __forceinline__ void done(const pg8::Unit&) const {}
};
struct SchedMerge {
    pg8::StaticOrder so; const char* ws; const char* os;
    __device__ __forceinline__ bool next(int i, pg8::Unit& u) const { u.st = i & 3; return so.tile(i >> 2, u.pm, u.pn); }
    __device__ __forceinline__ const char* a_ptr(const pg8::Unit& u) const {
        const size_t off = (u.st == 1) ? OFF_ZA : (u.st == 3) ? OFF_QB : OFF_H;
        return ws + off + (size_t)u.pm * (256 * DM * 2); }
    __device__ __forceinline__ const char* b_ptr(const pg8::Unit& u) const {
        const size_t off = (u.st == 0) ? (OO_WT + (size_t)7168 * DM * 2) : (u.st == 1) ? OO_WOG_T : (u.st == 2) ? (OO_WT + (size_t)8192 * DM * 2) : OO_WOD_T;
        return os + off + (size_t)u.pn * (256 * DM * 2); }
    __device__ __forceinline__ void a_ready(const pg8::Unit&) const {}
    __device__ __forceinline__ void done(const pg8::Unit&) const {}
};

__device__ __forceinline__ u32x4 pack8(const f32x4 v0, const f32x4 v1) { u32x4 w; w.x = cvt_pk_bf16(v0[0], v0[1]); w.y = cvt_pk_bf16(v0[2], v0[3]); w.z = cvt_pk_bf16(v1[0], v1[1]); w.w = cvt_pk_bf16(v1[2], v1[3]); return w; }
struct EpiProj {
    static constexpr bool PERM = true, AFTER_DRAIN = false;
    char* ws; char* os;
    __device__ __forceinline__ void operator()(const f32x4 (&acc)[2][2][4][2], const pg8::Unit& u, int wr, int wc, int fr, int fq) const {
        const int row0 = u.pm * 256 + wr * 64 + fr, lc0 = wc * 32 + 8 * fq, pn = u.pn;
        bf16_t* const KI = (bf16_t*)(ws + OFF_KI); float* const SMALL = (float*)(ws + OFF_SMALL);
        if (pn < 27) {
            bf16_t* base; int ldc, cb;
            if (pn < 24) { base = (bf16_t*)(ws + OFF_QA + (size_t)(pn >> 2) * (32 * MiB)); ldc = 1024; cb = (pn & 3) * 256; }
            else if (pn == 24) { base = (bf16_t*)(ws + OFF_CKV); ldc = 256; cb = 0; }
            else { base = (bf16_t*)(ws + OFF_QI); ldc = 512; cb = (pn - 25) * 256; }
#pragma unroll
            for (int ai = 0; ai < 2; ++ai)
#pragma unroll
                for (int m = 0; m < 4; ++m) { bf16_t* rowp = base + (size_t)(row0 + ai * 128 + m * 16) * ldc + cb + lc0;
#pragma unroll
                    for (int bj = 0; bj < 2; ++bj) *(u32x4*)(rowp + bj * 128) = pack8(acc[ai][bj][m][0], acc[ai][bj][m][1]); }
            if (pn < 12 && fr >= 13) {
                bf16_t* st = (bf16_t*)(os + OO_STASH) + (size_t)(pn >> 2) * (256 * 3 * 1024);
#pragma unroll
                for (int ai = 0; ai < 2; ++ai) { const int row = row0 + ai * 128 + 48; bf16_t* sp = st + ((size_t)(row >> 6) * 3 + ((row & 63) - 61)) * 1024 + cb + lc0;
#pragma unroll
                    for (int bj = 0; bj < 2; ++bj) *(u32x4*)(sp + bj * 128) = pack8(acc[ai][bj][3][0], acc[ai][bj][3][1]); }
            }
        } else {
#pragma unroll
            for (int ai = 0; ai < 2; ++ai)
#pragma unroll
                for (int m = 0; m < 4; ++m) { const size_t row = (size_t)(row0 + ai * 128 + m * 16);
                    if (lc0 < 64) *(u32x4*)(KI + row * 64 + lc0) = pack8(acc[ai][0][m][0], acc[ai][0][m][1]);
                    else if (lc0 < 88) { *(f32x4*)(SMALL + row * 32 + (lc0 - 64)) = acc[ai][0][m][0]; *(f32x4*)(SMALL + row * 32 + (lc0 - 64) + 4) = acc[ai][0][m][1]; } }
        }
    }
};
__device__ __forceinline__ f32x4 sig4(const f32x4 v) { f32x4 r; r[0] = sigmoid_f(v[0]); r[1] = sigmoid_f(v[1]); r[2] = sigmoid_f(v[2]); r[3] = sigmoid_f(v[3]); return r; }
__device__ __forceinline__ void unpack8(const u32x4 w, f32x4& a, f32x4& b) { a[0] = bflo(w.x); a[1] = bfhi(w.x); a[2] = bflo(w.y); a[3] = bfhi(w.y); b[0] = bflo(w.z); b[1] = bfhi(w.z); b[2] = bflo(w.w); b[3] = bfhi(w.w); }
struct EpiMerge {
    static constexpr bool PERM = true, AFTER_DRAIN = false;
    bf16_t* MERGED; bf16_t* PARK;
    __device__ __forceinline__ void operator()(const f32x4 (&acc)[2][2][4][2], const pg8::Unit& u, int wr, int wc, int fr, int fq) const {
        const int row0 = u.pm * 256 + wr * 64 + fr, col0 = u.pn * 256 + wc * 32 + 8 * fq, st = u.st;
#pragma unroll
        for (int ai = 0; ai < 2; ++ai)
#pragma unroll
            for (int m = 0; m < 4; ++m) { const size_t off = (size_t)(row0 + ai * 128 + m * 16) * 1024 + col0;
#pragma unroll
                for (int bj = 0; bj < 2; ++bj) {
                    const f32x4 v0 = acc[ai][bj][m][0], v1 = acc[ai][bj][m][1];
                    u32x4* pm_ = (u32x4*)(MERGED + off + bj * 128); u32x4* pp_ = (u32x4*)(PARK + off + bj * 128);
                    if (st == 0) *pm_ = pack8(sig4(v0), sig4(v1));
                    else if (st == 1) { f32x4 g0, g1; unpack8(*pm_, g0, g1); *pm_ = pack8(g0 * v0, g1 * v1); }
                    else if (st == 2) *pp_ = pack8(sig4(v0), sig4(v1));
                    else { f32x4 a0, a1, g0, g1; unpack8(*pm_, a0, a1); unpack8(*pp_, g0, g1); *pm_ = pack8(a0 + g0 * v0, a1 + g1 * v1); }
                } }
    }
};
struct EpiOut {
    static constexpr bool PERM = false, AFTER_DRAIN = false;
    const float* x; const float* MOD; float* XNEW;
    __device__ __forceinline__ void operator()(const f32x4 (&acc)[2][2][4][2], const pg8::Unit& u, int wr, int wc, int fr, int fq) const {
        const int row0 = u.pm * 256 + wr * 64 + fr, col0 = u.pn * 256 + wc * 32 + 4 * fq; const int b = u.pm >> 3;
        f32x4 gv[2][2];
#pragma unroll
        for (int bj = 0; bj < 2; ++bj)
#pragma unroll
            for (int n = 0; n < 2; ++n) gv[bj][n] = *(const f32x4*)(MOD + b * 3072 + 2048 + col0 + bj * 128 + n * 16);
#pragma unroll
        for (int ai = 0; ai < 2; ++ai)
#pragma unroll
            for (int m = 0; m < 4; ++m) { const size_t off = (size_t)(row0 + ai * 128 + m * 16) * 1024 + col0;
#pragma unroll
                for (int bj = 0; bj < 2; ++bj)
#pragma unroll
                    for (int n = 0; n < 2; ++n) { const f32x4 xv = *(const f32x4*)(x + off + bj * 128 + n * 16); *(f32x4*)(XNEW + off + bj * 128 + n * 16) = xv + gv[bj][n] * acc[ai][bj][m][n]; } }
    }
};

#define XB_TMO      128
#define XB_XCNT(j)  (256  + 64 * (j))
#define XB_XSUB(j)  (1280 + 64 * (j))
#define XB_XGEN(j)  (2304 + 64 * (j))
#define XB_TOP      3328
#define XB_TOPGEN   3392
#define XCD_BAR_WORDS 3456
#define XB_SPIN_CAP (1u << 18)

__device__ __forceinline__ unsigned xb_ld(unsigned* p)              { return __hip_atomic_load(p, __ATOMIC_RELAXED, __HIP_MEMORY_SCOPE_AGENT); }
__device__ __forceinline__ unsigned xb_add(unsigned* p, unsigned v) { return __hip_atomic_fetch_add(p, v, __ATOMIC_RELAXED, __HIP_MEMORY_SCOPE_AGENT); }
__device__ __forceinline__ unsigned xb_xcc_id() { return (unsigned)__builtin_amdgcn_s_getreg((3 << 11) | 20) & 0xFu; }
#define XB_SPIN(cond, bar) do { unsigned _sp = 0; while (cond) { __builtin_amdgcn_s_sleep(1); \
    if ((++_sp & 255u) == 0u) { if (xb_ld(&(bar)[XB_TMO])) break; if (_sp > XB_SPIN_CAP) { atomicAdd(&(bar)[XB_TMO], 1u); break; } } } } while (0)

struct XcdBarrier {
    unsigned* bar; unsigned x;
    volatile LAS unsigned* st;
};

__device__ __forceinline__ XcdBarrier xcd_barrier_post(unsigned* bar, volatile LAS unsigned* st) {
    XcdBarrier b; b.bar = bar; b.x = xb_xcc_id(); b.st = st;
    if (threadIdx.x == 0) (void)xb_add(&bar[XB_XCNT(b.x)], 1u);
    return b;
}
__device__ __forceinline__ void xcd_barrier_complete(unsigned* bar, unsigned x, unsigned& nloc, unsigned& nx) {
    const unsigned G = gridDim.x * gridDim.y * gridDim.z;
    unsigned sum, cnt, mine, sp = 0u;
    for (;;) {
        sum = 0u; cnt = 0u; mine = 0u;
#pragma unroll
        for (unsigned j = 0; j < 16; ++j) { const unsigned c = xb_ld(&bar[XB_XCNT(j)]); sum += c; cnt += (c > 0u) ? 1u : 0u; mine = (j == x) ? c : mine; }
        if (sum == G) break;
        __builtin_amdgcn_s_sleep(1);
        if ((++sp & 255u) == 0u) { if (xb_ld(&bar[XB_TMO])) break; if (sp > XB_SPIN_CAP) { atomicAdd(&bar[XB_TMO], 1u); break; } }
    }
    nloc = mine > 0u ? mine : 1u; nx = cnt > 0u ? cnt : 1u;
}

__device__ __forceinline__ void xcd_barrier(const XcdBarrier& b) {
    asm volatile("s_waitcnt vmcnt(0)" ::: "memory");
    __syncthreads();
    if (threadIdx.x == 0) {
        unsigned* bar = b.bar;
        __builtin_amdgcn_s_waitcnt(0);
        unsigned nloc = b.st[0], nx = b.st[1];
        if (nloc == 0u) { xcd_barrier_complete(bar, b.x, nloc, nx); b.st[0] = nloc; b.st[1] = nx; }
        const unsigned old = xb_add(&bar[XB_XSUB(b.x)], 1u);
        const unsigned gen = old / nloc;
        if (old + 1u == (gen + 1u) * nloc) {
            __builtin_amdgcn_fence(__ATOMIC_RELEASE, "agent");
            asm volatile("s_waitcnt vmcnt(0)" ::: "memory");
            const unsigned og = xb_add(&bar[XB_TOP], 1u);
            const unsigned tg = og / nx;
            if (og + 1u == (tg + 1u) * nx) xb_add(&bar[XB_TOPGEN], 1u);
            else XB_SPIN(xb_ld(&bar[XB_TOPGEN]) == tg, bar);
            __builtin_amdgcn_fence(__ATOMIC_ACQUIRE, "agent");
            xb_add(&bar[XB_XGEN(b.x)], 1u);
            asm volatile("s_waitcnt vmcnt(0)" ::: "memory");
        } else {
            XB_SPIN(xb_ld(&bar[XB_XGEN(b.x)]) == gen, bar);
            __builtin_amdgcn_fence(__ATOMIC_ACQUIRE, "agent");
            asm volatile("s_waitcnt vmcnt(0)" ::: "memory");
        }
    }
    __syncthreads();
}

constexpr int NWAVES = 8, NTHR = 512;
constexpr int RING_OFF = 0, RING_BYTES = 131072, LDS_BYTES = 163840, LDSCTL_OFF = LDS_BYTES - 256;
struct Params { const float* in[18]; float* out; char* ws; int ph_lo, ph_hi, li, pad; };

__device__ __forceinline__ void tr_tiles(const float* __restrict__ src, const int ld_src, bf16_t* __restrict__ dst, const int mode, const int ntn, LAS unsigned char* lds, const int nkt = 32, const int dstld = DM) {
    const int tid = threadIdx.x, G = gridDim.x, sub = tid >> 8, t = tid & 255, tx = t & 31, ty = t >> 5;
    LAS float* tile = (LAS float*)lds + sub * (32 * 33);
    const int NTILES = ntn * nkt;
    for (int base = blockIdx.x * 2; base < NTILES; base += G * 2) {
        const int id = base + sub, tn = id / nkt, tk = id % nkt, n0 = tn * 32, k0 = tk * 32;
        if (id < NTILES) {
#pragma unroll
            for (int i = 0; i < 4; ++i) { const int k = k0 + ty + i * 8, n = n0 + tx; const int col = mode ? wt_col(n) : n; tile[(ty + i * 8) * 33 + tx] = (col >= 0) ? src[(size_t)k * ld_src + col] : 0.f; }
        }
        __syncthreads();
        if (id < NTILES) {
#pragma unroll
            for (int i = 0; i < 4; ++i) { const int n = n0 + ty + i * 8, k = k0 + tx; dst[(size_t)n * dstld + k] = f2bf(tile[tx * 33 + ty + i * 8]); }
        }
        __syncthreads();
    }
}
__device__ __forceinline__ void p0_prologue(const Params& p, const Bufs& B, LAS unsigned char* lds) {
    const int tid = threadIdx.x, G = gridDim.x;
    tr_tiles(p.in[5], 9048, B.WT, 1, NWT / 32, lds);
    tr_tiles(p.in[10], 1024, B.WOG_T, 0, 32, lds);
    tr_tiles(p.in[14], 1024, B.WOD_T, 0, 32, lds);
    tr_tiles(p.in[15], 1024, B.WOUT_T, 0, 32, lds);
    tr_tiles(p.in[13], 1024, (bf16_t*)((char*)p.out + OO_WUV_T), 0, 32, lds, 8, 256);
    { bf16_t* wk = (bf16_t*)((char*)p.out + OO_WUK_B); const float* src = p.in[12]; for (int i = blockIdx.x * NTHR + threadIdx.x; i < 256 * 1024; i += G * NTHR) wk[i] = f2bf(src[i]); }
    {
        LAS float* sc = (LAS float*)(lds + 16384);
        LAS float* part = (LAS float*)(lds + 16384 + 32768);
        const float* c = p.in[1]; const float* w_ada = p.in[3]; const float* b_ada = p.in[4];
        for (int jb = blockIdx.x; jb < 192; jb += G) {
            for (int i = tid; i < 8192; i += NTHR) sc[i] = silu_f(c[i]);
            __syncthreads();
            const int jj = tid & 15, sl = tid >> 4, j = jb * 16 + jj;
            float acc[8];
#pragma unroll
            for (int b = 0; b < 8; ++b) acc[b] = 0.f;
            for (int ii = 0; ii < 32; ++ii) { const int i = sl * 32 + ii; const float w = w_ada[(size_t)i * 3072 + j];
#pragma unroll
                for (int b = 0; b < 8; ++b) acc[b] += sc[b * 1024 + i] * w; }
#pragma unroll
            for (int b = 0; b < 8; ++b) part[(sl * 8 + b) * 16 + jj] = acc[b];
            __syncthreads();
            if (tid < 128) { const int b = tid >> 4, j2 = tid & 15; float s = 0.f;
                for (int s2 = 0; s2 < 32; ++s2) s += part[(s2 * 8 + b) * 16 + j2];
                B.MOD[b * 3072 + jb * 16 + j2] = s + b_ada[jb * 16 + j2]; }
            __syncthreads();
        }
    }
}
__device__ __forceinline__ void p1_h(const Params& p, const Bufs& B) {
    const int tid = threadIdx.x, lane = tid & 63, wave = tid >> 6, G = gridDim.x;
    const float* x = p.in[0]; const float* ng = p.in[2];
    for (int row = blockIdx.x * NWAVES + wave; row < MROWS; row += G * NWAVES) {
        const int b = row >> 11; const float* xr = x + (size_t)row * DM; f32x4 v[4]; float ss = 0.f;
#pragma unroll
        for (int i = 0; i < 4; ++i) { v[i] = *(const f32x4*)(xr + 4 * lane + 256 * i); ss += v[i][0] * v[i][0] + v[i][1] * v[i][1] + v[i][2] * v[i][2] + v[i][3] * v[i][3]; }
        ss = wave_sum(ss);
        const float r = rsqrtf(ss * (1.f / DM) + 1e-6f);
#pragma unroll
        for (int i = 0; i < 4; ++i) { const int col = 4 * lane + 256 * i;
            const f32x4 g = *(const f32x4*)(ng + col), sc = *(const f32x4*)(B.MOD + b * 3072 + 1024 + col), sh = *(const f32x4*)(B.MOD + b * 3072 + col);
            const f32x4 y = (v[i] * r * g) * (sc + 1.0f) + sh;
            u32x2 w; w.x = cvt_pk_bf16(y[0], y[1]); w.y = cvt_pk_bf16(y[2], y[3]);
            *(u32x2*)(B.H + (size_t)row * DM + col) = w; }
    }
}
__device__ __forceinline__ void p8_final(const Params& p, const Bufs& B) {
    const int tid = threadIdx.x, lane = tid & 63, wave = tid >> 6, G = gridDim.x;
    const float* fg = p.in[17];
    for (int row = blockIdx.x * NWAVES + wave; row < MROWS; row += G * NWAVES) {
        const float* xr = B.XNEW + (size_t)row * DM; f32x4 v[4]; float ss = 0.f;
#pragma unroll
        for (int i = 0; i < 4; ++i) { v[i] = *(const f32x4*)(xr + 4 * lane + 256 * i); ss += v[i][0] * v[i][0] + v[i][1] * v[i][1] + v[i][2] * v[i][2] + v[i][3] * v[i][3]; }
        ss = wave_sum(ss);
        const float r = rsqrtf(ss * (1.f / DM) + 1e-6f);
#pragma unroll
        for (int i = 0; i < 4; ++i) { const int col = 4 * lane + 256 * i; const f32x4 g = *(const f32x4*)(fg + col); *(f32x4*)(p.out + (size_t)row * DM + col) = v[i] * r * g; }
    }
}


typedef float f32x16 __attribute__((ext_vector_type(16)));
#define MFMA32(a, b, c) __builtin_amdgcn_mfma_f32_32x32x16_bf16((a), (b), (c), 0, 0, 0)
__device__ __forceinline__ int crow(int reg, int h) { return (reg & 3) + 8 * (reg >> 2) + 4 * h; }
constexpr int G1_ROWB = 272, G1_IMG = 64 * G1_ROWB, G1_WAVE = G1_IMG + 2048;

template <int MODE>
__device__ __forceinline__ void g1_conv(const bf16_t* __restrict__ X, const bf16_t* __restrict__ stash  , const float* __restrict__ cw  ,
                                        LAS unsigned char* img, int b, int n, int h, int lane, int dry = 0) {
    const int col = h * 128 + 2 * lane; const unsigned row0 = (unsigned)(b * NT + n * 64);
    const __amdgpu_buffer_rsrc_t rs = __builtin_amdgcn_make_buffer_rsrc((void*)X, 0, MROWS * 1024 * 2, 0x00020000);
    const unsigned voff = (unsigned)col * 2u;
    float w[4][2];
#pragma unroll
    for (int j = 0; j < 4; ++j) { w[j][0] = cw[j * 3072 + col]; w[j][1] = cw[j * 3072 + col + 1]; }
    float h0[2] = {0.f, 0.f}, h1[2] = {0.f, 0.f}, h2[2] = {0.f, 0.f};
    if (n > 0) {
        const bf16_t* sp = stash + ((size_t)(b * 32 + n - 1) * 3) * 1024 + col;
        const unsigned a0 = *(const unsigned*)(sp), a1 = *(const unsigned*)(sp + 1024), a2 = *(const unsigned*)(sp + 2048);
        h0[0] = bflo(a0); h0[1] = bfhi(a0); h1[0] = bflo(a1); h1[1] = bfhi(a1); h2[0] = bflo(a2); h2[1] = bfhi(a2);
    }
    unsigned rawn[16];
#pragma unroll
    for (int t = 0; t < 16; ++t) rawn[t] = __builtin_amdgcn_raw_buffer_load_b32(rs, voff, (row0 + t) * 2048u, 0);
#pragma unroll 1
    for (int q4 = 0; q4 < 4; ++q4) {
        unsigned raw[16];
#pragma unroll
        for (int t = 0; t < 16; ++t) raw[t] = rawn[t];
        const unsigned rb = (row0 + q4 * 16) * 2048u;
        if (q4 < 3) {
#pragma unroll
            for (int t = 0; t < 16; ++t) rawn[t] = __builtin_amdgcn_raw_buffer_load_b32(rs, voff, rb + (16 + t) * 2048u, 0);
        }
#pragma unroll
        for (int t = 0; t < 16; ++t) {
            const float x0 = bflo(raw[t]), x1 = bfhi(raw[t]);
            const float y0 = silu_f(w[0][0] * h0[0] + w[1][0] * h1[0] + w[2][0] * h2[0] + w[3][0] * x0);
            const float y1 = silu_f(w[0][1] * h0[1] + w[1][1] * h1[1] + w[2][1] * h2[1] + w[3][1] * x1);
            h0[0] = h1[0]; h1[0] = h2[0]; h2[0] = x0; h0[1] = h1[1]; h1[1] = h2[1]; h2[1] = x1;
            const unsigned pk = cvt_pk_bf16(y0, y1);
            if (MODE == 0) *(LAS unsigned*)(img + (q4 * 16 + t) * G1_ROWB + 4 * lane) = pk;
            else if (!dry) __builtin_amdgcn_raw_buffer_store_b32(pk, rs, voff, rb + t * 2048u, 0);
        }
    }
}
__device__ __forceinline__ float g1_diag(const f32x16& g, int r, int hh) {
    float d = 0.f;
#pragma unroll
    for (int reg = 0; reg < 16; ++reg) d = (crow(reg, hh) == r) ? g[reg] : d;
    return d + __shfl_xor(d, 32);
}
__device__ __forceinline__ void g1_store_norm(bf16_t* __restrict__ Xout, const LAS unsigned char* img, const LAS float* scl, float mul, int b, int n, int h, int lane, int dry) {
    const size_t row0 = (size_t)b * NT + n * 64;
#pragma unroll 4
    for (int ps = 0; ps < 16; ++ps) {
        const int row = ps * 4 + (lane >> 4), c16 = lane & 15;
        const u32x4 v = *(const LAS u32x4*)(img + row * G1_ROWB + 16 * c16);
        const float s = scl[row] * mul;
        u32x4 o; o.x = cvt_pk_bf16(bflo(v.x) * s, bfhi(v.x) * s); o.y = cvt_pk_bf16(bflo(v.y) * s, bfhi(v.y) * s); o.z = cvt_pk_bf16(bflo(v.z) * s, bfhi(v.z) * s); o.w = cvt_pk_bf16(bflo(v.w) * s, bfhi(v.w) * s);
        if (!dry) *(u32x4*)(Xout + (row0 + row) * 1024 + h * 128 + 8 * c16) = o;
    }
}
__device__ __forceinline__ void g1_phase(const Params& p, LAS unsigned char* lds) {
    const int tid = threadIdx.x, lane0 = tid & 63, h = tid >> 6, G = gridDim.x;
    char* ws = p.ws; char* os = (char*)p.out;
    bf16_t* QA = (bf16_t*)(ws + OFF_QA); bf16_t* KA = (bf16_t*)(ws + OFF_KA); bf16_t* VA = (bf16_t*)(ws + OFF_VA);
    const float* SMALL = (const float*)(ws + OFF_SMALL);
    const bf16_t* STASH = (const bf16_t*)(os + OO_STASH);
    const float* conv_w = p.in[6];
    LAS unsigned char* img = lds + h * G1_WAVE;
    LAS float* sm = (LAS float*)(img + G1_IMG);
    const float Aexp = __expf(p.in[7][h]), dtb = p.in[8][h];
    for (int unit = blockIdx.x; unit < NB * 32; unit += G) {
        int lane = lane0; asm volatile("" : "+v"(lane));
        const int r = lane & 31, hh = lane >> 5;
        const int b = unit >> 5, n = unit & 31; const size_t row0 = (size_t)b * NT + n * 64;
        const int u = (b * 8 + h) * 32 + n;
        float gi, beta, d;
        {
            const float xg = SMALL[(row0 + lane) * 32 + h] + dtb;
            const float sp = xg > 20.f ? xg : log1pf(__expf(xg));
            gi = -Aexp * sp; beta = sigmoid_f(SMALL[(row0 + lane) * 32 + 8 + h]);
            d = gi;
#pragma unroll
            for (int o = 1; o < 64; o <<= 1) { const float v = __shfl_up(d, o); if (lane >= o) d += v; }
            const float dl = __shfl(d, 63);
            float* dec = (float*)(os + OO_DEC) + (size_t)u * 256;
            dec[lane] = __expf(d); dec[64 + lane] = __expf(dl - d); dec[128 + lane] = gi; dec[192 + lane] = beta;
            sm[128 + lane] = d; sm[192 + lane] = beta;
        }
        g1_conv<0>(KA, STASH + (size_t)1 * 256 * 3 * 1024, conv_w + 1024, img, b, n, h, lane);
        __syncthreads();
        f32x16 g00, g10, g11;
#pragma unroll
        for (int i = 0; i < 16; ++i) { g00[i] = 0.f; g10[i] = 0.f; g11[i] = 0.f; }
#pragma unroll 2
        for (int s = 0; s < 8; ++s) {
            const bf16x8 k0 = *(const LAS bf16x8*)(img + (r) * G1_ROWB + (16 * s + 8 * hh) * 2), k1 = *(const LAS bf16x8*)(img + (32 + r) * G1_ROWB + (16 * s + 8 * hh) * 2);
            g00 = MFMA32(k0, k0, g00); g10 = MFMA32(k1, k0, g10); g11 = MFMA32(k1, k1, g11);
        }
        {
            const float nlo = rsqrtf(g1_diag(g00, r, hh) + 1e-6f), nhi = rsqrtf(g1_diag(g11, r, hh) + 1e-6f);
            if (hh == 0) { sm[r] = nlo; sm[32 + r] = nhi; }
        }
        __syncthreads();
        g1_store_norm(KA, img, sm, 1.0f, b, n, h, lane, p.pad);
        asm volatile("s_waitcnt vmcnt(0)" ::: "memory");
        __syncthreads();
        g1_conv<0>(QA, STASH, conv_w, img, b, n, h, lane);
        __syncthreads();
        {
            f32x16 qq0, qq1;
#pragma unroll
            for (int i = 0; i < 16; ++i) { qq0[i] = 0.f; qq1[i] = 0.f; }
#pragma unroll 2
            for (int s = 0; s < 8; ++s) {
                const bf16x8 qa = *(const LAS bf16x8*)(img + (r) * G1_ROWB + (16 * s + 8 * hh) * 2), qb = *(const LAS bf16x8*)(img + (32 + r) * G1_ROWB + (16 * s + 8 * hh) * 2);
                qq0 = MFMA32(qa, qa, qq0); qq1 = MFMA32(qb, qb, qq1);
            }
            const float nlo = rsqrtf(g1_diag(qq0, r, hh) + 1e-6f), nhi = rsqrtf(g1_diag(qq1, r, hh) + 1e-6f);
            if (hh == 0) { sm[64 + r] = nlo; sm[96 + r] = nhi; }
        }
        f32x16 q00, q10, q11;
#pragma unroll
        for (int i = 0; i < 16; ++i) { q00[i] = 0.f; q10[i] = 0.f; q11[i] = 0.f; }
#pragma unroll 1
        for (int s4 = 0; s4 < 2; ++s4) {
            bf16x8 kf0[4], kf1[4];
#pragma unroll
            for (int s = 0; s < 4; ++s) {
                kf0[s] = *(const bf16x8*)(KA + (row0 + r) * 1024 + h * 128 + 16 * (4 * s4 + s) + 8 * hh);
                kf1[s] = *(const bf16x8*)(KA + (row0 + 32 + r) * 1024 + h * 128 + 16 * (4 * s4 + s) + 8 * hh);
            }
#pragma unroll
            for (int s = 0; s < 4; ++s) {
                const bf16x8 qa = *(const LAS bf16x8*)(img + (r) * G1_ROWB + (16 * (4 * s4 + s) + 8 * hh) * 2), qb = *(const LAS bf16x8*)(img + (32 + r) * G1_ROWB + (16 * (4 * s4 + s) + 8 * hh) * 2);
                q00 = MFMA32(qa, kf0[s], q00); q10 = MFMA32(qb, kf0[s], q10); q11 = MFMA32(qb, kf1[s], q11);
            }
        }
        __syncthreads();
        g1_store_norm(QA, img, sm + 64, 0.08838834764831845f, b, n, h, lane, p.pad);
        __syncthreads();
        g1_conv<1>(VA, STASH + (size_t)2 * 256 * 3 * 1024, conv_w + 2048, img, b, n, h, lane, p.pad);
        bf16_t* tp = (bf16_t*)(os + OO_TPATT + (size_t)u * 12288);
        LAS float* Am = (LAS float*)img;
#pragma unroll
        for (int blk = 0; blk < 3; ++blk) {
            __builtin_amdgcn_sched_barrier(0);
            const int bi = (blk == 0) ? 0 : 1, bj = (blk == 2) ? 1 : 0;
            const f32x16& gk = (blk == 0) ? g00 : (blk == 1) ? g10 : g11;
            const f32x16& gq = (blk == 0) ? q00 : (blk == 1) ? q10 : q11;
            const int j = 32 * bj + r; const float nkj = sm[j], dj = sm[128 + j];
#pragma unroll
            for (int g4 = 0; g4 < 4; ++g4) {
                const int ib = 32 * bi + 8 * g4 + 4 * hh;
                const f32x4 nki = *(const LAS f32x4*)(sm + ib), nqi = *(const LAS f32x4*)(sm + 64 + ib), di = *(const LAS f32x4*)(sm + 128 + ib), bti = *(const LAS f32x4*)(sm + 192 + ib);
#pragma unroll
                for (int e = 0; e < 4; ++e) {
                    const int i = ib + e, reg = 4 * g4 + e;
                    const float gam = __expf(di[e] - dj);
                    const float av = (i > j) ? gk[reg] * nki[e] * nkj * bti[e] * gam : 0.f;
                    const float tv = (i >= j) ? gq[reg] * (nqi[e] * 0.08838834764831845f) * gam : 0.f;
                    Am[i * 64 + j] = av;
                    if (blk == 0) Am[i * 64 + 32 + j] = 0.f;
                    tp[(3 + blk) * 1024 + (i & 31) * 32 + r] = f2bf(tv);
                }
            }
        }
        __syncthreads();
#pragma unroll 1
        for (int i0 = 0; i0 < 64; i0 += 4) {
            float t0 = (lane == i0) ? 1.f : 0.f, t1 = (lane == i0 + 1) ? 1.f : 0.f, t2 = (lane == i0 + 2) ? 1.f : 0.f, t3 = (lane == i0 + 3) ? 1.f : 0.f;
#pragma unroll 2
            for (int j4 = 0; j4 < i0; j4 += 4) {
                const f32x4 a0 = *(const LAS f32x4*)(Am + (i0 + 0) * 64 + j4), a1 = *(const LAS f32x4*)(Am + (i0 + 1) * 64 + j4), a2 = *(const LAS f32x4*)(Am + (i0 + 2) * 64 + j4), a3 = *(const LAS f32x4*)(Am + (i0 + 3) * 64 + j4);
#pragma unroll
                for (int e = 0; e < 4; ++e) { const float tj = Am[(j4 + e) * 64 + lane]; t0 -= a0[e] * tj; t1 -= a1[e] * tj; t2 -= a2[e] * tj; t3 -= a3[e] * tj; }
            }
            const f32x4 d1 = *(const LAS f32x4*)(Am + (i0 + 1) * 64 + i0), d2 = *(const LAS f32x4*)(Am + (i0 + 2) * 64 + i0), d3 = *(const LAS f32x4*)(Am + (i0 + 3) * 64 + i0);
            t1 -= d1[0] * t0;
            t2 -= d2[0] * t0 + d2[1] * t1;
            t3 -= d3[0] * t0 + d3[1] * t1 + d3[2] * t2;
            Am[(i0 + 0) * 64 + lane] = t0; Am[(i0 + 1) * 64 + lane] = t1; Am[(i0 + 2) * 64 + lane] = t2; Am[(i0 + 3) * 64 + lane] = t3;
        }
        for (int i = 0; i < 64; ++i) {
            const bf16_t v = f2bf(Am[i * 64 + lane] * beta);
            if (i < 32) { if (lane < 32) tp[0 * 1024 + i * 32 + lane] = v; }
            else { tp[(lane < 32 ? 1 : 2) * 1024 + (i - 32) * 32 + (lane & 31)] = v; }
        }
        __syncthreads();
    }
}


typedef short s16x4 __attribute__((ext_vector_type(4)));
typedef __bf16 bf16x8_t __attribute__((ext_vector_type(8)));
typedef float f32x8 __attribute__((ext_vector_type(8)));
constexpr int G2_RB = 264, G2_IMG = 64 * G2_RB, G2_BRB = 72, G2_BLK = 32 * G2_BRB;
constexpr int G2_K = 0, G2_Q = G2_IMG, G2_V = 2 * G2_IMG, G2_TP = 3 * G2_IMG, G2_AT = G2_TP + 3 * G2_BLK, G2_DE = G2_AT + 3 * G2_BLK, G2_CB = G2_DE + 512;
constexpr int G2_OB = 2 * G2_CB, G2_OBSZ = 64 * 256;
static_assert(G2_CB % 16 == 0 && G2_OB + 2 * G2_OBSZ <= LDSCTL_OFF, "GDN scan LDS map");
__device__ __forceinline__ bf16x8 pack_step(const f32x16& x, const int s) {
    f32x8 v;
#pragma unroll
    for (int j = 0; j < 8; ++j) v[j] = x[8 * s + j];
    return __builtin_bit_cast(bf16x8, __builtin_convertvector(v, bf16x8_t));
}
__device__ __forceinline__ bf16x8 perm_frag(const LAS unsigned char* img, const int rowb, const int row, const int kc, const int hh) {
    const s16x4 lo = *(const LAS s16x4*)(img + row * rowb + (kc + 4 * hh) * 2), hi = *(const LAS s16x4*)(img + row * rowb + (kc + 8 + 4 * hh) * 2);
    return __builtin_shufflevector(lo, hi, 0, 1, 2, 3, 4, 5, 6, 7);
}
__device__ __forceinline__ s16x4 tr4(const LAS unsigned char* img, const int rowb, const int row0, const int c0, const int lane) {
    const int q = (lane & 15) >> 2, pq = lane & 3, blk = (lane >> 4) & 1;
    return __builtin_amdgcn_ds_read_tr16_b64_v4i16((LAS s16x4*)(img + (row0 + q) * rowb + (c0 + 16 * blk + 4 * pq) * 2));
}
#define G2_LV_SET(S_, k_, val_) do { const u32x4 _v = (val_); S_[(k_) >> 2][4 * ((k_) & 3) + 0] = __uint_as_float(_v.x); S_[(k_) >> 2][4 * ((k_) & 3) + 1] = __uint_as_float(_v.y); S_[(k_) >> 2][4 * ((k_) & 3) + 2] = __uint_as_float(_v.z); S_[(k_) >> 2][4 * ((k_) & 3) + 3] = __uint_as_float(_v.w); } while (0)
#define G2_LV_GET(S_, k_) ((u32x4){__float_as_uint(S_[(k_) >> 2][4 * ((k_) & 3) + 0]), __float_as_uint(S_[(k_) >> 2][4 * ((k_) & 3) + 1]), __float_as_uint(S_[(k_) >> 2][4 * ((k_) & 3) + 2]), __float_as_uint(S_[(k_) >> 2][4 * ((k_) & 3) + 3])})
__device__ __forceinline__ void g2_issue_chunk(const Params& p, f32x16 (&v)[4], const int b, const int h, const int n, const int lt) {
    char* ws = p.ws; const char* os = (const char*)p.out;
    const unsigned row0 = (unsigned)(b * NT + n * 64); const int u = (b * 8 + h) * 32 + n;
    const unsigned voff = (unsigned)((lt >> 4) * 2048 + h * 256 + (lt & 15) * 16);
#pragma unroll
    for (int t3 = 0; t3 < 3; ++t3) {
        const __amdgpu_buffer_rsrc_t rs = __builtin_amdgcn_make_buffer_rsrc((void*)(ws + OFF_QA + (size_t)(t3 == 0 ? 1 : t3 == 1 ? 0 : 2) * (32 * MiB)), 0, 32 * 1024 * 1024, 0x00020000);
#pragma unroll
        for (int k = 0; k < 4; ++k) G2_LV_SET(v, t3 * 4 + k, __builtin_amdgcn_raw_buffer_load_b128(rs, voff, (row0 + 16 * k) * 2048u, 0));
    }
    const __amdgpu_buffer_rsrc_t rt = __builtin_amdgcn_make_buffer_rsrc((void*)(os + OO_TPATT), 0, 24 * 1024 * 1024, 0x00020000);
#pragma unroll
    for (int k = 0; k < 3; ++k) G2_LV_SET(v, 12 + k, __builtin_amdgcn_raw_buffer_load_b128(rt, (unsigned)lt * 16u, (unsigned)u * 12288u + 4096u * k, 0));
    const __amdgpu_buffer_rsrc_t rd = __builtin_amdgcn_make_buffer_rsrc((void*)(os + OO_DEC), 0, 2 * 1024 * 1024, 0x00020000);
    G2_LV_SET(v, 15, __builtin_amdgcn_raw_buffer_load_b128(rd, (unsigned)(lt & 31) * 16u, (unsigned)u * 1024u, 0));
}
__device__ __forceinline__ void g2_commit_chunk(LAS unsigned char* cb, const f32x16 (&v)[4], const int lt) {
#pragma unroll
    for (int t3 = 0; t3 < 3; ++t3)
#pragma unroll
        for (int k = 0; k < 4; ++k) { const int pi = lt + 256 * k, row = pi >> 4, c16 = pi & 15; LAS u32x2* d = (LAS u32x2*)(cb + t3 * G2_IMG + row * G2_RB + 16 * c16);
            const u32x4 vv = G2_LV_GET(v, t3 * 4 + k); d[0] = (u32x2){vv.x, vv.y}; d[1] = (u32x2){vv.z, vv.w}; }
#pragma unroll
    for (int k = 0; k < 3; ++k) { const int pi = lt + 256 * k, blk = pi >> 7, row = (pi & 127) >> 2, c16 = pi & 3; LAS u32x2* d = (LAS u32x2*)(cb + G2_TP + blk * G2_BLK + row * G2_BRB + 16 * c16);
        const u32x4 vv = G2_LV_GET(v, 12 + k); d[0] = (u32x2){vv.x, vv.y}; d[1] = (u32x2){vv.z, vv.w}; }
    if (lt < 32) *(LAS u32x4*)(cb + G2_DE + 16 * lt) = G2_LV_GET(v, 15);
}
__device__ __forceinline__ void g2_issue_za(const Params& p, unsigned (&z)[16], const int b, const int h, const int n, const int lw, const int lane) {
    const __amdgpu_buffer_rsrc_t rz = __builtin_amdgcn_make_buffer_rsrc((void*)(p.ws + OFF_ZA), 0, 32 * 1024 * 1024, 0x00020000);
    const unsigned row0 = (unsigned)(b * NT + n * 64 + lw * 16), voff = (unsigned)(h * 256 + 4 * lane);
#pragma unroll
    for (int rr = 0; rr < 16; ++rr) z[rr] = __builtin_amdgcn_raw_buffer_load_b32(rz, voff, (row0 + rr) * 2048u, 0);
}
__device__ __forceinline__ void g2_epilogue(const Params& p, const LAS unsigned char* ob, const unsigned (&z)[16], const int b, const int h, const int n, const int lw  , const int lane) {
    const float* gg = p.in[9];
    const float g0 = gg[2 * lane], g1 = gg[2 * lane + 1];
    const __amdgpu_buffer_rsrc_t rz = __builtin_amdgcn_make_buffer_rsrc((void*)(p.ws + OFF_ZA), 0, 32 * 1024 * 1024, 0x00020000);
    const unsigned row0 = (unsigned)(b * NT + n * 64 + lw * 16), voff = (unsigned)(h * 256 + 4 * lane);
    unsigned w[16]; float ss[16];
#pragma unroll
    for (int rr = 0; rr < 16; ++rr) { w[rr] = *(const LAS unsigned*)(ob + (lw * 16 + rr) * 256 + 4 * lane); const float o0 = bflo(w[rr]), o1 = bfhi(w[rr]); ss[rr] = o0 * o0 + o1 * o1; }
#pragma unroll
    for (int o = 32; o > 0; o >>= 1) {
        float tmp[16];
#pragma unroll
        for (int rr = 0; rr < 16; ++rr) tmp[rr] = __shfl_xor(ss[rr], o);
#pragma unroll
        for (int rr = 0; rr < 16; ++rr) ss[rr] += tmp[rr];
    }
    if (!p.pad) {
#pragma unroll
        for (int rr = 0; rr < 16; ++rr) {
            const float rs = rsqrtf(ss[rr] * (1.f / 128.f) + 1e-6f);
            __builtin_amdgcn_raw_buffer_store_b32(cvt_pk_bf16(bflo(w[rr]) * rs * g0 * silu_f(bflo(z[rr])), bfhi(w[rr]) * rs * g1 * silu_f(bfhi(z[rr]))), rz, voff, (row0 + rr) * 2048u, 0);
        }
    }
}
__device__ __forceinline__ void g2_phase(const Params& p, LAS unsigned char* lds) {
    const int tid = threadIdx.x, wave = __builtin_amdgcn_readfirstlane(tid >> 6), G = gridDim.x;
    for (int bh = blockIdx.x; bh < NB * 8; bh += G) {
        int lane = tid & 63; asm volatile("" : "+v"(lane));
        const int r = lane & 31, hh = lane >> 5, b = bh >> 3, h = bh & 7;
        f32x16 S[4];
#pragma unroll
        for (int i = 0; i < 4; ++i)
#pragma unroll
            for (int e = 0; e < 16; ++e) S[i][e] = 0.f;
        unsigned zc[16];
        if (wave >= 4) { g2_issue_chunk(p, S, b, h, 0, tid - 256); g2_commit_chunk(lds, S, tid - 256); g2_issue_chunk(p, S, b, h, 1, tid - 256); g2_issue_za(p, zc, b, h, 0, wave - 4, lane); }
        __syncthreads();
#pragma unroll 1
        for (int n = 0; n < 32; ++n) {
            LAS unsigned char* cb = lds + (n & 1) * G2_CB;
            if (wave < 4) {
                const int j = wave;
                const LAS unsigned char* KI = cb + G2_K; const LAS unsigned char* QI = cb + G2_Q; const LAS unsigned char* VI = cb + G2_V;
                const LAS float* ED = (const LAS float*)(cb + G2_DE); const LAS float* EDL = ED + 64;
                f32x16 ks[2], qs[2];
#pragma unroll
                for (int tb = 0; tb < 2; ++tb)
#pragma unroll
                    for (int e = 0; e < 16; ++e) { ks[tb][e] = 0.f; qs[tb][e] = 0.f; }
                bf16x8 fa[2][4];
#define G2_LD1(buf, g) do { fa[buf][0] = perm_frag(KI, G2_RB, r, 16 * (g), hh); fa[buf][1] = perm_frag(KI, G2_RB, 32 + r, 16 * (g), hh); \
                            fa[buf][2] = perm_frag(QI, G2_RB, r, 16 * (g), hh); fa[buf][3] = perm_frag(QI, G2_RB, 32 + r, 16 * (g), hh); } while (0)
                G2_LD1(0, 0);
#pragma unroll
                for (int g = 0; g < 8; ++g) {
                    if (g + 1 < 8) G2_LD1((g + 1) & 1, g + 1);
                    __builtin_amdgcn_sched_barrier(0);
                    const bf16x8 xs = pack_step(S[g >> 1], g & 1);
                    ks[0] = MFMA32(fa[g & 1][0], xs, ks[0]); ks[1] = MFMA32(fa[g & 1][1], xs, ks[1]);
                    qs[0] = MFMA32(fa[g & 1][2], xs, qs[0]); qs[1] = MFMA32(fa[g & 1][3], xs, qs[1]);
                    __builtin_amdgcn_sched_barrier(0);
                }
#undef G2_LD1
                f32x16 R[2], O[2];
#pragma unroll
                for (int tb = 0; tb < 2; ++tb)
#pragma unroll
                    for (int g4 = 0; g4 < 4; ++g4) {
                        const int t0 = 32 * tb + 8 * g4 + 4 * hh;
                        const s16x4 vv = tr4(VI, G2_RB, t0, 32 * j, lane);
                        const f32x4 ed = *(const LAS f32x4*)(ED + t0);
#pragma unroll
                        for (int e = 0; e < 4; ++e) { R[tb][4 * g4 + e] = bf2f((bf16_t)vv[e]) - ed[e] * ks[tb][4 * g4 + e]; O[tb][4 * g4 + e] = ed[e] * qs[tb][4 * g4 + e]; }
                    }
                f32x16 vn[2];
#pragma unroll
                for (int e = 0; e < 16; ++e) { vn[0][e] = 0.f; vn[1][e] = 0.f; }
                {
                    bf16x8 ft[3][2];
#pragma unroll
                    for (int bk = 0; bk < 3; ++bk)
#pragma unroll
                        for (int s = 0; s < 2; ++s) ft[bk][s] = perm_frag(cb + G2_TP + bk * G2_BLK, G2_BRB, r, 16 * s, hh);
                    __builtin_amdgcn_sched_barrier(0);
#pragma unroll
                    for (int s = 0; s < 2; ++s) {
                        const bf16x8 x0 = pack_step(R[0], s), x1 = pack_step(R[1], s);
                        vn[0] = MFMA32(ft[0][s], x0, vn[0]); vn[1] = MFMA32(ft[1][s], x0, vn[1]); vn[1] = MFMA32(ft[2][s], x1, vn[1]);
                    }
                }
                f32x16 vs[2];
#pragma unroll
                for (int tb = 0; tb < 2; ++tb)
#pragma unroll
                    for (int g4 = 0; g4 < 4; ++g4) {
                        const f32x4 el = *(const LAS f32x4*)(EDL + 32 * tb + 8 * g4 + 4 * hh);
#pragma unroll
                        for (int e = 0; e < 4; ++e) vs[tb][4 * g4 + e] = el[e] * vn[tb][4 * g4 + e];
                    }
                {
                    bf16x8 ft[3][2];
#pragma unroll
                    for (int bk = 0; bk < 3; ++bk)
#pragma unroll
                        for (int s = 0; s < 2; ++s) ft[bk][s] = perm_frag(cb + G2_AT + bk * G2_BLK, G2_BRB, r, 16 * s, hh);
                    __builtin_amdgcn_sched_barrier(0);
#pragma unroll
                    for (int s = 0; s < 2; ++s) {
                        const bf16x8 x0 = pack_step(vn[0], s), x1 = pack_step(vn[1], s);
                        O[0] = MFMA32(ft[0][s], x0, O[0]); O[1] = MFMA32(ft[1][s], x0, O[1]); O[1] = MFMA32(ft[2][s], x1, O[1]);
                    }
                }
                LAS unsigned char* ob = lds + G2_OB + (n & 1) * G2_OBSZ;
#pragma unroll
                for (int tb = 0; tb < 2; ++tb)
#pragma unroll
                    for (int e = 0; e < 16; ++e) *(LAS bf16_t*)(ob + (32 * tb + crow(e, hh)) * 256 + (32 * j + r) * 2) = f2bf(O[tb][e]);
                const float edl_all = ED[63];
                bf16x8 xv[2][2];
#pragma unroll
                for (int tb = 0; tb < 2; ++tb)
#pragma unroll
                    for (int s = 0; s < 2; ++s) xv[tb][s] = pack_step(vs[tb], s);
                s16x4 fk[1][8];
#define G2_LD5(buf, i) do { _Pragma("unroll") for (int tb = 0; tb < 2; ++tb) _Pragma("unroll") for (int s = 0; s < 2; ++s) { const int t0 = 32 * tb + 16 * s + 4 * hh; \
                            fk[buf][(tb * 2 + s) * 2] = tr4(KI, G2_RB, t0, 32 * (i), lane); fk[buf][(tb * 2 + s) * 2 + 1] = tr4(KI, G2_RB, t0 + 8, 32 * (i), lane); } } while (0)
#pragma unroll
                for (int i = 0; i < 4; ++i) {
                    G2_LD5(0, i);
                    __builtin_amdgcn_sched_barrier(0);
#pragma unroll
                    for (int e = 0; e < 16; ++e) S[i][e] *= edl_all;
#pragma unroll
                    for (int tb = 0; tb < 2; ++tb)
#pragma unroll
                        for (int s = 0; s < 2; ++s) {
                            const bf16x8 a = __builtin_shufflevector(fk[0][(tb * 2 + s) * 2], fk[0][(tb * 2 + s) * 2 + 1], 0, 1, 2, 3, 4, 5, 6, 7);
                            S[i] = MFMA32(a, xv[tb][s], S[i]);
                        }
                    __builtin_amdgcn_sched_barrier(0);
                }
#undef G2_LD5
            } else {
                const int lt = tid - 256;
                if (n > 0) g2_epilogue(p, lds + G2_OB + ((n - 1) & 1) * G2_OBSZ, zc, b, h, n - 1, wave - 4, lane);
                if (n + 1 < 32) g2_commit_chunk(lds + ((n + 1) & 1) * G2_CB, S, lt);
                if (n + 2 < 32) g2_issue_chunk(p, S, b, h, n + 2, lt);
                if (n > 0) g2_issue_za(p, zc, b, h, n, wave - 4, lane);
            }
            __syncthreads();
        }
        if (wave >= 4) g2_epilogue(p, lds + G2_OB + 1 * G2_OBSZ, zc, b, h, 31, wave - 4, lane);
        __syncthreads();
    }
}

__device__ const unsigned char T5_BUCKET[128] = {
    0, 1, 2, 3, 4, 5, 6, 7, 8, 9, 10, 11, 12, 13, 14, 15, 16, 16, 16, 17, 17, 18, 18, 18, 19, 19, 19, 20, 20, 20, 20, 21,
    21, 21, 21, 22, 22, 22, 22, 22, 23, 23, 23, 23, 23, 23, 24, 24, 24, 24, 24, 24, 25, 25, 25, 25, 25, 25, 25, 26, 26, 26, 26, 26,
    26, 26, 26, 27, 27, 27, 27, 27, 27, 27, 27, 27, 27, 28, 28, 28, 28, 28, 28, 28, 28, 28, 28, 29, 29, 29, 29, 29, 29, 29, 29, 29,
    29, 29, 29, 30, 30, 30, 30, 30, 30, 30, 30, 30, 30, 30, 30, 30, 30, 31, 31, 31, 31, 31, 31, 31, 31, 31, 31, 31, 31, 31, 31, 31};
__device__ __forceinline__ int t5_bucket(int n) { return n >= 128 ? 31 : (int)T5_BUCKET[n]; }

constexpr size_t OFF_QL = OFF_QA;
typedef unsigned short u16_t;
#define MFMA16(a, b, c) __builtin_amdgcn_mfma_f32_16x16x32_bf16((a), (b), (c), 0, 0, 0)

__device__ __forceinline__ void qlat_phase(const Params& p, LAS unsigned char* lds) {
    const int tid = threadIdx.x, wave = tid >> 6, G = gridDim.x, wm = wave & 1, wn = wave >> 1;
    const bf16_t* QB = (const bf16_t*)(p.ws + OFF_QB); const bf16_t* WUK = (const bf16_t*)((const char*)p.out + OO_WUK_B); bf16_t* QL = (bf16_t*)(p.ws + OFF_QL);
    int hcur = -1; bf16x8 bfr[2][8];
    for (int unit = blockIdx.x; unit < 1024; unit += G) {
        int lane = tid & 63; asm volatile("" : "+v"(lane));
        const int r = lane & 31, hh = lane >> 5, h = unit & 7, mt = unit >> 3, m0 = mt * 128 + wm * 64, n0 = wn * 64;
        if (h != hcur) { hcur = h;
#pragma unroll
            for (int nt = 0; nt < 2; ++nt)
#pragma unroll
                for (int s = 0; s < 8; ++s) bfr[nt][s] = *(const bf16x8*)(WUK + (size_t)(n0 + 32 * nt + r) * 1024 + h * 128 + 16 * s + 8 * hh); }
        bf16x8 a[2][8];
#pragma unroll
        for (int mi = 0; mi < 2; ++mi)
#pragma unroll
            for (int s = 0; s < 8; ++s) a[mi][s] = *(const bf16x8*)(QB + (size_t)(m0 + 32 * mi + r) * 1024 + h * 128 + 16 * s + 8 * hh);
        f32x16 acc[2][2];
#pragma unroll
        for (int i = 0; i < 4; ++i)
#pragma unroll
            for (int e = 0; e < 16; ++e) acc[i >> 1][i & 1][e] = 0.f;
#pragma unroll
        for (int s = 0; s < 8; ++s)
#pragma unroll
            for (int mi = 0; mi < 2; ++mi)
#pragma unroll
                for (int nt = 0; nt < 2; ++nt) acc[mi][nt] = MFMA32(a[mi][s], bfr[nt][s], acc[mi][nt]);
#pragma unroll
        for (int mi = 0; mi < 2; ++mi)
#pragma unroll
            for (int nt = 0; nt < 2; ++nt)
#pragma unroll
                for (int e = 0; e < 16; ++e) *(LAS bf16_t*)(lds + (wm * 64 + 32 * mi + crow(e, hh)) * 528 + (n0 + 32 * nt + r) * 2) = f2bf(acc[mi][nt][e] * 0.08838834764831845f);
        __syncthreads();
#pragma unroll
        for (int k = 0; k < 8; ++k) { const int pi = tid + 512 * k, row = pi >> 5, c16 = pi & 31;
            *(u32x4*)(QL + (size_t)(mt * 128 + row) * 2048 + h * 256 + 8 * c16) = *(const LAS u32x4*)(lds + row * 528 + 16 * c16); }
        __syncthreads();
    }
}
__device__ __forceinline__ void wuv_phase(const Params& p, LAS unsigned char* lds) {
    const int tid = threadIdx.x, wave = tid >> 6, G = gridDim.x, wm = wave & 1, wn = wave >> 1;
    const bf16_t* OL = (const bf16_t*)(p.ws + OFF_QL); const bf16_t* WUV = (const bf16_t*)((const char*)p.out + OO_WUV_T); bf16_t* OB = (bf16_t*)(p.ws + OFF_QB); const bf16_t* ZB = (const bf16_t*)(p.ws + OFF_ZB);
    int hcur = -1; bf16x8 bfr[16];
    for (int unit = blockIdx.x; unit < 1024; unit += G) {
        int lane = tid & 63; asm volatile("" : "+v"(lane));
        const int r = lane & 31, hh = lane >> 5, h = unit & 7, mt = unit >> 3, m0 = mt * 128 + wm * 64, n0 = wn * 32;
        if (h != hcur) { hcur = h;
#pragma unroll
            for (int s = 0; s < 16; ++s) bfr[s] = *(const bf16x8*)(WUV + (size_t)(h * 128 + n0 + r) * 256 + 16 * s + 8 * hh); }
        f32x16 acc[2];
#pragma unroll
        for (int i = 0; i < 2; ++i)
#pragma unroll
            for (int e = 0; e < 16; ++e) acc[i][e] = 0.f;
#pragma unroll
        for (int s8 = 0; s8 < 2; ++s8) {
            bf16x8 a[2][8];
#pragma unroll
            for (int mi = 0; mi < 2; ++mi)
#pragma unroll
                for (int s = 0; s < 8; ++s) a[mi][s] = *(const bf16x8*)(OL + (size_t)(m0 + 32 * mi + r) * 2048 + h * 256 + 16 * (8 * s8 + s) + 8 * hh);
#pragma unroll
            for (int s = 0; s < 8; ++s)
#pragma unroll
                for (int mi = 0; mi < 2; ++mi) acc[mi] = MFMA32(a[mi][s], bfr[8 * s8 + s], acc[mi]);
        }
#pragma unroll
        for (int mi = 0; mi < 2; ++mi)
#pragma unroll
            for (int e = 0; e < 16; ++e) *(LAS bf16_t*)(lds + (wm * 64 + 32 * mi + crow(e, hh)) * 272 + (n0 + r) * 2) = f2bf(acc[mi][e]);
        __syncthreads();
#pragma unroll
        for (int k = 0; k < 4; ++k) { const int pi = tid + 512 * k, row = pi >> 4, c16 = pi & 15;
            const u32x4 v = *(const LAS u32x4*)(lds + row * 272 + 16 * c16); const size_t o = (size_t)(mt * 128 + row) * 1024 + h * 128 + 8 * c16;
            const u32x4 z = *(const u32x4*)(ZB + o); u32x4 w;
            w.x = cvt_pk_bf16(bflo(v.x) * silu_f(bflo(z.x)), bfhi(v.x) * silu_f(bfhi(z.x))); w.y = cvt_pk_bf16(bflo(v.y) * silu_f(bflo(z.y)), bfhi(v.y) * silu_f(bfhi(z.y)));
            w.z = cvt_pk_bf16(bflo(v.z) * silu_f(bflo(z.z)), bfhi(v.z) * silu_f(bfhi(z.z))); w.w = cvt_pk_bf16(bflo(v.w) * silu_f(bflo(z.w)), bfhi(v.w) * silu_f(bfhi(z.w)));
            *(u32x4*)(OB + o) = w; }
        __syncthreads();
    }
}

constexpr int D2_RB = 528, D2_KB = 32 * D2_RB, D2_BIAS = 8 * D2_KB;
static_assert(D2_BIAS + 129 * 8 * 4 <= LDSCTL_OFF, "DSA attention LDS map");
__device__ __forceinline__ void d2_phase(const Params& p, LAS unsigned char* lds) {
    const int tid = threadIdx.x, wave = __builtin_amdgcn_readfirstlane(tid >> 6), G = gridDim.x;
    const bf16_t* CKV = (const bf16_t*)(p.ws + OFF_CKV); bf16_t* QL = (bf16_t*)(p.ws + OFF_QL); const u16_t* IDX = (const u16_t*)((const char*)p.out + OO_IDX);
    LAS unsigned char* kb = lds + wave * D2_KB; LAS float* sbias = (LAS float*)(lds + D2_BIAS);
    for (int i = tid; i < 129 * 8; i += NTHR) sbias[i] = p.in[16][t5_bucket(i >> 3) * 8 + (i & 7)];
    __syncthreads();
    for (int it = blockIdx.x; it < 2048; it += G) {
        int lane = tid & 63; asm volatile("" : "+v"(lane));
        const int c16 = lane & 15, q = lane >> 4, b = it & 7, c8 = (it >> 3) & 31, kk = it >> 8, t = kk * 256 + c8 * 8 + wave;
        const size_t token = (size_t)b * NT + t;
        const int n_sel = (t + 1 < 256) ? (t + 1) : 256, nch = (n_sel + 31) >> 5;
        const __amdgpu_buffer_rsrc_t rck = __builtin_amdgcn_make_buffer_rsrc((void*)(CKV + (size_t)b * NT * 256), 0, NT * 512, 0x00020000); const unsigned gvo = 16u * (lane & 31);
        unsigned iw0, iw1;
        if (t < 256) { const int k0 = 4 * lane; iw0 = (unsigned)(k0 < n_sel ? k0 : 0) | ((unsigned)(k0 + 1 < n_sel ? k0 + 1 : 0) << 16); iw1 = (unsigned)(k0 + 2 < n_sel ? k0 + 2 : 0) | ((unsigned)(k0 + 3 < n_sel ? k0 + 3 : 0) << 16); }
        else { const u32x2 w = *(const u32x2*)(IDX + token * 256 + 4 * lane); iw0 = w.x; iw1 = w.y; }
        bf16x8 bq[8];
#pragma unroll
        for (int s = 0; s < 8; ++s) {
            u32x4 v = (u32x4){0u, 0u, 0u, 0u};
            if (c16 < 8) v = *(const u32x4*)(QL + token * 2048 + c16 * 256 + 32 * s + 8 * q);
            bq[s] = __builtin_bit_cast(bf16x8, v);
        }
        f32x4 O[16];
#pragma unroll
        for (int i = 0; i < 16; ++i) O[i] = (f32x4){0.f, 0.f, 0.f, 0.f};
        float mrun = -1.0e30f, lrun = 0.f;
        u32x4 g[16];
#define D2_GATHER(c) do { _Pragma("unroll") for (int i = 0; i < 16; ++i) { \
            const unsigned wa = (unsigned)__builtin_amdgcn_readlane((int)(((2 * i) & 2) ? iw1 : iw0), 8 * (c) + ((2 * i) >> 2)); \
            const int ka = (int)(wa & 0xFFFFu), kb2 = (int)(wa >> 16); const int key = (lane >> 5) ? kb2 : ka; \
            g[i] = __builtin_amdgcn_raw_buffer_load_b128(rck, gvo + ((unsigned)key << 9), 0, 0); } } while (0)
        D2_GATHER(0);
#pragma unroll 1
        for (int ch = 0; ch < nch; ++ch) {
#pragma unroll
            for (int i = 0; i < 16; ++i) *(LAS u32x4*)(kb + (2 * i + (lane >> 5)) * D2_RB + 16 * (lane & 31)) = g[i];
            if (ch + 1 < nch) D2_GATHER(ch + 1);
            f32x4 sc[2];
#pragma unroll
            for (int kt = 0; kt < 2; ++kt) { sc[kt] = (f32x4){0.f, 0.f, 0.f, 0.f};
#pragma unroll
                for (int s = 0; s < 8; ++s) sc[kt] = MFMA16(*(const LAS bf16x8*)(kb + (16 * kt + c16) * D2_RB + (32 * s + 8 * q) * 2), bq[s], sc[kt]); }
            float cmax = -1.0e30f;
#pragma unroll
            for (int kt = 0; kt < 2; ++kt) {
                const unsigned w0 = (unsigned)__shfl((int)iw0, 8 * ch + 4 * kt + q), w1 = (unsigned)__shfl((int)iw1, 8 * ch + 4 * kt + q);
#pragma unroll
                for (int e = 0; e < 4; ++e) {
                    const int sl = 16 * kt + 4 * q + e; const unsigned ww = (e & 2) ? w1 : w0; const int key = (e & 1) ? (int)(ww >> 16) : (int)(ww & 0xFFFFu);
                    const int dist = t - key; const float bias = sbias[(dist < 128 ? dist : 128) * 8 + (c16 & 7)];
                    const float v = (ch * 32 + sl < n_sel) ? sc[kt][e] + bias : -1.0e30f;
                    sc[kt][e] = v; cmax = fmaxf(cmax, v);
                }
            }
            cmax = fmaxf(cmax, __shfl_xor(cmax, 16)); cmax = fmaxf(cmax, __shfl_xor(cmax, 32));
            const bool resc = __any(cmax > mrun + 8.0f);
            const float mnew = resc ? fmaxf(mrun, cmax) : mrun, alpha = resc ? __expf(mrun - mnew) : 1.0f;
            float psum = 0.f;
#pragma unroll
            for (int kt = 0; kt < 2; ++kt)
#pragma unroll
                for (int e = 0; e < 4; ++e) { const float pv = __expf(sc[kt][e] - mnew); sc[kt][e] = pv; psum += pv; }
            lrun = lrun * alpha + psum; mrun = mnew;
            if (resc) {
#pragma unroll
                for (int mt = 0; mt < 16; ++mt) O[mt] = O[mt] * alpha;
            }
            f32x8 pf;
#pragma unroll
            for (int e = 0; e < 4; ++e) { pf[e] = sc[0][e]; pf[4 + e] = sc[1][e]; }
            const bf16x8 pb = __builtin_bit_cast(bf16x8, __builtin_convertvector(pf, bf16x8_t));
#pragma unroll
            for (int mt = 0; mt < 16; ++mt) {
                const s16x4 lo = __builtin_amdgcn_ds_read_tr16_b64_v4i16((LAS s16x4*)(kb + (4 * q + (c16 >> 2)) * D2_RB + (16 * mt + 4 * (lane & 3)) * 2));
                const s16x4 hi = __builtin_amdgcn_ds_read_tr16_b64_v4i16((LAS s16x4*)(kb + (16 + 4 * q + (c16 >> 2)) * D2_RB + (16 * mt + 4 * (lane & 3)) * 2));
                const bf16x8 a = __builtin_shufflevector(lo, hi, 0, 1, 2, 3, 4, 5, 6, 7);
                O[mt] = MFMA16(a, pb, O[mt]);
            }
        }
#undef D2_GATHER
        float lt = lrun + __shfl_xor(lrun, 16); lt += __shfl_xor(lt, 32);
        const float inv = 1.f / lt;
        if (c16 < 8 && !p.pad) {
#pragma unroll
            for (int mt = 0; mt < 16; ++mt) { u32x2 w; w.x = cvt_pk_bf16(O[mt][0] * inv, O[mt][1] * inv); w.y = cvt_pk_bf16(O[mt][2] * inv, O[mt][3] * inv);
                *(u32x2*)(QL + token * 2048 + c16 * 256 + 16 * mt + 4 * q) = w; }
        }
    }
}
constexpr int D1_SC = 0, D1_WI = 16 * 2048 * 4;
static_assert(D1_WI + 512 + 8 * 256 <= LDSCTL_OFF, "indexer LDS map");
__device__ __forceinline__ void d1_phase(const Params& p, LAS unsigned char* lds) {
    const int tid = threadIdx.x, wave = __builtin_amdgcn_readfirstlane(tid >> 6), G = gridDim.x;
    const bf16_t* QI = (const bf16_t*)(p.ws + OFF_QI); const bf16_t* KI = (const bf16_t*)(p.ws + OFF_KI); const float* SMALL = (const float*)(p.ws + OFF_SMALL);
    u16_t* IDX = (u16_t*)((char*)p.out + OO_IDX);
    LAS float* sc = (LAS float*)(lds + D1_SC); LAS float* swi = (LAS float*)(lds + D1_WI);
    unsigned* qhead = (unsigned*)(p.ws + OFF_CTL) + CW_D1Q + (p.pad == 2 ? 64 : 0); volatile LAS int* qslot = (volatile LAS int*)(lds + LDSCTL_OFF + 128);
    for (;;) {
        if (tid == 0) *qslot = (int)__hip_atomic_fetch_add(qhead, 1u, __ATOMIC_RELAXED, __HIP_MEMORY_SCOPE_AGENT);
        __syncthreads();
        const int unit = *qslot;
        __syncthreads();
        if (unit >= 896) break;
        int lane = tid & 63; asm volatile("" : "+v"(lane));
        const int r = lane & 31, hh = lane >> 5;
        const int b = unit & 7, t0 = 256 + 16 * (111 - (unit >> 3));
        const size_t tok0 = (size_t)b * NT + t0;
        if (tid < 128) swi[tid] = SMALL[(tok0 + (tid >> 3)) * 32 + 16 + (tid & 7)] * 0.04419417382415922f;
        const int tokr = ((r >> 2) & 1) | ((r >> 4) << 1), headr = (r & 3) | (((r >> 3) & 1) << 2);
        bf16x8 af[4][4];
#pragma unroll
        for (int mt = 0; mt < 4; ++mt)
#pragma unroll
            for (int s = 0; s < 4; ++s) af[mt][s] = *(const bf16x8*)(QI + (tok0 + 4 * mt + tokr) * 512 + headr * 64 + 16 * s + 8 * hh);
        __syncthreads();
        const int ntiles = (t0 + 16 + 31) >> 5;
        bf16x8 bnx[4];
        if (wave < ntiles) {
#pragma unroll
            for (int s = 0; s < 4; ++s) bnx[s] = *(const bf16x8*)(KI + ((size_t)b * NT + 32 * wave + r) * 64 + 16 * s + 8 * hh);
        }
#pragma unroll 1
        for (int nt = wave; nt < ntiles; nt += NWAVES) {
            const int key = 32 * nt + r;
            bf16x8 bfr[4];
#pragma unroll
            for (int s = 0; s < 4; ++s) bfr[s] = bnx[s];
            if (nt + NWAVES < ntiles) {
#pragma unroll
                for (int s = 0; s < 4; ++s) bnx[s] = *(const bf16x8*)(KI + ((size_t)b * NT + key + 32 * NWAVES) * 64 + 16 * s + 8 * hh);
            }
#pragma unroll
            for (int mt = 0; mt < 4; ++mt) {
                f32x16 acc;
#pragma unroll
                for (int e = 0; e < 16; ++e) acc[e] = 0.f;
#pragma unroll
                for (int s = 0; s < 4; ++s) acc = MFMA32(af[mt][s], bfr[s], acc);
                const int ta = 4 * mt + hh, tb = ta + 2;
                const f32x4 wa0 = *(const LAS f32x4*)(swi + ta * 8), wa1 = *(const LAS f32x4*)(swi + ta * 8 + 4), wb0 = *(const LAS f32x4*)(swi + tb * 8), wb1 = *(const LAS f32x4*)(swi + tb * 8 + 4);
                float s0 = 0.f, s1 = 0.f;
#pragma unroll
                for (int e = 0; e < 4; ++e) { s0 += wa0[e] * fmaxf(acc[e], 0.f); s0 += wa1[e] * fmaxf(acc[4 + e], 0.f); s1 += wb0[e] * fmaxf(acc[8 + e], 0.f); s1 += wb1[e] * fmaxf(acc[12 + e], 0.f); }
                sc[ta * 2048 + key] = s0; sc[tb * 2048 + key] = s1;
            }
        }
        __syncthreads();
#pragma unroll 1
        for (int tt = 0; tt < 2; ++tt) {
            const int ti = 2 * wave + tt, t = t0 + ti;
            unsigned u[32];
#pragma unroll
            for (int i = 0; i < 32; ++i) {
                const int key = lane + 64 * i;
                float x = sc[ti * 2048 + key] + 0.0f;
                unsigned v = __float_as_uint(x); v = (v & 0x80000000u) ? ~v : (v | 0x80000000u);
                u[i] = (key <= t) ? v : 0u;
            }
            unsigned P = 0u, Q = 0xFFFFFFFFu; int cQ = 0, cP = 2048;
            bool exact = false; int bit = 31;
#pragma unroll 1
            for (; bit >= 0; --bit) {
                const unsigned cand = P | (1u << bit);
                int cl = 0;
#pragma unroll
                for (int i = 0; i < 32; ++i) cl += (u[i] >= cand) ? 1 : 0;
                int cnt = 0;
#pragma unroll
                for (int bb = 0; bb < 6; ++bb) cnt += __popcll(__ballot((cl >> bb) & 1)) << bb;
                if (cnt >= 256) { P = cand; cP = cnt; if (cnt == 256) { exact = true; break; } }
                else { Q = cand; cQ = cnt; }
                if (cP - cQ <= 64) { --bit; break; }
            }
            if (!exact && bit >= 0) {
                LAS unsigned* wsc = (LAS unsigned*)(lds + D1_WI + 512) + wave * 64;
                int pos = 0;
#pragma unroll
                for (int i = 0; i < 32; ++i) { const bool in = (u[i] >= P) && (u[i] < Q); const unsigned long long m = __ballot(in);
                    if (in) wsc[pos + __builtin_amdgcn_mbcnt_hi((unsigned)(m >> 32), __builtin_amdgcn_mbcnt_lo((unsigned)m, 0u))] = u[i];
                    pos += __popcll(m); }
                const int mcnt = pos, rneed = 256 - cQ;
                const unsigned x = (lane < mcnt) ? wsc[lane] : 0u;
                int gt = 0;
                for (int m2 = 0; m2 < mcnt; ++m2) { const unsigned y = (unsigned)__builtin_amdgcn_readlane((int)x, m2); gt += (y > x) ? 1 : 0; }
                unsigned cand2 = (lane < mcnt && gt < rneed) ? x : 0xFFFFFFFFu;
#pragma unroll
                for (int o = 32; o > 0; o >>= 1) { const unsigned y = (unsigned)__shfl_xor((int)cand2, o); cand2 = y < cand2 ? y : cand2; }
                P = cand2;
                const int gtc = __popcll(__ballot(lane < mcnt && x > cand2)), eqc = __popcll(__ballot(lane < mcnt && x == cand2));
                exact = (cQ + gtc + eqc == 256);
            }
            u16_t* out = IDX + (tok0 + ti) * 256;
            int pos = 0;
            if (exact) {
#pragma unroll
                for (int i = 0; i < 32; ++i) { const bool sel = u[i] >= P; const unsigned long long m = __ballot(sel);
                    if (sel) out[pos + __builtin_amdgcn_mbcnt_hi((unsigned)(m >> 32), __builtin_amdgcn_mbcnt_lo((unsigned)m, 0u))] = (u16_t)(lane + 64 * i);
                    pos += __popcll(m); }
            } else {
#pragma unroll
                for (int i = 0; i < 32; ++i) { const bool sel = u[i] > P; const unsigned long long m = __ballot(sel);
                    if (sel) out[pos + __builtin_amdgcn_mbcnt_hi((unsigned)(m >> 32), __builtin_amdgcn_mbcnt_lo((unsigned)m, 0u))] = (u16_t)(lane + 64 * i);
                    pos += __popcll(m); }
                int need = 256 - pos;
#pragma unroll
                for (int i = 0; i < 32; ++i) { const bool eq = u[i] == P; const unsigned long long m = __ballot(eq);
                    const int rk = __builtin_amdgcn_mbcnt_hi((unsigned)(m >> 32), __builtin_amdgcn_mbcnt_lo((unsigned)m, 0u));
                    if (eq && rk < need) out[pos + rk] = (u16_t)(lane + 64 * i);
                    const int c = __popcll(m), take = c < need ? c : need; pos += take; need -= take; }
            }
        }
        __syncthreads();
    }
}
__device__ __forceinline__ void ckvnorm_phase(const Params& p) {
    const int tid = threadIdx.x, lane = tid & 63, wave = tid >> 6, G = gridDim.x;
    bf16_t* CKV = (bf16_t*)(p.ws + OFF_CKV); const float* g = p.in[11];
    const f32x4 gv = *(const f32x4*)(g + 4 * lane);
    for (int row = blockIdx.x * NWAVES + wave; row < MROWS; row += G * NWAVES) {
        u32x2* rp = (u32x2*)(CKV + (size_t)row * 256 + 4 * lane);
        const u32x2 w = *rp; const float v0 = bflo(w.x), v1 = bfhi(w.x), v2 = bflo(w.y), v3 = bfhi(w.y);
        const float ss = wave_sum(v0 * v0 + v1 * v1 + v2 * v2 + v3 * v3);
        const float rs = rsqrtf(ss * (1.f / 256.f) + 1e-6f);
        u32x2 o; o.x = cvt_pk_bf16(v0 * rs * gv[0], v1 * rs * gv[1]); o.y = cvt_pk_bf16(v2 * rs * gv[2], v3 * rs * gv[3]);
        *rp = o;
    }
}
__device__ __forceinline__ void topk_naive_phase(const Params& p, LAS unsigned char* lds) {
    const int tid = threadIdx.x, G = gridDim.x;
    const bf16_t* QI = (const bf16_t*)(p.ws + OFF_QI); const bf16_t* KI = (const bf16_t*)(p.ws + OFF_KI); const float* SMALL = (const float*)(p.ws + OFF_SMALL);
    u16_t* IDX = (u16_t*)((char*)p.out + OO_IDX);
    LAS float* s_score = (LAS float*)lds; LAS float* s_qi = s_score + 2048; LAS float* s_wi = s_qi + 512; LAS int* s_cnt = (LAS int*)(s_wi + 8);
    for (int row = blockIdx.x; row < MROWS; row += G) {
        const int b = row >> 11, t = row & 2047;
        if (t < 256) continue;
        for (int i = tid; i < 512; i += NTHR) s_qi[i] = bf2f(QI[(size_t)row * 512 + i]);
        if (tid < 8) s_wi[tid] = SMALL[(size_t)row * 32 + 16 + tid] * 0.04419417382415922f;
        if (tid == 0) *s_cnt = 0;
        __syncthreads();
        const int nvalid = t + 1;
        for (int s = tid; s < nvalid; s += NTHR) {
            const bf16_t* kr = KI + ((size_t)b * NT + s) * 64;
            float acc[8];
#pragma unroll
            for (int hh = 0; hh < 8; ++hh) acc[hh] = 0.f;
            for (int d = 0; d < 64; ++d) { const float kd = bf2f(kr[d]);
#pragma unroll
                for (int hh = 0; hh < 8; ++hh) acc[hh] += s_qi[hh * 64 + d] * kd; }
            float sc = 0.f;
#pragma unroll
            for (int hh = 0; hh < 8; ++hh) sc += s_wi[hh] * fmaxf(acc[hh], 0.f);
            s_score[s] = sc;
        }
        __syncthreads();
        for (int s = tid; s < nvalid; s += NTHR) {
            const float v = s_score[s]; int rank = 0;
            for (int s2 = 0; s2 < nvalid; ++s2) { const float v2 = s_score[s2]; rank += (v2 > v || (v2 == v && s2 < s)) ? 1 : 0; }
            if (rank < 256) { const int pos = atomicAdd((int*)s_cnt, 1); IDX[(size_t)row * 256 + pos] = (u16_t)s; }
        }
        __syncthreads();
    }
}

__global__ void __launch_bounds__(NTHR, 2) fwd(Params p) {
    extern __shared__ __attribute__((aligned(16))) unsigned char lds_raw[];
    LAS unsigned char* lds = (LAS unsigned char*)lds_raw;
    const int tid = threadIdx.x;
    for (int u = tid; u < (LDS_BYTES - LDSCTL_OFF) / 4; u += NTHR) ((LAS unsigned*)(lds + LDSCTL_OFF))[u] = 0u;
    __syncthreads();
    const Bufs B = make_bufs(p.ws, (char*)p.out);
    const int lo = p.ph_lo, hi = p.ph_hi;
    unsigned* barw = (unsigned*)(p.ws + OFF_CTL) + CW_BAR + p.li * XCD_BAR_WORDS;
    XcdBarrier bar; bar.bar = barw; bar.x = 0; bar.st = nullptr;
    if (hi - lo > 1) bar = xcd_barrier_post(barw, (volatile LAS unsigned*)(lds + LDSCTL_OFF + 64));
#define IN(k) (lo <= (k) && (k) < hi)
#define SEAM(k) do { if (IN(k) && IN((k) + 1)) xcd_barrier(bar); } while (0)
    if (IN(0)) { p0_prologue(p, B, lds); SEAM(0); }
    if (IN(1)) { p1_h(p, B); SEAM(1); }
    if (IN(2)) {
        SchedProj S; S.so.init(MROWS, NPAD, gridDim.x, blockIdx.x); S.A = (const char*)B.H; S.Bt = (const char*)B.WT;
        EpiProj E{p.ws, (char*)p.out};
        pg8::gemm_phase<EpiProj, SchedProj, true, true>(lds + RING_OFF, DM, DM, DM, S, E);
        SEAM(2);
    }
    if (IN(3)) { g1_phase(p, lds); ckvnorm_phase(p); SEAM(3); }
    if (IN(4)) { if (p.pad != 2) g2_phase(p, lds); d1_phase(p, lds); SEAM(4); }
    if (IN(5)) { qlat_phase(p, lds); SEAM(5); }
    if (IN(6)) { d2_phase(p, lds); SEAM(6); }
    if (IN(7)) { wuv_phase(p, lds); SEAM(7); }
    if (IN(8)) {
        SchedMerge S; S.so.init(MROWS, DM, gridDim.x, blockIdx.x); S.ws = p.ws; S.os = (const char*)p.out;
        EpiMerge E{B.MERGED, B.PARK};
        pg8::gemm_phase<EpiMerge, SchedMerge, true, true>(lds + RING_OFF, DM, DM, DM, S, E);
        SEAM(8);
    }
    if (IN(9)) {
        SchedProj S; S.so.init(MROWS, DM, gridDim.x, blockIdx.x); S.A = (const char*)B.MERGED; S.Bt = (const char*)B.WOUT_T;
        EpiOut E{p.in[0], B.MOD, B.XNEW};
        pg8::gemm_phase<EpiOut, SchedProj, true, true>(lds + RING_OFF, DM, DM, DM, S, E);
        SEAM(9);
    }
    if (IN(10)) { p8_final(p, B); }
#undef IN
#undef SEAM
}

__global__ void k_ckvnorm(bf16_t* __restrict__ CKV, const float* __restrict__ g) {
    const int row = blockIdx.x * 4 + (threadIdx.x >> 6), lane = threadIdx.x & 63;
    bf16_t* r = CKV + (size_t)row * 256; float v[4]; float ss = 0.f;
#pragma unroll
    for (int i = 0; i < 4; ++i) { v[i] = bf2f(r[lane + 64 * i]); ss += v[i] * v[i]; }
    ss = wave_sum(ss);
    const float rs = rsqrtf(ss * (1.f / 256.f) + 1e-6f);
#pragma unroll
    for (int i = 0; i < 4; ++i) r[lane + 64 * i] = f2bf(v[i] * rs * g[lane + 64 * i]);
}

__global__ void __launch_bounds__(256) k_gdn_naive(Bufs B, const float* __restrict__ conv_w, const float* __restrict__ a_log, const float* __restrict__ dt_bias,
                                                   const float* __restrict__ gdn_norm_g) {
    const int b = blockIdx.x >> 3, h = blockIdx.x & 7, tid = threadIdx.x, dv = tid & 127, half = tid >> 7, wv = tid >> 6;
    __shared__ float sq[128], sk[128], sv[128], part[2][128], part2[2][128], sred[4], sred2[2];
    float S[64];
#pragma unroll
    for (int i = 0; i < 64; ++i) S[i] = 0.f;
    const int ch0 = (half == 0 ? 0 : 1024) + h * 128 + dv, ch1 = 2048 + h * 128 + dv;
    float w0[4], w1[4];
#pragma unroll
    for (int j = 0; j < 4; ++j) { w0[j] = conv_w[j * 3072 + ch0]; w1[j] = conv_w[j * 3072 + ch1]; }
    float h0a = 0.f, h0b = 0.f, h0c = 0.f, h1a = 0.f, h1b = 0.f, h1c = 0.f;
    const float Aexp = __expf(a_log[h]), dtb = dt_bias[h], gn = gdn_norm_g[dv];
    const bf16_t* src0 = (half == 0 ? B.QA : B.KA);
    for (int t = 0; t < NT; ++t) {
        const size_t row = (size_t)b * NT + t;
        const float raw0 = bf2f(src0[row * 1024 + h * 128 + dv]);
        const float y0 = silu_f(w0[0] * h0a + w0[1] * h0b + w0[2] * h0c + w0[3] * raw0);
        h0a = h0b; h0b = h0c; h0c = raw0;
        if (half == 0) {
            const float raw1 = bf2f(B.VA[row * 1024 + h * 128 + dv]);
            const float y1 = silu_f(w1[0] * h1a + w1[1] * h1b + w1[2] * h1c + w1[3] * raw1);
            h1a = h1b; h1b = h1c; h1c = raw1;
            sq[dv] = y0; sv[dv] = y1;
        } else sk[dv] = y0;
        const float s2 = wave_sum(y0 * y0);
        if ((tid & 63) == 0) sred[wv] = s2;
        __syncthreads();
        const float qn = rsqrtf(sred[0] + sred[1] + 1e-6f) * 0.08838834764831845f, kn = rsqrtf(sred[2] + sred[3] + 1e-6f);
        const float beta = sigmoid_f(B.SMALL[row * 32 + 8 + h]);
        const float xg = B.SMALL[row * 32 + h] + dtb;
        const float sp = xg > 20.f ? xg : log1pf(__expf(xg));
        const float a = __expf(-Aexp * sp);
        float p = 0.f;
#pragma unroll
        for (int i = 0; i < 64; ++i) p += sk[half * 64 + i] * S[i];
        part[half][dv] = p * kn;
        __syncthreads();
        const float kS = part[0][dv] + part[1][dv];
        const float vnew = beta * (sv[dv] - a * kS);
        float o = 0.f;
#pragma unroll
        for (int i = 0; i < 64; ++i) { S[i] = a * S[i] + (sk[half * 64 + i] * kn) * vnew; o += sq[half * 64 + i] * S[i]; }
        part2[half][dv] = o * qn;
        __syncthreads();
        float ov = 0.f;
        if (half == 0) {
            ov = part2[0][dv] + part2[1][dv];
            const float o2 = wave_sum(ov * ov);
            if ((tid & 63) == 0) sred2[wv] = o2;
        }
        __syncthreads();
        if (half == 0) {
            const float rs = rsqrtf((sred2[0] + sred2[1]) * (1.f / 128.f) + 1e-6f);
            const size_t zi = row * 1024 + h * 128 + dv;
            const float z = bf2f(B.ZA[zi]);
            B.ZA[zi] = f2bf(ov * rs * gn * silu_f(z));
        }
    }
}


__global__ void __launch_bounds__(256) k_gdn_naive2(Bufs B, const float* __restrict__ DEC, const float* __restrict__ gdn_norm_g) {
    const int b = blockIdx.x >> 3, h = blockIdx.x & 7, tid = threadIdx.x, dv = tid & 127, half = tid >> 7, wv = tid >> 6;
    __shared__ float sq[128], sk[128], sv[128], part[2][128], part2[2][128], sred2[2];
    float S[64];
#pragma unroll
    for (int i = 0; i < 64; ++i) S[i] = 0.f;
    const float gn = gdn_norm_g[dv];
    for (int t = 0; t < NT; ++t) {
        const size_t row = (size_t)b * NT + t;
        if (half == 0) { sq[dv] = bf2f(B.QA[row * 1024 + h * 128 + dv]); sv[dv] = bf2f(B.VA[row * 1024 + h * 128 + dv]); }
        else sk[dv] = bf2f(B.KA[row * 1024 + h * 128 + dv]);
        const float* dec = DEC + (size_t)((b * 8 + h) * 32 + (t >> 6)) * 256;
        const float a = __expf(dec[128 + (t & 63)]), beta = dec[192 + (t & 63)];
        __syncthreads();
        float pp = 0.f;
#pragma unroll
        for (int i = 0; i < 64; ++i) pp += sk[half * 64 + i] * S[i];
        part[half][dv] = pp;
        __syncthreads();
        const float kS = part[0][dv] + part[1][dv];
        const float vnew = beta * (sv[dv] - a * kS);
        float o = 0.f;
#pragma unroll
        for (int i = 0; i < 64; ++i) { S[i] = a * S[i] + sk[half * 64 + i] * vnew; o += sq[half * 64 + i] * S[i]; }
        part2[half][dv] = o;
        __syncthreads();
        float ov = 0.f;
        if (half == 0) { ov = part2[0][dv] + part2[1][dv]; const float o2 = wave_sum(ov * ov); if ((tid & 63) == 0) sred2[wv] = o2; }
        __syncthreads();
        if (half == 0) {
            const float rs = rsqrtf((sred2[0] + sred2[1]) * (1.f / 128.f) + 1e-6f);
            const size_t zi = row * 1024 + h * 128 + dv;
            B.ZA[zi] = f2bf(ov * rs * gn * silu_f(bf2f(B.ZA[zi])));
        }
    }
}

__global__ void __launch_bounds__(256) k_topk_naive(Bufs B, u16_t* __restrict__ IDX) {
    const int row = blockIdx.x, b = row >> 11, t = row & 2047, tid = threadIdx.x;
    if (t < 256) return;
    __shared__ float s_score[2048], s_qi[512], s_wi[8];
    __shared__ int s_cnt;
    for (int i = tid; i < 512; i += 256) s_qi[i] = bf2f(B.QI[(size_t)row * 512 + i]);
    if (tid < 8) s_wi[tid] = B.SMALL[(size_t)row * 32 + 16 + tid] * 0.04419417382415922f;
    if (tid == 0) s_cnt = 0;
    __syncthreads();
    const int nvalid = t + 1;
    for (int s = tid; s < nvalid; s += 256) {
        const bf16_t* kr = B.KI + ((size_t)b * NT + s) * 64;
        float acc[8];
#pragma unroll
        for (int hh = 0; hh < 8; ++hh) acc[hh] = 0.f;
        for (int d = 0; d < 64; ++d) { const float kd = bf2f(kr[d]);
#pragma unroll
            for (int hh = 0; hh < 8; ++hh) acc[hh] += s_qi[hh * 64 + d] * kd; }
        float sc = 0.f;
#pragma unroll
        for (int hh = 0; hh < 8; ++hh) sc += s_wi[hh] * fmaxf(acc[hh], 0.f);
        s_score[s] = sc;
    }
    __syncthreads();
    for (int s = tid; s < nvalid; s += 256) {
        const float v = s_score[s]; int rank = 0;
        for (int s2 = 0; s2 < nvalid; ++s2) { const float v2 = s_score[s2]; rank += (v2 > v || (v2 == v && s2 < s)) ? 1 : 0; }
        if (rank < 256) { const int pos = atomicAdd(&s_cnt, 1); IDX[(size_t)row * 256 + pos] = (u16_t)s; }
    }
}
__global__ void __launch_bounds__(256) k_dsa_naive(Bufs B, const float* __restrict__ w_uk, const float* __restrict__ w_uv, const float* __restrict__ rel_bias) {
    const int row = blockIdx.x, b = row >> 11, t = row & 2047, tid = threadIdx.x, lane = tid & 63, wv = tid >> 6;
    __shared__ float s_score[2048], s_qi[512], s_wi[8], s_q[1024], s_qlat[2048], s_p[2048], s_ol[2048];
    __shared__ int s_sel[256]; __shared__ int s_cnt;
    for (int i = tid; i < 512; i += 256) s_qi[i] = bf2f(B.QI[(size_t)row * 512 + i]);
    for (int i = tid; i < 1024; i += 256) s_q[i] = bf2f(B.QB[(size_t)row * 1024 + i]);
    if (tid < 8) s_wi[tid] = B.SMALL[(size_t)row * 32 + 16 + tid] * 0.04419417382415922f;
    if (tid == 0) s_cnt = 0;
    __syncthreads();
    const int nvalid = t + 1;
    for (int s = tid; s < nvalid; s += 256) {
        const bf16_t* kr = B.KI + ((size_t)b * NT + s) * 64;
        float acc[8];
#pragma unroll
        for (int hh = 0; hh < 8; ++hh) acc[hh] = 0.f;
        for (int d = 0; d < 64; ++d) { const float kd = bf2f(kr[d]);
#pragma unroll
            for (int hh = 0; hh < 8; ++hh) acc[hh] += s_qi[hh * 64 + d] * kd; }
        float sc = 0.f;
#pragma unroll
        for (int hh = 0; hh < 8; ++hh) sc += s_wi[hh] * fmaxf(acc[hh], 0.f);
        s_score[s] = sc;
    }
    __syncthreads();
    int nsel;
    if (nvalid <= 256) { for (int s = tid; s < nvalid; s += 256) s_sel[s] = s; nsel = nvalid; }
    else {
        for (int s = tid; s < nvalid; s += 256) {
            const float v = s_score[s]; int rank = 0;
            for (int s2 = 0; s2 < nvalid; ++s2) { const float v2 = s_score[s2]; rank += (v2 > v || (v2 == v && s2 < s)) ? 1 : 0; }
            if (rank < 256) { const int pos = atomicAdd(&s_cnt, 1); s_sel[pos] = s; }
        }
        nsel = 256;
    }
    for (int o = tid; o < 2048; o += 256) {
        const int hh = o >> 8, c = o & 255; const float* wr = w_uk + (size_t)c * 1024 + hh * 128; float d = 0.f;
        for (int k = 0; k < 128; ++k) d += s_q[hh * 128 + k] * wr[k];
        s_qlat[o] = d * 0.08838834764831845f;
    }
    __syncthreads();
    for (int o = tid; o < 2048; o += 256) {
        const int hh = o >> 8, k = o & 255;
        if (k < nsel) {
            const int s = s_sel[k]; const bf16_t* cr = B.CKV + ((size_t)b * NT + s) * 256; float d = 0.f;
            for (int c = 0; c < 256; ++c) d += s_qlat[hh * 256 + c] * bf2f(cr[c]);
            s_p[o] = d + rel_bias[t5_bucket(t - s) * 8 + hh];
        }
    }
    __syncthreads();
    for (int hh = wv; hh < 8; hh += 4) {
        float m = -3.0e38f;
        for (int k = lane; k < nsel; k += 64) m = fmaxf(m, s_p[hh * 256 + k]);
        m = wave_max(m);
        float sum = 0.f;
        for (int k = lane; k < nsel; k += 64) { const float e = __expf(s_p[hh * 256 + k] - m); s_p[hh * 256 + k] = e; sum += e; }
        sum = wave_sum(sum);
        const float inv = 1.f / sum;
        for (int k = lane; k < nsel; k += 64) s_p[hh * 256 + k] *= inv;
    }
    __syncthreads();
    for (int o = tid; o < 2048; o += 256) {
        const int hh = o >> 8, c = o & 255; float d = 0.f;
        for (int k = 0; k < nsel; ++k) d += s_p[hh * 256 + k] * bf2f(B.CKV[((size_t)b * NT + s_sel[k]) * 256 + c]);
        s_ol[o] = d;
    }
    __syncthreads();
    for (int o = tid; o < 1024; o += 256) {
        const int hh = o >> 7, d = o & 127; float acc = 0.f;
        for (int c = 0; c < 256; ++c) acc += s_ol[hh * 256 + c] * w_uv[(size_t)c * 1024 + hh * 128 + d];
        const float z = bf2f(B.ZB[(size_t)row * 1024 + o]);
        B.QB[(size_t)row * 1024 + o] = f2bf(acc * silu_f(z));
    }
}

#ifndef PROBE_SEQ
#define PROBE_SEQ 0
#endif

extern "C" void kernel_launch(void* const* d_in, const int* in_sizes, int n_in, void* d_out, int out_size, void* d_ws, size_t ws_size, hipStream_t stream) {
    static int grid = 0;
    if (grid == 0) {
        if (n_in != 18 || ws_size < WS_NEED || out_size != MROWS * DM) { fprintf(stderr, "kernel_launch: unexpected shapes (n_in %d, ws %zu, out %d)\n", n_in, ws_size, out_size); grid = -1; return; }
        int dev = 0, cus = 0;
        if (hipGetDevice(&dev) != hipSuccess || hipDeviceGetAttribute(&cus, hipDeviceAttributeMultiprocessorCount, dev) != hipSuccess) { grid = -1; return; }
        if (hipFuncSetAttribute((const void*)fwd, hipFuncAttributeMaxDynamicSharedMemorySize, LDS_BYTES) != hipSuccess) { fprintf(stderr, "kernel_launch: hipFuncSetAttribute failed\n"); grid = -1; return; }
        int per_cu = 0;
        if (hipOccupancyMaxActiveBlocksPerMultiprocessor(&per_cu, (const void*)fwd, NTHR, LDS_BYTES) != hipSuccess || per_cu < 1) fprintf(stderr, "kernel_launch: occupancy query says %d\n", per_cu);
        (void)hipGetLastError();
        grid = cus > 0 ? cus : 256;
    }
    if (grid < 0) return;
    const float* conv_w = (const float*)d_in[6]; const float* a_log = (const float*)d_in[7]; const float* dt_bias = (const float*)d_in[8];
    const float* gdn_norm_g = (const float*)d_in[9]; const float* kv_norm_g = (const float*)d_in[11];
    const float* w_uk = (const float*)d_in[12]; const float* w_uv = (const float*)d_in[13]; const float* rel_bias = (const float*)d_in[16];
    (void)hipMemsetAsync((char*)d_ws + OFF_CTL, 0, CTL_ZERO_BYTES, stream);
    Params p{};
    for (int i = 0; i < 18; ++i) p.in[i] = (const float*)d_in[i];
    p.out = (float*)d_out; p.ws = (char*)d_ws;
    const Bufs B = make_bufs((char*)d_ws, (char*)d_out);
    int li = 0;
#define FWD(lo_, hi_) do { p.pad = 0; p.ph_lo = (lo_); p.ph_hi = (hi_); p.li = ((hi_) - (lo_) > 1) ? li++ : 0; hipLaunchKernelGGL(fwd, dim3(grid), dim3(NTHR), LDS_BYTES, stream, p); } while (0)
#define DRY(lo_, hi_) do { p.pad = 1; p.ph_lo = (lo_); p.ph_hi = (hi_); p.li = 0; hipLaunchKernelGGL(fwd, dim3(grid), dim3(NTHR), LDS_BYTES, stream, p); } while (0)
#if PROBE_SEQ == 0
    FWD(0, 11);
#elif PROBE_SEQ == 1
    FWD(0, 3); DRY(3, 4); FWD(3, 11);
#elif PROBE_SEQ == 2
    FWD(0, 4); DRY(4, 5); FWD(4, 11);
#elif PROBE_SEQ == 3
    FWD(0, 6); DRY(6, 7); FWD(6, 11);
#elif PROBE_SEQ == 4
    FWD(0, 4); p.pad = 2; p.ph_lo = 4; p.ph_hi = 5; p.li = 0; hipLaunchKernelGGL(fwd, dim3(grid), dim3(NTHR), LDS_BYTES, stream, p); FWD(4, 11);
#endif
#undef FWD
}
```

```cpp
#include <hip/hip_runtime.h>
#include <stdint.h>
#include <stdio.h>

#define LAS __attribute__((address_space(3)))
typedef unsigned short bf16_t;
typedef short bf16x8 __attribute__((ext_vector_type(8)));
typedef float f32x4 __attribute__((ext_vector_type(4)));
typedef unsigned u32x4 __attribute__((ext_vector_type(4)));
typedef unsigned u32x2 __attribute__((ext_vector_type(2)));
__device__ __forceinline__ float bf2f(bf16_t v) { return __uint_as_float(((unsigned)v) << 16); }
__device__ __forceinline__ bf16_t f2bf(float f) { unsigned u = __float_as_uint(f); u += 0x7FFFu + ((u >> 16) & 1u); return (bf16_t)(u >> 16); }
__device__ __forceinline__ float bflo(unsigned w) { return __uint_as_float(w << 16); }
__device__ __forceinline__ float bfhi(unsigned w) { return __uint_as_float(w & 0xFFFF0000u); }
__device__ __forceinline__ unsigned cvt_pk_bf16(float lo, float hi) { unsigned r; asm volatile("v_cvt_pk_bf16_f32 %0, %1, %2" : "=v"(r) : "v"(lo), "v"(hi)); return r; }
__device__ __forceinline__ float silu_f(float x) { return x * __builtin_amdgcn_rcpf(1.f + __expf(-x)); }
__device__ __forceinline__ float sigmoid_f(float x) { return __builtin_amdgcn_rcpf(1.f + __expf(-x)); }
__device__ __forceinline__ float wave_sum(float v) {
#pragma unroll
    for (int o = 32; o > 0; o >>= 1) v += __shfl_xor(v, o);
    return v;
}
__device__ __forceinline__ float wave_max(float v) {
#pragma unroll
    for (int o = 32; o > 0; o >>= 1) v = fmaxf(v, __shfl_xor(v, o));
    return v;
}

constexpr int NB = 8, NT = 2048, DM = 1024, MROWS = NB * NT;
constexpr int NPAD = 7168;
constexpr int NWT = 9216;
constexpr size_t MiB = 1ull << 20;
constexpr size_t OFF_CTL = 0, CTL_ZERO_BYTES = 64 * 1024, OFF_MOD = 64 * 1024, OFF_SMALL = 1 * MiB, OFF_KI = 3 * MiB, OFF_CKV = 5 * MiB, OFF_QI = 13 * MiB,
                 OFF_QA = 29 * MiB, OFF_KA = 61 * MiB, OFF_VA = 93 * MiB, OFF_ZA = 125 * MiB, OFF_QB = 157 * MiB, OFF_ZB = 189 * MiB,
                 OFF_H = 221 * MiB, OFF_WOUT_T = 253 * MiB, WS_NEED = 255 * MiB;
constexpr size_t OFF_XNEW = OFF_QA, OFF_MERGED = OFF_VA, OFF_PARK = OFF_KA;
constexpr size_t OO_WT = 0, OO_WOG_T = 18 * MiB, OO_WOD_T = 20 * MiB;
constexpr size_t OO_TPATT = 31 * MiB;
constexpr size_t OO_STASH = 55 * MiB;
constexpr size_t OO_DEC = 60 * MiB;
constexpr size_t OO_WUK_B = 22 * MiB;
constexpr size_t OO_WUV_T = 22 * MiB + 512 * 1024;
constexpr size_t OO_IDX = 23 * MiB;
constexpr int CW_BAR = 1024, CW_D1Q = 64;

__host__ __device__ __forceinline__ int wt_col(int n) {
    if (n < 4096) return n;
    if (n < 5120) return 4112 + (n - 4096);
    if (n < 6144) return 5392 + (n - 5120);
    if (n < 6400) return 5136 + (n - 6144);
    if (n < 6912) return 6416 + (n - 6400);
    if (n < 6976) return 6928 + (n - 6912);
    if (n < 6984) return 4096 + (n - 6976);
    if (n < 6992) return 4104 + (n - 6984);
    if (n < 7000) return 6992 + (n - 6992);
    if (n < 7168) return -1;
    return 7000 + (n - 7168);
}

struct Bufs {
    bf16_t *QA, *KA, *VA, *ZA, *QB, *ZB, *CKV, *QI, *KI, *H, *WT, *WOG_T, *WOD_T, *WOUT_T, *MERGED, *PARK;
    float *SMALL, *MOD, *XNEW;
};
__host__ __device__ __forceinline__ Bufs make_bufs(char* ws, char* os) {
    Bufs B;
    B.QA = (bf16_t*)(ws + OFF_QA); B.KA = (bf16_t*)(ws + OFF_KA); B.VA = (bf16_t*)(ws + OFF_VA); B.ZA = (bf16_t*)(ws + OFF_ZA);
    B.QB = (bf16_t*)(ws + OFF_QB); B.ZB = (bf16_t*)(ws + OFF_ZB); B.CKV = (bf16_t*)(ws + OFF_CKV); B.QI = (bf16_t*)(ws + OFF_QI);
    B.KI = (bf16_t*)(ws + OFF_KI); B.H = (bf16_t*)(ws + OFF_H); B.WT = (bf16_t*)(os + OO_WT); B.WOG_T = (bf16_t*)(os + OO_WOG_T);
    B.WOD_T = (bf16_t*)(os + OO_WOD_T); B.WOUT_T = (bf16_t*)(ws + OFF_WOUT_T); B.MERGED = (bf16_t*)(ws + OFF_MERGED); B.PARK = (bf16_t*)(ws + OFF_PARK);
    B.SMALL = (float*)(ws + OFF_SMALL); B.MOD = (float*)(ws + OFF_MOD); B.XNEW = (float*)(ws + OFF_XNEW);
    return B;
}

namespace pg8 {
#define PG8_LAS __attribute__((address_space(3)))
constexpr int BM = 256, BK = 64, HALF = 128, HTB = HALF * BK * 2  , STAGE_BYTES = 8 * HTB, NXCD = 8, WGM = 8;
__host__ __device__ __forceinline__ int lds_byte(int r, int c) { const int st = (r >> 4) * 2 + (c >> 5), rr = r & 15, cc = c & 31, ob = rr * 64 + cc * 2; return st * 1024 + (ob ^ (((ob >> 9) & 1) << 5)); }
__host__ __device__ __forceinline__ void stage_rc(int b, int& R, int& C) { const int st = b / 1024, sb = b % 1024, swz = sb ^ (((sb >> 9) & 1) << 5); R = (st >> 1) * 16 + swz / 64; C = (st & 1) * 32 + (swz % 64) / 2; }
__host__ __device__ __forceinline__ int perm32(int rho) { const int n = rho >> 4, i = rho & 15; return 8 * (i >> 2) + 4 * n + (i & 3); }
struct Unit { int pm, pn, st; };
struct StaticOrder {
    int nM, nN, nwg, G, c;
    __host__ __device__ void init(int M, int N, int G_, int c_) { nM = M / BM; nN = N / BM; nwg = nM * nN; G = G_; c = c_; }
    __host__ __device__ bool tile(int i, int& pm, int& pn) const {
        const long L = (long)i * G + c; if (L >= nwg) return false;
        int wgid = (int)L; { const int q = nwg / NXCD, r = nwg % NXCD, xcd = wgid % NXCD, off = wgid / NXCD; wgid = (xcd < r ? xcd * (q + 1) : r * (q + 1) + (xcd - r) * q) + off; }
        const int nig = WGM * nN, gid = wgid / nig, fm = gid * WGM, gsz = (nM - fm) < WGM ? (nM - fm) : WGM;
        pm = fm + ((wgid % nig) % gsz); pn = (wgid % nig) / gsz; return true;
    }
};
template <class Epi, class Sched, bool ALIGN_EPI = false, bool SP2 = false>
__device__ __forceinline__ void gemm_phase(PG8_LAS unsigned char* lds, const int K, const int lda, const int ldb, const Sched& S, const Epi& E) {
    const int tid = threadIdx.x, wid = __builtin_amdgcn_readfirstlane(tid >> 6), lane = tid & 63, wr = wid >> 2, wc = wid & 3, fr = lane & 15, fq = lane >> 4;
    const int nt = K / BK;
    unsigned voffA[2], voffB[2];
#pragma unroll
    for (int i = 0; i < 2; ++i) { int R, C; stage_rc(tid * 16 + i * 8192, R, C); const int Rb = Epi::PERM ? ((R & ~31) + perm32(R & 31)) : R;
        voffA[i] = (unsigned)(R * lda + C) * 2u; voffB[i] = (unsigned)(Rb * ldb + C) * 2u; }
    const size_t kstep = (size_t)(BK * 2);
    const size_t hstepA = (size_t)HALF * lda * 2, hstepB = (size_t)HALF * ldb * 2;
    const unsigned ldsw = (unsigned)wid * 1024u;
    const int aoff = lds_byte(wr * 64 + fr, fq * 8), boff = lds_byte(wc * 32 + fr, fq * 8);
#define PG8_SA(b, h) (((b) * 2 + (h)) * HTB)
#define PG8_SB(b, h) ((4 + (b) * 2 + (h)) * HTB)
#define PG8_STAGE(bufoff, gbase, voff) do { _Pragma("unroll") for (int _i = 0; _i < 2; ++_i) \
        __builtin_amdgcn_global_load_lds((const unsigned*)((const char*)(gbase) + (voff)[_i]), (PG8_LAS unsigned*)(lds + (bufoff) + ldsw + _i * 8192), 16, 0, 0); } while (0)
#define PG8_LDA(dst, b, h) do { _Pragma("unroll") for (int m = 0; m < 4; ++m) _Pragma("unroll") for (int k = 0; k < 2; ++k) dst[m][k] = *(const PG8_LAS bf16x8*)(lds + PG8_SA(b, h) + aoff + m * 2048 + k * 1024); } while (0)
#define PG8_LDB(dst, b, h) do { _Pragma("unroll") for (int n = 0; n < 2; ++n) _Pragma("unroll") for (int k = 0; k < 2; ++k) dst[n][k] = *(const PG8_LAS bf16x8*)(lds + PG8_SB(b, h) + boff + n * 2048 + k * 1024); } while (0)
#define PG8_MMA(ai, bj, At, Bt) do { __builtin_amdgcn_s_setprio(1); _Pragma("unroll") for (int m = 0; m < 4; ++m) _Pragma("unroll") for (int n = 0; n < 2; ++n) _Pragma("unroll") for (int k = 0; k < 2; ++k) \
        acc[ai][bj][m][n] = __builtin_amdgcn_mfma_f32_16x16x32_bf16(Bt[n][k], At[m][k], acc[ai][bj][m][n], 0, 0, 0); __builtin_amdgcn_s_setprio(0); } while (0)
#define PG8_WAIT_V(n) asm volatile("s_waitcnt vmcnt(" #n ")" ::: "memory")
#define PG8_WAIT_L(n) asm volatile("s_waitcnt lgkmcnt(" #n ")" ::: "memory")
#define PG8_BAR __builtin_amdgcn_s_barrier()
#define PG8_SCHED __builtin_amdgcn_sched_barrier(0)
    Unit cur, nxt; int ui = 0;
    if (!S.next(0, cur)) return;
    f32x4 acc[2][2][4][2];
#pragma unroll
    for (int a = 0; a < 2; ++a)
#pragma unroll
        for (int b = 0; b < 2; ++b)
#pragma unroll
            for (int m = 0; m < 4; ++m)
#pragma unroll
                for (int n = 0; n < 2; ++n) acc[a][b][m][n] = (f32x4){0.f, 0.f, 0.f, 0.f};
    bf16x8 At[4][2], B0[2][2], B1[2][2];
    const char* cA = S.a_ptr(cur); const char* cB = S.b_ptr(cur);
    S.a_ready(cur);
    if constexpr (SP2) {
        PG8_STAGE(PG8_SB(0, 0), cB, voffB); PG8_STAGE(PG8_SB(0, 1), cB + hstepB, voffB); PG8_STAGE(PG8_SA(0, 0), cA, voffA); PG8_STAGE(PG8_SA(0, 1), cA + hstepA, voffA);
        if (wr == 1) PG8_BAR;
        PG8_WAIT_V(2); PG8_BAR;
        PG8_STAGE(PG8_SB(1, 0), cB + kstep, voffB); PG8_STAGE(PG8_SA(1, 0), cA + kstep, voffA); PG8_STAGE(PG8_SB(1, 1), cB + hstepB + kstep, voffB);
        PG8_WAIT_V(6); PG8_BAR;
    } else {
        PG8_STAGE(PG8_SB(0, 0), cB, voffB); PG8_STAGE(PG8_SA(0, 0), cA, voffA); PG8_STAGE(PG8_SB(0, 1), cB + hstepB, voffB); PG8_STAGE(PG8_SA(0, 1), cA + hstepA, voffA);
        if (wr == 1) PG8_BAR;
        PG8_WAIT_V(4); PG8_BAR;
        PG8_STAGE(PG8_SB(1, 0), cB + kstep, voffB); PG8_STAGE(PG8_SA(1, 0), cA + kstep, voffA); PG8_STAGE(PG8_SB(1, 1), cB + hstepB + kstep, voffB);
        PG8_WAIT_V(6); PG8_BAR;
    }
    for (;;) {
        const bool has_next = S.next(ui + 1, nxt);
        const char* nA = has_next ? S.a_ptr(nxt) : cA; const char* nB = has_next ? S.b_ptr(nxt) : cB;
        for (int t = 0; t < nt; t += 2) {
            const bool last = (t == nt - 2);
            const char* a1 = cA + (size_t)(t + 1) * kstep;
            const char* a2 = last ? nA : cA + (size_t)(t + 2) * kstep; const char* b2 = last ? nB : cB + (size_t)(t + 2) * kstep;
            const char* a3 = a2 + kstep; const char* b3 = b2 + kstep;
            if (last && has_next) S.a_ready(nxt);
            if constexpr (SP2) {
            PG8_LDB(B0, 0, 0); PG8_LDB(B1, 0, 1); PG8_SCHED; PG8_LDA(At, 0, 0); PG8_STAGE(PG8_SA(1, 1), a1 + hstepA, voffA);
            PG8_WAIT_V(8); PG8_WAIT_L(0); PG8_BAR; PG8_MMA(0, 0, At, B0); PG8_MMA(0, 1, At, B1); PG8_BAR; PG8_SCHED;
            PG8_LDA(At, 0, 1); PG8_STAGE(PG8_SB(0, 0), b2, voffB); PG8_STAGE(PG8_SB(0, 1), b2 + hstepB, voffB); PG8_STAGE(PG8_SA(0, 0), a2, voffA);
            PG8_WAIT_V(8); PG8_WAIT_L(0); PG8_BAR; PG8_MMA(1, 0, At, B0); PG8_MMA(1, 1, At, B1); PG8_BAR; PG8_SCHED;
            PG8_LDB(B0, 1, 0); PG8_LDB(B1, 1, 1); PG8_SCHED; PG8_LDA(At, 1, 0); PG8_STAGE(PG8_SA(0, 1), a2 + hstepA, voffA);
            PG8_WAIT_V(8); PG8_WAIT_L(0); PG8_BAR; PG8_MMA(0, 0, At, B0); PG8_MMA(0, 1, At, B1); PG8_BAR; PG8_SCHED;
            PG8_LDA(At, 1, 1); PG8_STAGE(PG8_SB(1, 0), b3, voffB); PG8_STAGE(PG8_SB(1, 1), b3 + hstepB, voffB); PG8_STAGE(PG8_SA(1, 0), a3, voffA);
            PG8_WAIT_V(8); PG8_WAIT_L(0); PG8_BAR; PG8_MMA(1, 0, At, B0); PG8_MMA(1, 1, At, B1); PG8_BAR; PG8_SCHED;
            } else {
            PG8_LDB(B0, 0, 0); PG8_SCHED; PG8_LDA(At, 0, 0); PG8_STAGE(PG8_SA(1, 1), a1 + hstepA, voffA);
            PG8_WAIT_L(8); PG8_BAR; PG8_WAIT_L(0); PG8_MMA(0, 0, At, B0); PG8_BAR; PG8_SCHED;
            PG8_LDB(B1, 0, 1); PG8_STAGE(PG8_SB(0, 0), b2, voffB);
            PG8_BAR; PG8_WAIT_L(0); PG8_MMA(0, 1, At, B1); PG8_BAR;
            PG8_LDA(At, 0, 1); PG8_STAGE(PG8_SA(0, 0), a2, voffA);
            PG8_BAR; PG8_WAIT_L(0); PG8_MMA(1, 0, At, B0); PG8_BAR; PG8_SCHED;
            PG8_STAGE(PG8_SB(0, 1), b2 + hstepB, voffB);
            PG8_WAIT_V(6); PG8_BAR; PG8_MMA(1, 1, At, B1); PG8_BAR;
            PG8_LDB(B0, 1, 0); PG8_SCHED; PG8_LDA(At, 1, 0); PG8_STAGE(PG8_SA(0, 1), a2 + hstepA, voffA);
            PG8_WAIT_L(8); PG8_BAR; PG8_WAIT_L(0); PG8_MMA(0, 0, At, B0); PG8_BAR; PG8_SCHED;
            PG8_LDB(B1, 1, 1); PG8_STAGE(PG8_SB(1, 0), b3, voffB);
            PG8_BAR; PG8_WAIT_L(0); PG8_MMA(0, 1, At, B1); PG8_BAR;
            PG8_LDA(At, 1, 1); PG8_STAGE(PG8_SA(1, 0), a3, voffA);
            PG8_BAR; PG8_WAIT_L(0); PG8_MMA(1, 0, At, B0); PG8_BAR; PG8_SCHED;
            PG8_STAGE(PG8_SB(1, 1), b3 + hstepB, voffB);
            PG8_WAIT_V(6); PG8_BAR; PG8_MMA(1, 1, At, B1); PG8_BAR;
            }
        }
        if constexpr (ALIGN_EPI) { if (wr == 0) PG8_BAR; }
        if constexpr (!Epi::AFTER_DRAIN) { E(acc, cur, wr, wc, fr, fq); S.done(cur); }
        if (!has_next) break;
#pragma unroll
        for (int a = 0; a < 2; ++a)
#pragma unroll
            for (int b = 0; b < 2; ++b)
#pragma unroll
                for (int m = 0; m < 4; ++m)
#pragma unroll
                    for (int n = 0; n < 2; ++n) acc[a][b][m][n] = (f32x4){0.f, 0.f, 0.f, 0.f};
        cur = nxt; cA = nA; cB = nB; ++ui;
        if constexpr (ALIGN_EPI) { if (wr == 1) PG8_BAR; }
    }
    PG8_WAIT_V(0);
    if constexpr (!ALIGN_EPI) { if (wr == 0) PG8_BAR; }
    PG8_BAR;
    if constexpr (Epi::AFTER_DRAIN) { E.fused(acc, cur, wr, wc, fr, fq, lds, wid, lane); S.done(cur); }
#undef PG8_SA
#undef PG8_SB
#undef PG8_STAGE
#undef PG8_LDA
#undef PG8_LDB
#undef PG8_MMA
#undef PG8_WAIT_V
#undef PG8_WAIT_L
#undef PG8_BAR
#undef PG8_SCHED
}
}

struct SchedProj {
    pg8::StaticOrder so; const char* A; const char* Bt;
    __device__ __forceinline__ bool next(int i, pg8::Unit& u) const { u.st = 0; return so.tile(i, u.pm, u.pn); }
    __device__ __forceinline__ const char* a_ptr(const pg8::Unit& u) const { return A + (size_t)u.pm * (256 * DM * 2); }
    __device__ __forceinline__ const char* b_ptr(const pg8::Unit& u) const { return Bt + (size_t)u.pn * (256 * DM * 2); }
    __device__ __forceinline__ void a_ready(const pg8::Unit&) const {}
    __device__ __forceinline__ void done(const pg8::Unit&) const {}
};
struct SchedMerge {
    pg8::StaticOrder so; const char* ws; const char* os;
    __device__ __forceinline__ bool next(int i, pg8::Unit& u) const { u.st = i & 3; return so.tile(i >> 2, u.pm, u.pn); }
    __device__ __forceinline__ const char* a_ptr(const pg8::Unit& u) const {
        const size_t off = (u.st == 1) ? OFF_ZA : (u.st == 3) ? OFF_QB : OFF_H;
        return ws + off + (size_t)u.pm * (256 * DM * 2); }
    __device__ __forceinline__ const char* b_ptr(const pg8::Unit& u) const {
        const size_t off = (u.st == 0) ? (OO_WT + (size_t)7168 * DM * 2) : (u.st == 1) ? OO_WOG_T : (u.st == 2) ? (OO_WT + (size_t)8192 * DM * 2) : OO_WOD_T;
        return os + off + (size_t)u.pn * (256 * DM * 2); }
    __device__ __forceinline__ void a_ready(const pg8::Unit&) const {}
    __device__ __forceinline__ void done(const pg8::Unit&) const {}
};

__device__ __forceinline__ u32x4 pack8(const f32x4 v0, const f32x4 v1) { u32x4 w; w.x = cvt_pk_bf16(v0[0], v0[1]); w.y = cvt_pk_bf16(v0[2], v0[3]); w.z = cvt_pk_bf16(v1[0], v1[1]); w.w = cvt_pk_bf16(v1[2], v1[3]); return w; }
struct EpiProj {
    static constexpr bool PERM = true, AFTER_DRAIN = false;
    char* ws; char* os;
    __device__ __forceinline__ void operator()(const f32x4 (&acc)[2][2][4][2], const pg8::Unit& u, int wr, int wc, int fr, int fq) const {
        const int row0 = u.pm * 256 + wr * 64 + fr, lc0 = wc * 32 + 8 * fq, pn = u.pn;
        bf16_t* const KI = (bf16_t*)(ws + OFF_KI); float* const SMALL = (float*)(ws + OFF_SMALL);
        if (pn < 27) {
            bf16_t* base; int ldc, cb;
            if (pn < 24) { base = (bf16_t*)(ws + OFF_QA + (size_t)(pn >> 2) * (32 * MiB)); ldc = 1024; cb = (pn & 3) * 256; }
            else if (pn == 24) { base = (bf16_t*)(ws + OFF_CKV); ldc = 256; cb = 0; }
            else { base = (bf16_t*)(ws + OFF_QI); ldc = 512; cb = (pn - 25) * 256; }
#pragma unroll
            for (int ai = 0; ai < 2; ++ai)
#pragma unroll
                for (int m = 0; m < 4; ++m) { bf16_t* rowp = base + (size_t)(row0 + ai * 128 + m * 16) * ldc + cb + lc0;
#pragma unroll
                    for (int bj = 0; bj < 2; ++bj) *(u32x4*)(rowp + bj * 128) = pack8(acc[ai][bj][m][0], acc[ai][bj][m][1]); }
            if (pn < 12 && fr >= 13) {
                bf16_t* st = (bf16_t*)(os + OO_STASH) + (size_t)(pn >> 2) * (256 * 3 * 1024);
#pragma unroll
                for (int ai = 0; ai < 2; ++ai) { const int row = row0 + ai * 128 + 48; bf16_t* sp = st + ((size_t)(row >> 6) * 3 + ((row & 63) - 61)) * 1024 + cb + lc0;
#pragma unroll
                    for (int bj = 0; bj < 2; ++bj) *(u32x4*)(sp + bj * 128) = pack8(acc[ai][bj][3][0], acc[ai][bj][3][1]); }
            }
        } else {
#pragma unroll
            for (int ai = 0; ai < 2; ++ai)
#pragma unroll
                for (int m = 0; m < 4; ++m) { const size_t row = (size_t)(row0 + ai * 128 + m * 16);
                    if (lc0 < 64) *(u32x4*)(KI + row * 64 + lc0) = pack8(acc[ai][0][m][0], acc[ai][0][m][1]);
                    else if (lc0 < 88) { *(f32x4*)(SMALL + row * 32 + (lc0 - 64)) = acc[ai][0][m][0]; *(f32x4*)(SMALL + row * 32 + (lc0 - 64) + 4) = acc[ai][0][m][1]; } }
        }
    }
};
__device__ __forceinline__ f32x4 sig4(const f32x4 v) { f32x4 r; r[0] = sigmoid_f(v[0]); r[1] = sigmoid_f(v[1]); r[2] = sigmoid_f(v[2]); r[3] = sigmoid_f(v[3]); return r; }
__device__ __forceinline__ void unpack8(const u32x4 w, f32x4& a, f32x4& b) { a[0] = bflo(w.x); a[1] = bfhi(w.x); a[2] = bflo(w.y); a[3] = bfhi(w.y); b[0] = bflo(w.z); b[1] = bfhi(w.z); b[2] = bflo(w.w); b[3] = bfhi(w.w); }
struct EpiMerge {
    static constexpr bool PERM = true, AFTER_DRAIN = false;
    bf16_t* MERGED; bf16_t* PARK;
    __device__ __forceinline__ void operator()(const f32x4 (&acc)[2][2][4][2], const pg8::Unit& u, int wr, int wc, int fr, int fq) const {
        const int row0 = u.pm * 256 + wr * 64 + fr, col0 = u.pn * 256 + wc * 32 + 8 * fq, st = u.st;
#pragma unroll
        for (int ai = 0; ai < 2; ++ai)
#pragma unroll
            for (int m = 0; m < 4; ++m) { const size_t off = (size_t)(row0 + ai * 128 + m * 16) * 1024 + col0;
#pragma unroll
                for (int bj = 0; bj < 2; ++bj) {
                    const f32x4 v0 = acc[ai][bj][m][0], v1 = acc[ai][bj][m][1];
                    u32x4* pm_ = (u32x4*)(MERGED + off + bj * 128); u32x4* pp_ = (u32x4*)(PARK + off + bj * 128);
                    if (st == 0) *pm_ = pack8(sig4(v0), sig4(v1));
                    else if (st == 1) { f32x4 g0, g1; unpack8(*pm_, g0, g1); *pm_ = pack8(g0 * v0, g1 * v1); }
                    else if (st == 2) *pp_ = pack8(sig4(v0), sig4(v1));
                    else { f32x4 a0, a1, g0, g1; unpack8(*pm_, a0, a1); unpack8(*pp_, g0, g1); *pm_ = pack8(a0 + g0 * v0, a1 + g1 * v1); }
                } }
    }
};
struct EpiOut {
    static constexpr bool PERM = false, AFTER_DRAIN = false;
    const float* x; const float* MOD; float* XNEW;
    __device__ __forceinline__ void operator()(const f32x4 (&acc)[2][2][4][2], const pg8::Unit& u, int wr, int wc, int fr, int fq) const {
        const int row0 = u.pm * 256 + wr * 64 + fr, col0 = u.pn * 256 + wc * 32 + 4 * fq; const int b = u.pm >> 3;
        f32x4 gv[2][2];
#pragma unroll
        for (int bj = 0; bj < 2; ++bj)
#pragma unroll
            for (int n = 0; n < 2; ++n) gv[bj][n] = *(const f32x4*)(MOD + b * 3072 + 2048 + col0 + bj * 128 + n * 16);
#pragma unroll
        for (int ai = 0; ai < 2; ++ai)
#pragma unroll
            for (int m = 0; m < 4; ++m) { const size_t off = (size_t)(row0 + ai * 128 + m * 16) * 1024 + col0;
#pragma unroll
                for (int bj = 0; bj < 2; ++bj)
#pragma unroll
                    for (int n = 0; n < 2; ++n) { const f32x4 xv = *(const f32x4*)(x + off + bj * 128 + n * 16); *(f32x4*)(XNEW + off + bj * 128 + n * 16) = xv + gv[bj][n] * acc[ai][bj][m][n]; } }
    }
};

#define XB_TMO      128
#define XB_XCNT(j)  (256  + 64 * (j))
#define XB_XSUB(j)  (1280 + 64 * (j))
#define XB_XGEN(j)  (2304 + 64 * (j))
#define XB_TOP      3328
#define XB_TOPGEN   3392
#define XCD_BAR_WORDS 3456
#define XB_SPIN_CAP (1u << 18)

__device__ __forceinline__ unsigned xb_ld(unsigned* p)              { return __hip_atomic_load(p, __ATOMIC_RELAXED, __HIP_MEMORY_SCOPE_AGENT); }
__device__ __forceinline__ unsigned xb_add(unsigned* p, unsigned v) { return __hip_atomic_fetch_add(p, v, __ATOMIC_RELAXED, __HIP_MEMORY_SCOPE_AGENT); }
__device__ __forceinline__ unsigned xb_xcc_id() { return (unsigned)__builtin_amdgcn_s_getreg((3 << 11) | 20) & 0xFu; }
#define XB_SPIN(cond, bar) do { unsigned _sp = 0; while (cond) { __builtin_amdgcn_s_sleep(1); \
    if ((++_sp & 255u) == 0u) { if (xb_ld(&(bar)[XB_TMO])) break; if (_sp > XB_SPIN_CAP) { atomicAdd(&(bar)[XB_TMO], 1u); break; } } } } while (0)

struct XcdBarrier {
    unsigned* bar; unsigned x;
    volatile LAS unsigned* st;
};

__device__ __forceinline__ XcdBarrier xcd_barrier_post(unsigned* bar, volatile LAS unsigned* st) {
    XcdBarrier b; b.bar = bar; b.x = xb_xcc_id(); b.st = st;
    if (threadIdx.x == 0) (void)xb_add(&bar[XB_XCNT(b.x)], 1u);
    return b;
}
__device__ __forceinline__ void xcd_barrier_complete(unsigned* bar, unsigned x, unsigned& nloc, unsigned& nx) {
    const unsigned G = gridDim.x * gridDim.y * gridDim.z;
    unsigned sum, cnt, mine, sp = 0u;
    for (;;) {
        sum = 0u; cnt = 0u; mine = 0u;
#pragma unroll
        for (unsigned j = 0; j < 16; ++j) { const unsigned c = xb_ld(&bar[XB_XCNT(j)]); sum += c; cnt += (c > 0u) ? 1u : 0u; mine = (j == x) ? c : mine; }
        if (sum == G) break;
        __builtin_amdgcn_s_sleep(1);
        if ((++sp & 255u) == 0u) { if (xb_ld(&bar[XB_TMO])) break; if (sp > XB_SPIN_CAP) { atomicAdd(&bar[XB_TMO], 1u); break; } }
    }
    nloc = mine > 0u ? mine : 1u; nx = cnt > 0u ? cnt : 1u;
}

__device__ __forceinline__ void xcd_barrier(const XcdBarrier& b) {
    asm volatile("s_waitcnt vmcnt(0)" ::: "memory");
    __syncthreads();
    if (threadIdx.x == 0) {
        unsigned* bar = b.bar;
        __builtin_amdgcn_s_waitcnt(0);
        unsigned nloc = b.st[0], nx = b.st[1];
        if (nloc == 0u) { xcd_barrier_complete(bar, b.x, nloc, nx); b.st[0] = nloc; b.st[1] = nx; }
        const unsigned old = xb_add(&bar[XB_XSUB(b.x)], 1u);
        const unsigned gen = old / nloc;
        if (old + 1u == (gen + 1u) * nloc) {
            __builtin_amdgcn_fence(__ATOMIC_RELEASE, "agent");
            asm volatile("s_waitcnt vmcnt(0)" ::: "memory");
            const unsigned og = xb_add(&bar[XB_TOP], 1u);
            const unsigned tg = og / nx;
            if (og + 1u == (tg + 1u) * nx) xb_add(&bar[XB_TOPGEN], 1u);
            else XB_SPIN(xb_ld(&bar[XB_TOPGEN]) == tg, bar);
            __builtin_amdgcn_fence(__ATOMIC_ACQUIRE, "agent");
            xb_add(&bar[XB_XGEN(b.x)], 1u);
            asm volatile("s_waitcnt vmcnt(0)" ::: "memory");
        } else {
            XB_SPIN(xb_ld(&bar[XB_XGEN(b.x)]) == gen, bar);
            __builtin_amdgcn_fence(__ATOMIC_ACQUIRE, "agent");
            asm volatile("s_waitcnt vmcnt(0)" ::: "memory");
        }
    }
    __syncthreads();
}

constexpr int NWAVES = 8, NTHR = 512;
constexpr int RING_OFF = 0, RING_BYTES = 131072, LDS_BYTES = 163840, LDSCTL_OFF = LDS_BYTES - 256;
struct Params { const float* in[18]; float* out; char* ws; int ph_lo, ph_hi, li, pad; };

__device__ __forceinline__ void tr_tiles(const float* __restrict__ src, const int ld_src, bf16_t* __restrict__ dst, const int mode, const int ntn, LAS unsigned char* lds, const int nkt = 32, const int dstld = DM) {
    const int tid = threadIdx.x, G = gridDim.x, sub = tid >> 8, t = tid & 255, tx = t & 31, ty = t >> 5;
    LAS float* tile = (LAS float*)lds + sub * (4 * 32 * 33);
    const int NTILES = ntn * nkt;
    for (int base = blockIdx.x * 8; base < NTILES; base += G * 8) {
        float v[4][4];
#pragma unroll
        for (int q = 0; q < 4; ++q) {
            const int id = base + sub * 4 + q, tn = id / nkt, tk = id - tn * nkt, n0 = tn * 32, k0 = tk * 32;
#pragma unroll
            for (int i = 0; i < 4; ++i) { const int k = k0 + ty + i * 8, n = n0 + tx; const int col = mode ? wt_col(n) : n; v[q][i] = (id < NTILES && col >= 0) ? src[(size_t)k * ld_src + col] : 0.f; }
        }
#pragma unroll
        for (int q = 0; q < 4; ++q)
#pragma unroll
            for (int i = 0; i < 4; ++i) tile[q * (32 * 33) + (ty + i * 8) * 33 + tx] = v[q][i];
        __syncthreads();
#pragma unroll
        for (int q = 0; q < 4; ++q) {
            const int id = base + sub * 4 + q, tn = id / nkt, tk = id - tn * nkt, n0 = tn * 32, k0 = tk * 32;
            if (id < NTILES) {
#pragma unroll
                for (int i = 0; i < 4; ++i) { const int n = n0 + ty + i * 8, k = k0 + tx; dst[(size_t)n * dstld + k] = f2bf(tile[q * (32 * 33) + tx * 33 + ty + i * 8]); }
            }
        }
        __syncthreads();
    }
}
__device__ __forceinline__ void p0_prologue(const Params& p, const Bufs& B, LAS unsigned char* lds) {
    const int tid = threadIdx.x, G = gridDim.x;
    tr_tiles(p.in[5], 9048, B.WT, 1, NWT / 32, lds);
    tr_tiles(p.in[10], 1024, B.WOG_T, 0, 32, lds);
    tr_tiles(p.in[14], 1024, B.WOD_T, 0, 32, lds);
    tr_tiles(p.in[15], 1024, B.WOUT_T, 0, 32, lds);
    tr_tiles(p.in[13], 1024, (bf16_t*)((char*)p.out + OO_WUV_T), 0, 32, lds, 8, 256);
    { bf16_t* wk = (bf16_t*)((char*)p.out + OO_WUK_B); const float* src = p.in[12]; for (int i = blockIdx.x * NTHR + threadIdx.x; i < 256 * 1024; i += G * NTHR) wk[i] = f2bf(src[i]); }
    {
        LAS float* sc = (LAS float*)(lds + 36864);
        LAS float* part = (LAS float*)(lds + 36864 + 32768);
        const float* c = p.in[1]; const float* w_ada = p.in[3]; const float* b_ada = p.in[4];
        for (int jb = blockIdx.x; jb < 192; jb += G) {
            for (int i = tid; i < 8192; i += NTHR) sc[i] = silu_f(c[i]);
            __syncthreads();
            const int jj = tid & 15, sl = tid >> 4, j = jb * 16 + jj;
            float acc[8];
#pragma unroll
            for (int b = 0; b < 8; ++b) acc[b] = 0.f;
            for (int ii = 0; ii < 32; ++ii) { const int i = sl * 32 + ii; const float w = w_ada[(size_t)i * 3072 + j];
#pragma unroll
                for (int b = 0; b < 8; ++b) acc[b] += sc[b * 1024 + i] * w; }
#pragma unroll
            for (int b = 0; b < 8; ++b) part[(sl * 8 + b) * 16 + jj] = acc[b];
            __syncthreads();
            if (tid < 128) { const int b = tid >> 4, j2 = tid & 15; float s = 0.f;
                for (int s2 = 0; s2 < 32; ++s2) s += part[(s2 * 8 + b) * 16 + j2];
                B.MOD[b * 3072 + jb * 16 + j2] = s + b_ada[jb * 16 + j2]; }
            __syncthreads();
        }
    }
}
__device__ __forceinline__ void p1_h(const Params& p, const Bufs& B) {
    const int tid = threadIdx.x, lane = tid & 63, wave = tid >> 6, G = gridDim.x;
    const float* x = p.in[0]; const float* ng = p.in[2];
    for (int row0 = (blockIdx.x * NWAVES + wave) * 4; row0 < MROWS; row0 += G * NWAVES * 4) {
        const int b = row0 >> 11; f32x4 v[4][4]; float ss[4];
#pragma unroll
        for (int rr = 0; rr < 4; ++rr) { ss[rr] = 0.f;
#pragma unroll
            for (int i = 0; i < 4; ++i) v[rr][i] = *(const f32x4*)(x + (size_t)(row0 + rr) * DM + 4 * lane + 256 * i); }
#pragma unroll
        for (int rr = 0; rr < 4; ++rr)
#pragma unroll
            for (int i = 0; i < 4; ++i) ss[rr] += v[rr][i][0] * v[rr][i][0] + v[rr][i][1] * v[rr][i][1] + v[rr][i][2] * v[rr][i][2] + v[rr][i][3] * v[rr][i][3];
#pragma unroll
        for (int o = 32; o > 0; o >>= 1) { float t4[4];
#pragma unroll
            for (int rr = 0; rr < 4; ++rr) t4[rr] = __shfl_xor(ss[rr], o);
#pragma unroll
            for (int rr = 0; rr < 4; ++rr) ss[rr] += t4[rr]; }
#pragma unroll
        for (int i = 0; i < 4; ++i) { const int col = 4 * lane + 256 * i;
            const f32x4 g = *(const f32x4*)(ng + col), sc = *(const f32x4*)(B.MOD + b * 3072 + 1024 + col), sh = *(const f32x4*)(B.MOD + b * 3072 + col);
#pragma unroll
            for (int rr = 0; rr < 4; ++rr) { const float r = rsqrtf(ss[rr] * (1.f / DM) + 1e-6f);
                const f32x4 y = (v[rr][i] * r * g) * (sc + 1.0f) + sh;
                u32x2 w; w.x = cvt_pk_bf16(y[0], y[1]); w.y = cvt_pk_bf16(y[2], y[3]);
                *(u32x2*)(B.H + (size_t)(row0 + rr) * DM + col) = w; } }
    }
}
__device__ __forceinline__ void p8_final(const Params& p, const Bufs& B) {
    const int tid = threadIdx.x, lane = tid & 63, wave = tid >> 6, G = gridDim.x;
    const float* fg = p.in[17];
    for (int row0 = (blockIdx.x * NWAVES + wave) * 4; row0 < MROWS; row0 += G * NWAVES * 4) {
        f32x4 v[4][4]; float ss[4];
#pragma unroll
        for (int rr = 0; rr < 4; ++rr) { ss[rr] = 0.f;
#pragma unroll
            for (int i = 0; i < 4; ++i) v[rr][i] = *(const f32x4*)(B.XNEW + (size_t)(row0 + rr) * DM + 4 * lane + 256 * i); }
#pragma unroll
        for (int rr = 0; rr < 4; ++rr)
#pragma unroll
            for (int i = 0; i < 4; ++i) ss[rr] += v[rr][i][0] * v[rr][i][0] + v[rr][i][1] * v[rr][i][1] + v[rr][i][2] * v[rr][i][2] + v[rr][i][3] * v[rr][i][3];
#pragma unroll
        for (int o = 32; o > 0; o >>= 1) { float t4[4];
#pragma unroll
            for (int rr = 0; rr < 4; ++rr) t4[rr] = __shfl_xor(ss[rr], o);
#pragma unroll
            for (int rr = 0; rr < 4; ++rr) ss[rr] += t4[rr]; }
#pragma unroll
        for (int i = 0; i < 4; ++i) { const int col = 4 * lane + 256 * i; const f32x4 g = *(const f32x4*)(fg + col);
#pragma unroll
            for (int rr = 0; rr < 4; ++rr) { const float r = rsqrtf(ss[rr] * (1.f / DM) + 1e-6f); *(f32x4*)(p.out + (size_t)(row0 + rr) * DM + col) = v[rr][i] * r * g; } }
    }
}


typedef float f32x16 __attribute__((ext_vector_type(16)));
#define MFMA32(a, b, c) __builtin_amdgcn_mfma_f32_32x32x16_bf16((a), (b), (c), 0, 0, 0)
__device__ __forceinline__ int crow(int reg, int h) { return (reg & 3) + 8 * (reg >> 2) + 4 * h; }
constexpr int G1_ROWB = 272, G1_IMG = 64 * G1_ROWB, G1_WAVE = G1_IMG + 2048;

template <int MODE>
__device__ __forceinline__ void g1_conv(const bf16_t* __restrict__ X, const bf16_t* __restrict__ stash  , const float* __restrict__ cw  ,
                                        LAS unsigned char* img, int b, int n, int h, int lane, int dry = 0) {
    const int col = h * 128 + 2 * lane; const unsigned row0 = (unsigned)(b * NT + n * 64);
    const __amdgpu_buffer_rsrc_t rs = __builtin_amdgcn_make_buffer_rsrc((void*)X, 0, MROWS * 1024 * 2, 0x00020000);
    const unsigned voff = (unsigned)col * 2u;
    float w[4][2];
#pragma unroll
    for (int j = 0; j < 4; ++j) { w[j][0] = cw[j * 3072 + col]; w[j][1] = cw[j * 3072 + col + 1]; }
    float h0[2] = {0.f, 0.f}, h1[2] = {0.f, 0.f}, h2[2] = {0.f, 0.f};
    if (n > 0) {
        const bf16_t* sp = stash + ((size_t)(b * 32 + n - 1) * 3) * 1024 + col;
        const unsigned a0 = *(const unsigned*)(sp), a1 = *(const unsigned*)(sp + 1024), a2 = *(const unsigned*)(sp + 2048);
        h0[0] = bflo(a0); h0[1] = bfhi(a0); h1[0] = bflo(a1); h1[1] = bfhi(a1); h2[0] = bflo(a2); h2[1] = bfhi(a2);
    }
    unsigned rawn[16];
#pragma unroll
    for (int t = 0; t < 16; ++t) rawn[t] = __builtin_amdgcn_raw_buffer_load_b32(rs, voff, (row0 + t) * 2048u, 0);
#pragma unroll 1
    for (int q4 = 0; q4 < 4; ++q4) {
        unsigned raw[16];
#pragma unroll
        for (int t = 0; t < 16; ++t) raw[t] = rawn[t];
        const unsigned rb = (row0 + q4 * 16) * 2048u;
        if (q4 < 3) {
#pragma unroll
            for (int t = 0; t < 16; ++t) rawn[t] = __builtin_amdgcn_raw_buffer_load_b32(rs, voff, rb + (16 + t) * 2048u, 0);
        }
#pragma unroll
        for (int t = 0; t < 16; ++t) {
            const float x0 = bflo(raw[t]), x1 = bfhi(raw[t]);
            const float y0 = silu_f(w[0][0] * h0[0] + w[1][0] * h1[0] + w[2][0] * h2[0] + w[3][0] * x0);
            const float y1 = silu_f(w[0][1] * h0[1] + w[1][1] * h1[1] + w[2][1] * h2[1] + w[3][1] * x1);
            h0[0] = h1[0]; h1[0] = h2[0]; h2[0] = x0; h0[1] = h1[1]; h1[1] = h2[1]; h2[1] = x1;
            const unsigned pk = cvt_pk_bf16(y0, y1);
            if (MODE == 0) *(LAS unsigned*)(img + (q4 * 16 + t) * G1_ROWB + 4 * lane) = pk;
            else if (!dry) __builtin_amdgcn_raw_buffer_store_b32(pk, rs, voff, rb + t * 2048u, 0);
        }
    }
}
__device__ __forceinline__ float g1_diag(const f32x16& g, int r, int hh) {
    float d = 0.f;
#pragma unroll
    for (int reg = 0; reg < 16; ++reg) d = (crow(reg, hh) == r) ? g[reg] : d;
    return d + __shfl_xor(d, 32);
}
__device__ __forceinline__ void g1_store_norm(bf16_t* __restrict__ Xout, const LAS unsigned char* img, const LAS float* scl, float mul, int b, int n, int h, int lane, int dry) {
    const size_t row0 = (size_t)b * NT + n * 64;
#pragma unroll 4
    for (int ps = 0; ps < 16; ++ps) {
        const int row = ps * 4 + (lane >> 4), c16 = lane & 15;
        const u32x4 v = *(const LAS u32x4*)(img + row * G1_ROWB + 16 * c16);
        const float s = scl[row] * mul;
        u32x4 o; o.x = cvt_pk_bf16(bflo(v.x) * s, bfhi(v.x) * s); o.y = cvt_pk_bf16(bflo(v.y) * s, bfhi(v.y) * s); o.z = cvt_pk_bf16(bflo(v.z) * s, bfhi(v.z) * s); o.w = cvt_pk_bf16(bflo(v.w) * s, bfhi(v.w) * s);
        if (!dry) *(u32x4*)(Xout + (row0 + row) * 1024 + h * 128 + 8 * c16) = o;
    }
}
__device__ __forceinline__ void g1_phase(const Params& p, LAS unsigned char* lds) {
    const int tid = threadIdx.x, lane0 = tid & 63, h = tid >> 6, G = gridDim.x;
    char* ws = p.ws; char* os = (char*)p.out;
    bf16_t* QA = (bf16_t*)(ws + OFF_QA); bf16_t* KA = (bf16_t*)(ws + OFF_KA); bf16_t* VA = (bf16_t*)(ws + OFF_VA);
    const float* SMALL = (const float*)(ws + OFF_SMALL);
    const bf16_t* STASH = (const bf16_t*)(os + OO_STASH);
    const float* conv_w = p.in[6];
    LAS unsigned char* img = lds + h * G1_WAVE;
    LAS float* sm = (LAS float*)(img + G1_IMG);
    const float Aexp = __expf(p.in[7][h]), dtb = p.in[8][h];
    for (int unit = blockIdx.x; unit < NB * 32; unit += G) {
        int lane = lane0; asm volatile("" : "+v"(lane));
        const int r = lane & 31, hh = lane >> 5;
        const int b = unit >> 5, n = unit & 31; const size_t row0 = (size_t)b * NT + n * 64;
        const int u = (b * 8 + h) * 32 + n;
        float gi, beta, d;
        {
            const float xg = SMALL[(row0 + lane) * 32 + h] + dtb;
            const float sp = xg > 20.f ? xg : log1pf(__expf(xg));
            gi = -Aexp * sp; beta = sigmoid_f(SMALL[(row0 + lane) * 32 + 8 + h]);
            d = gi;
#pragma unroll
            for (int o = 1; o < 64; o <<= 1) { const float v = __shfl_up(d, o); if (lane >= o) d += v; }
            const float dl = __shfl(d, 63);
            float* dec = (float*)(os + OO_DEC) + (size_t)u * 256;
            dec[lane] = __expf(d); dec[64 + lane] = __expf(dl - d); dec[128 + lane] = gi; dec[192 + lane] = beta;
            sm[128 + lane] = d; sm[192 + lane] = beta;
        }
        g1_conv<0>(KA, STASH + (size_t)1 * 256 * 3 * 1024, conv_w + 1024, img, b, n, h, lane);
        __syncthreads();
        f32x16 g00, g10, g11;
#pragma unroll
        for (int i = 0; i < 16; ++i) { g00[i] = 0.f; g10[i] = 0.f; g11[i] = 0.f; }
#pragma unroll 2
        for (int s = 0; s < 8; ++s) {
            const bf16x8 k0 = *(const LAS bf16x8*)(img + (r) * G1_ROWB + (16 * s + 8 * hh) * 2), k1 = *(const LAS bf16x8*)(img + (32 + r) * G1_ROWB + (16 * s + 8 * hh) * 2);
            g00 = MFMA32(k0, k0, g00); g10 = MFMA32(k1, k0, g10); g11 = MFMA32(k1, k1, g11);
        }
        {
            const float nlo = rsqrtf(g1_diag(g00, r, hh) + 1e-6f), nhi = rsqrtf(g1_diag(g11, r, hh) + 1e-6f);
            if (hh == 0) { sm[r] = nlo; sm[32 + r] = nhi; }
        }
        __syncthreads();
        g1_store_norm(KA, img, sm, 1.0f, b, n, h, lane, p.pad);
        asm volatile("s_waitcnt vmcnt(0)" ::: "memory");
        __syncthreads();
        g1_conv<0>(QA, STASH, conv_w, img, b, n, h, lane);
        __syncthreads();
        {
            f32x16 qq0, qq1;
#pragma unroll
            for (int i = 0; i < 16; ++i) { qq0[i] = 0.f; qq1[i] = 0.f; }
#pragma unroll 2
            for (int s = 0; s < 8; ++s) {
                const bf16x8 qa = *(const LAS bf16x8*)(img + (r) * G1_ROWB + (16 * s + 8 * hh) * 2), qb = *(const LAS bf16x8*)(img + (32 + r) * G1_ROWB + (16 * s + 8 * hh) * 2);
                qq0 = MFMA32(qa, qa, qq0); qq1 = MFMA32(qb, qb, qq1);
            }
            const float nlo = rsqrtf(g1_diag(qq0, r, hh) + 1e-6f), nhi = rsqrtf(g1_diag(qq1, r, hh) + 1e-6f);
            if (hh == 0) { sm[64 + r] = nlo; sm[96 + r] = nhi; }
        }
        f32x16 q00, q10, q11;
#pragma unroll
        for (int i = 0; i < 16; ++i) { q00[i] = 0.f; q10[i] = 0.f; q11[i] = 0.f; }
#pragma unroll 1
        for (int s4 = 0; s4 < 2; ++s4) {
            bf16x8 kf0[4], kf1[4];
#pragma unroll
            for (int s = 0; s < 4; ++s) {
                kf0[s] = *(const bf16x8*)(KA + (row0 + r) * 1024 + h * 128 + 16 * (4 * s4 + s) + 8 * hh);
                kf1[s] = *(const bf16x8*)(KA + (row0 + 32 + r) * 1024 + h * 128 + 16 * (4 * s4 + s) + 8 * hh);
            }
#pragma unroll
            for (int s = 0; s < 4; ++s) {
                const bf16x8 qa = *(const LAS bf16x8*)(img + (r) * G1_ROWB + (16 * (4 * s4 + s) + 8 * hh) * 2), qb = *(const LAS bf16x8*)(img + (32 + r) * G1_ROWB + (16 * (4 * s4 + s) + 8 * hh) * 2);
                q00 = MFMA32(qa, kf0[s], q00); q10 = MFMA32(qb, kf0[s], q10); q11 = MFMA32(qb, kf1[s], q11);
            }
        }
        __syncthreads();
        g1_store_norm(QA, img, sm + 64, 0.08838834764831845f, b, n, h, lane, p.pad);
        __syncthreads();
        g1_conv<1>(VA, STASH + (size_t)2 * 256 * 3 * 1024, conv_w + 2048, img, b, n, h, lane, p.pad);
        bf16_t* tp = (bf16_t*)(os + OO_TPATT + (size_t)u * 12288);
        LAS float* Am = (LAS float*)img;
#pragma unroll
        for (int blk = 0; blk < 3; ++blk) {
            __builtin_amdgcn_sched_barrier(0);
            const int bi = (blk == 0) ? 0 : 1, bj = (blk == 2) ? 1 : 0;
            const f32x16& gk = (blk == 0) ? g00 : (blk == 1) ? g10 : g11;
            const f32x16& gq = (blk == 0) ? q00 : (blk == 1) ? q10 : q11;
            const int j = 32 * bj + r; const float nkj = sm[j], dj = sm[128 + j];
#pragma unroll
            for (int g4 = 0; g4 < 4; ++g4) {
                const int ib = 32 * bi + 8 * g4 + 4 * hh;
                const f32x4 nki = *(const LAS f32x4*)(sm + ib), nqi = *(const LAS f32x4*)(sm + 64 + ib), di = *(const LAS f32x4*)(sm + 128 + ib), bti = *(const LAS f32x4*)(sm + 192 + ib);
#pragma unroll
                for (int e = 0; e < 4; ++e) {
                    const int i = ib + e, reg = 4 * g4 + e;
                    const float gam = __expf(di[e] - dj);
                    const float av = (i > j) ? gk[reg] * nki[e] * nkj * bti[e] * gam : 0.f;
                    const float tv = (i >= j) ? gq[reg] * (nqi[e] * 0.08838834764831845f) * gam : 0.f;
                    Am[i * 64 + j] = av;
                    if (blk == 0) Am[i * 64 + 32 + j] = 0.f;
                    tp[(3 + blk) * 1024 + (i & 31) * 32 + r] = f2bf(tv);
                }
            }
        }
        __syncthreads();
#pragma unroll 1
        for (int i0 = 0; i0 < 64; i0 += 4) {
            float t0 = (lane == i0) ? 1.f : 0.f, t1 = (lane == i0 + 1) ? 1.f : 0.f, t2 = (lane == i0 + 2) ? 1.f : 0.f, t3 = (lane == i0 + 3) ? 1.f : 0.f;
#pragma unroll 2
            for (int j4 = 0; j4 < i0; j4 += 4) {
                const f32x4 a0 = *(const LAS f32x4*)(Am + (i0 + 0) * 64 + j4), a1 = *(const LAS f32x4*)(Am + (i0 + 1) * 64 + j4), a2 = *(const LAS f32x4*)(Am + (i0 + 2) * 64 + j4), a3 = *(const LAS f32x4*)(Am + (i0 + 3) * 64 + j4);
#pragma unroll
                for (int e = 0; e < 4; ++e) { const float tj = Am[(j4 + e) * 64 + lane]; t0 -= a0[e] * tj; t1 -= a1[e] * tj; t2 -= a2[e] * tj; t3 -= a3[e] * tj; }
            }
            const f32x4 d1 = *(const LAS f32x4*)(Am + (i0 + 1) * 64 + i0), d2 = *(const LAS f32x4*)(Am + (i0 + 2) * 64 + i0), d3 = *(const LAS f32x4*)(Am + (i0 + 3) * 64 + i0);
            t1 -= d1[0] * t0;
            t2 -= d2[0] * t0 + d2[1] * t1;
            t3 -= d3[0] * t0 + d3[1] * t1 + d3[2] * t2;
            Am[(i0 + 0) * 64 + lane] = t0; Am[(i0 + 1) * 64 + lane] = t1; Am[(i0 + 2) * 64 + lane] = t2; Am[(i0 + 3) * 64 + lane] = t3;
        }
        for (int i = 0; i < 64; ++i) {
            const bf16_t v = f2bf(Am[i * 64 + lane] * beta);
            if (i < 32) { if (lane < 32) tp[0 * 1024 + i * 32 + lane] = v; }
            else { tp[(lane < 32 ? 1 : 2) * 1024 + (i - 32) * 32 + (lane & 31)] = v; }
        }
        __syncthreads();
    }
}


typedef short s16x4 __attribute__((ext_vector_type(4)));
typedef __bf16 bf16x8_t __attribute__((ext_vector_type(8)));
typedef float f32x8 __attribute__((ext_vector_type(8)));
constexpr int G2_RB = 264, G2_IMG = 64 * G2_RB, G2_BRB = 72, G2_BLK = 32 * G2_BRB;
constexpr int G2_K = 0, G2_Q = G2_IMG, G2_V = 2 * G2_IMG, G2_TP = 3 * G2_IMG, G2_AT = G2_TP + 3 * G2_BLK, G2_DE = G2_AT + 3 * G2_BLK, G2_CB = G2_DE + 512;
constexpr int G2_OB = 2 * G2_CB, G2_OBSZ = 64 * 256;
static_assert(G2_CB % 16 == 0 && G2_OB + 2 * G2_OBSZ <= LDSCTL_OFF, "GDN scan LDS map");
__device__ __forceinline__ bf16x8 pack_step(const f32x16& x, const int s) {
    f32x8 v;
#pragma unroll
    for (int j = 0; j < 8; ++j) v[j] = x[8 * s + j];
    return __builtin_bit_cast(bf16x8, __builtin_convertvector(v, bf16x8_t));
}
__device__ __forceinline__ bf16x8 perm_frag(const LAS unsigned char* img, const int rowb, const int row, const int kc, const int hh) {
    const s16x4 lo = *(const LAS s16x4*)(img + row * rowb + (kc + 4 * hh) * 2), hi = *(const LAS s16x4*)(img + row * rowb + (kc + 8 + 4 * hh) * 2);
    return __builtin_shufflevector(lo, hi, 0, 1, 2, 3, 4, 5, 6, 7);
}
__device__ __forceinline__ s16x4 tr4(const LAS unsigned char* img, const int rowb, const int row0, const int c0, const int lane) {
    const int q = (lane & 15) >> 2, pq = lane & 3, blk = (lane >> 4) & 1;
    return __builtin_amdgcn_ds_read_tr16_b64_v4i16((LAS s16x4*)(img + (row0 + q) * rowb + (c0 + 16 * blk + 4 * pq) * 2));
}
#define G2_LV_SET(S_, k_, val_) do { const u32x4 _v = (val_); S_[(k_) >> 2][4 * ((k_) & 3) + 0] = __uint_as_float(_v.x); S_[(k_) >> 2][4 * ((k_) & 3) + 1] = __uint_as_float(_v.y); S_[(k_) >> 2][4 * ((k_) & 3) + 2] = __uint_as_float(_v.z); S_[(k_) >> 2][4 * ((k_) & 3) + 3] = __uint_as_float(_v.w); } while (0)
#define G2_LV_GET(S_, k_) ((u32x4){__float_as_uint(S_[(k_) >> 2][4 * ((k_) & 3) + 0]), __float_as_uint(S_[(k_) >> 2][4 * ((k_) & 3) + 1]), __float_as_uint(S_[(k_) >> 2][4 * ((k_) & 3) + 2]), __float_as_uint(S_[(k_) >> 2][4 * ((k_) & 3) + 3])})
__device__ __forceinline__ void g2_issue_chunk(const Params& p, f32x16 (&v)[4], const int b, const int h, const int n, const int lt) {
    char* ws = p.ws; const char* os = (const char*)p.out;
    const unsigned row0 = (unsigned)(b * NT + n * 64); const int u = (b * 8 + h) * 32 + n;
    const unsigned voff = (unsigned)((lt >> 4) * 2048 + h * 256 + (lt & 15) * 16);
#pragma unroll
    for (int t3 = 0; t3 < 3; ++t3) {
        const __amdgpu_buffer_rsrc_t rs = __builtin_amdgcn_make_buffer_rsrc((void*)(ws + OFF_QA + (size_t)(t3 == 0 ? 1 : t3 == 1 ? 0 : 2) * (32 * MiB)), 0, 32 * 1024 * 1024, 0x00020000);
#pragma unroll
        for (int k = 0; k < 4; ++k) G2_LV_SET(v, t3 * 4 + k, __builtin_amdgcn_raw_buffer_load_b128(rs, voff, (row0 + 16 * k) * 2048u, 0));
    }
    const __amdgpu_buffer_rsrc_t rt = __builtin_amdgcn_make_buffer_rsrc((void*)(os + OO_TPATT), 0, 24 * 1024 * 1024, 0x00020000);
#pragma unroll
    for (int k = 0; k < 3; ++k) G2_LV_SET(v, 12 + k, __builtin_amdgcn_raw_buffer_load_b128(rt, (unsigned)lt * 16u, (unsigned)u * 12288u + 4096u * k, 0));
    const __amdgpu_buffer_rsrc_t rd = __builtin_amdgcn_make_buffer_rsrc((void*)(os + OO_DEC), 0, 2 * 1024 * 1024, 0x00020000);
    G2_LV_SET(v, 15, __builtin_amdgcn_raw_buffer_load_b128(rd, (unsigned)(lt & 31) * 16u, (unsigned)u * 1024u, 0));
}
__device__ __forceinline__ void g2_commit_chunk(LAS unsigned char* cb, const f32x16 (&v)[4], const int lt) {
#pragma unroll
    for (int t3 = 0; t3 < 3; ++t3)
#pragma unroll
        for (int k = 0; k < 4; ++k) { const int pi = lt + 256 * k, row = pi >> 4, c16 = pi & 15; LAS u32x2* d = (LAS u32x2*)(cb + t3 * G2_IMG + row * G2_RB + 16 * c16);
            const u32x4 vv = G2_LV_GET(v, t3 * 4 + k); d[0] = (u32x2){vv.x, vv.y}; d[1] = (u32x2){vv.z, vv.w}; }
#pragma unroll
    for (int k = 0; k < 3; ++k) { const int pi = lt + 256 * k, blk = pi >> 7, row = (pi & 127) >> 2, c16 = pi & 3; LAS u32x2* d = (LAS u32x2*)(cb + G2_TP + blk * G2_BLK + row * G2_BRB + 16 * c16);
        const u32x4 vv = G2_LV_GET(v, 12 + k); d[0] = (u32x2){vv.x, vv.y}; d[1] = (u32x2){vv.z, vv.w}; }
    if (lt < 32) *(LAS u32x4*)(cb + G2_DE + 16 * lt) = G2_LV_GET(v, 15);
}
__device__ __forceinline__ void g2_issue_za(const Params& p, unsigned (&z)[16], const int b, const int h, const int n, const int lw, const int lane) {
    const __amdgpu_buffer_rsrc_t rz = __builtin_amdgcn_make_buffer_rsrc((void*)(p.ws + OFF_ZA), 0, 32 * 1024 * 1024, 0x00020000);
    const unsigned row0 = (unsigned)(b * NT + n * 64 + lw * 16), voff = (unsigned)(h * 256 + 4 * lane);
#pragma unroll
    for (int rr = 0; rr < 16; ++rr) z[rr] = __builtin_amdgcn_raw_buffer_load_b32(rz, voff, (row0 + rr) * 2048u, 0);
}
__device__ __forceinline__ void g2_epilogue(const Params& p, const LAS unsigned char* ob, const unsigned (&z)[16], const int b, const int h, const int n, const int lw  , const int lane) {
    const float* gg = p.in[9];
    const float g0 = gg[2 * lane], g1 = gg[2 * lane + 1];
    const __amdgpu_buffer_rsrc_t rz = __builtin_amdgcn_make_buffer_rsrc((void*)(p.ws + OFF_ZA), 0, 32 * 1024 * 1024, 0x00020000);
    const unsigned row0 = (unsigned)(b * NT + n * 64 + lw * 16), voff = (unsigned)(h * 256 + 4 * lane);
    unsigned w[16]; float ss[16];
#pragma unroll
    for (int rr = 0; rr < 16; ++rr) { w[rr] = *(const LAS unsigned*)(ob + (lw * 16 + rr) * 256 + 4 * lane); const float o0 = bflo(w[rr]), o1 = bfhi(w[rr]); ss[rr] = o0 * o0 + o1 * o1; }
#pragma unroll
    for (int o = 32; o > 0; o >>= 1) {
        float tmp[16];
#pragma unroll
        for (int rr = 0; rr < 16; ++rr) tmp[rr] = __shfl_xor(ss[rr], o);
#pragma unroll
        for (int rr = 0; rr < 16; ++rr) ss[rr] += tmp[rr];
    }
    if (!p.pad) {
#pragma unroll
        for (int rr = 0; rr < 16; ++rr) {
            const float rs = rsqrtf(ss[rr] * (1.f / 128.f) + 1e-6f);
            __builtin_amdgcn_raw_buffer_store_b32(cvt_pk_bf16(bflo(w[rr]) * rs * g0 * silu_f(bflo(z[rr])), bfhi(w[rr]) * rs * g1 * silu_f(bfhi(z[rr]))), rz, voff, (row0 + rr) * 2048u, 0);
        }
    }
}
__device__ __forceinline__ void g2_phase(const Params& p, LAS unsigned char* lds) {
    const int tid = threadIdx.x, wave = __builtin_amdgcn_readfirstlane(tid >> 6), G = gridDim.x;
    for (int bh = blockIdx.x; bh < NB * 8; bh += G) {
        int lane = tid & 63; asm volatile("" : "+v"(lane));
        const int r = lane & 31, hh = lane >> 5, b = bh >> 3, h = bh & 7;
        f32x16 S[4];
#pragma unroll
        for (int i = 0; i < 4; ++i)
#pragma unroll
            for (int e = 0; e < 16; ++e) S[i][e] = 0.f;
        unsigned zc[16];
        if (wave >= 4) { g2_issue_chunk(p, S, b, h, 0, tid - 256); g2_commit_chunk(lds, S, tid - 256); g2_issue_chunk(p, S, b, h, 1, tid - 256); g2_issue_za(p, zc, b, h, 0, wave - 4, lane); }
        __syncthreads();
#pragma unroll 1
        for (int n = 0; n < 32; ++n) {
            LAS unsigned char* cb = lds + (n & 1) * G2_CB;
            if (wave < 4) {
                const int j = wave;
                const LAS unsigned char* KI = cb + G2_K; const LAS unsigned char* QI = cb + G2_Q; const LAS unsigned char* VI = cb + G2_V;
                const LAS float* ED = (const LAS float*)(cb + G2_DE); const LAS float* EDL = ED + 64;
                f32x16 ks[2], qs[2];
#pragma unroll
                for (int tb = 0; tb < 2; ++tb)
#pragma unroll
                    for (int e = 0; e < 16; ++e) { ks[tb][e] = 0.f; qs[tb][e] = 0.f; }
                bf16x8 fa[2][4];
#define G2_LD1(buf, g) do { fa[buf][0] = perm_frag(KI, G2_RB, r, 16 * (g), hh); fa[buf][1] = perm_frag(KI, G2_RB, 32 + r, 16 * (g), hh); \
                            fa[buf][2] = perm_frag(QI, G2_RB, r, 16 * (g), hh); fa[buf][3] = perm_frag(QI, G2_RB, 32 + r, 16 * (g), hh); } while (0)
                G2_LD1(0, 0);
#pragma unroll
                for (int g = 0; g < 8; ++g) {
                    if (g + 1 < 8) G2_LD1((g + 1) & 1, g + 1);
                    __builtin_amdgcn_sched_barrier(0);
                    const bf16x8 xs = pack_step(S[g >> 1], g & 1);
                    ks[0] = MFMA32(fa[g & 1][0], xs, ks[0]); ks[1] = MFMA32(fa[g & 1][1], xs, ks[1]);
                    qs[0] = MFMA32(fa[g & 1][2], xs, qs[0]); qs[1] = MFMA32(fa[g & 1][3], xs, qs[1]);
                    __builtin_amdgcn_sched_barrier(0);
                }
#undef G2_LD1
                f32x16 R[2], O[2];
#pragma unroll
                for (int tb = 0; tb < 2; ++tb)
#pragma unroll
                    for (int g4 = 0; g4 < 4; ++g4) {
                        const int t0 = 32 * tb + 8 * g4 + 4 * hh;
                        const s16x4 vv = tr4(VI, G2_RB, t0, 32 * j, lane);
                        const f32x4 ed = *(const LAS f32x4*)(ED + t0);
#pragma unroll
                        for (int e = 0; e < 4; ++e) { R[tb][4 * g4 + e] = bf2f((bf16_t)vv[e]) - ed[e] * ks[tb][4 * g4 + e]; O[tb][4 * g4 + e] = ed[e] * qs[tb][4 * g4 + e]; }
                    }
                f32x16 vn[2];
#pragma unroll
                for (int e = 0; e < 16; ++e) { vn[0][e] = 0.f; vn[1][e] = 0.f; }
                {
                    bf16x8 ft[3][2];
#pragma unroll
                    for (int bk = 0; bk < 3; ++bk)
#pragma unroll
                        for (int s = 0; s < 2; ++s) ft[bk][s] = perm_frag(cb + G2_TP + bk * G2_BLK, G2_BRB, r, 16 * s, hh);
                    __builtin_amdgcn_sched_barrier(0);
#pragma unroll
                    for (int s = 0; s < 2; ++s) {
                        const bf16x8 x0 = pack_step(R[0], s), x1 = pack_step(R[1], s);
                        vn[0] = MFMA32(ft[0][s], x0, vn[0]); vn[1] = MFMA32(ft[1][s], x0, vn[1]); vn[1] = MFMA32(ft[2][s], x1, vn[1]);
                    }
                }
                f32x16 vs[2];
#pragma unroll
                for (int tb = 0; tb < 2; ++tb)
#pragma unroll
                    for (int g4 = 0; g4 < 4; ++g4) {
                        const f32x4 el = *(const LAS f32x4*)(EDL + 32 * tb + 8 * g4 + 4 * hh);
#pragma unroll
                        for (int e = 0; e < 4; ++e) vs[tb][4 * g4 + e] = el[e] * vn[tb][4 * g4 + e];
                    }
                {
                    bf16x8 ft[3][2];
#pragma unroll
                    for (int bk = 0; bk < 3; ++bk)
#pragma unroll
                        for (int s = 0; s < 2; ++s) ft[bk][s] = perm_frag(cb + G2_AT + bk * G2_BLK, G2_BRB, r, 16 * s, hh);
                    __builtin_amdgcn_sched_barrier(0);
#pragma unroll
                    for (int s = 0; s < 2; ++s) {
                        const bf16x8 x0 = pack_step(vn[0], s), x1 = pack_step(vn[1], s);
                        O[0] = MFMA32(ft[0][s], x0, O[0]); O[1] = MFMA32(ft[1][s], x0, O[1]); O[1] = MFMA32(ft[2][s], x1, O[1]);
                    }
                }
                LAS unsigned char* ob = lds + G2_OB + (n & 1) * G2_OBSZ;
#pragma unroll
                for (int tb = 0; tb < 2; ++tb)
#pragma unroll
                    for (int e = 0; e < 16; ++e) *(LAS bf16_t*)(ob + (32 * tb + crow(e, hh)) * 256 + (32 * j + r) * 2) = f2bf(O[tb][e]);
                const float edl_all = ED[63];
                bf16x8 xv[2][2];
#pragma unroll
                for (int tb = 0; tb < 2; ++tb)
#pragma unroll
                    for (int s = 0; s < 2; ++s) xv[tb][s] = pack_step(vs[tb], s);
                s16x4 fk[1][8];
#define G2_LD5(buf, i) do { _Pragma("unroll") for (int tb = 0; tb < 2; ++tb) _Pragma("unroll") for (int s = 0; s < 2; ++s) { const int t0 = 32 * tb + 16 * s + 4 * hh; \
                            fk[buf][(tb * 2 + s) * 2] = tr4(KI, G2_RB, t0, 32 * (i), lane); fk[buf][(tb * 2 + s) * 2 + 1] = tr4(KI, G2_RB, t0 + 8, 32 * (i), lane); } } while (0)
#pragma unroll
                for (int i = 0; i < 4; ++i) {
                    G2_LD5(0, i);
                    __builtin_amdgcn_sched_barrier(0);
#pragma unroll
                    for (int e = 0; e < 16; ++e) S[i][e] *= edl_all;
#pragma unroll
                    for (int tb = 0; tb < 2; ++tb)
#pragma unroll
                        for (int s = 0; s < 2; ++s) {
                            const bf16x8 a = __builtin_shufflevector(fk[0][(tb * 2 + s) * 2], fk[0][(tb * 2 + s) * 2 + 1], 0, 1, 2, 3, 4, 5, 6, 7);
                            S[i] = MFMA32(a, xv[tb][s], S[i]);
                        }
                    __builtin_amdgcn_sched_barrier(0);
                }
#undef G2_LD5
            } else {
                const int lt = tid - 256;
                if (n > 0) g2_epilogue(p, lds + G2_OB + ((n - 1) & 1) * G2_OBSZ, zc, b, h, n - 1, wave - 4, lane);
                if (n + 1 < 32) g2_commit_chunk(lds + ((n + 1) & 1) * G2_CB, S, lt);
                if (n + 2 < 32) g2_issue_chunk(p, S, b, h, n + 2, lt);
                if (n > 0) g2_issue_za(p, zc, b, h, n, wave - 4, lane);
            }
            __syncthreads();
        }
        if (wave >= 4) g2_epilogue(p, lds + G2_OB + 1 * G2_OBSZ, zc, b, h, 31, wave - 4, lane);
        __syncthreads();
    }
}

__device__ const unsigned char T5_BUCKET[128] = {
    0, 1, 2, 3, 4, 5, 6, 7, 8, 9, 10, 11, 12, 13, 14, 15, 16, 16, 16, 17, 17, 18, 18, 18, 19, 19, 19, 20, 20, 20, 20, 21,
    21, 21, 21, 22, 22, 22, 22, 22, 23, 23, 23, 23, 23, 23, 24, 24, 24, 24, 24, 24, 25, 25, 25, 25, 25, 25, 25, 26, 26, 26, 26, 26,
    26, 26, 26, 27, 27, 27, 27, 27, 27, 27, 27, 27, 27, 28, 28, 28, 28, 28, 28, 28, 28, 28, 28, 29, 29, 29, 29, 29, 29, 29, 29, 29,
    29, 29, 29, 30, 30, 30, 30, 30, 30, 30, 30, 30, 30, 30, 30, 30, 30, 31, 31, 31, 31, 31, 31, 31, 31, 31, 31, 31, 31, 31, 31, 31};
__device__ __forceinline__ int t5_bucket(int n) { return n >= 128 ? 31 : (int)T5_BUCKET[n]; }

constexpr size_t OFF_QL = OFF_QA;
typedef unsigned short u16_t;
#define MFMA16(a, b, c) __builtin_amdgcn_mfma_f32_16x16x32_bf16((a), (b), (c), 0, 0, 0)

__device__ __forceinline__ void qlat_phase(const Params& p, LAS unsigned char* lds) {
    const int tid = threadIdx.x, wave = tid >> 6, G = gridDim.x, wm = wave & 1, wn = wave >> 1;
    const bf16_t* QB = (const bf16_t*)(p.ws + OFF_QB); const bf16_t* WUK = (const bf16_t*)((const char*)p.out + OO_WUK_B); bf16_t* QL = (bf16_t*)(p.ws + OFF_QL);
    int hcur = -1; bf16x8 bfr[2][8]; bf16x8 a[2][8]; bool have = false;
    for (int unit = blockIdx.x; unit < 1024; unit += G) {
        int lane = tid & 63; asm volatile("" : "+v"(lane));
        const int r = lane & 31, hh = lane >> 5, h = unit & 7, mt = unit >> 3, m0 = mt * 128 + wm * 64, n0 = wn * 64;
        if (h != hcur) { hcur = h;
#pragma unroll
            for (int nt = 0; nt < 2; ++nt)
#pragma unroll
                for (int s = 0; s < 8; ++s) bfr[nt][s] = *(const bf16x8*)(WUK + (size_t)(n0 + 32 * nt + r) * 1024 + h * 128 + 16 * s + 8 * hh); }
        if (!have) {
#pragma unroll
            for (int mi = 0; mi < 2; ++mi)
#pragma unroll
                for (int s = 0; s < 8; ++s) a[mi][s] = *(const bf16x8*)(QB + (size_t)(m0 + 32 * mi + r) * 1024 + h * 128 + 16 * s + 8 * hh);
        }
        f32x16 acc[2][2];
#pragma unroll
        for (int i = 0; i < 4; ++i)
#pragma unroll
            for (int e = 0; e < 16; ++e) acc[i >> 1][i & 1][e] = 0.f;
#pragma unroll
        for (int s = 0; s < 8; ++s)
#pragma unroll
            for (int mi = 0; mi < 2; ++mi)
#pragma unroll
                for (int nt = 0; nt < 2; ++nt) acc[mi][nt] = MFMA32(a[mi][s], bfr[nt][s], acc[mi][nt]);
        have = false;
        if (unit + G < 1024 && ((unit + G) & 7) == h) {
            const int m1 = ((unit + G) >> 3) * 128 + wm * 64; have = true;
#pragma unroll
            for (int mi = 0; mi < 2; ++mi)
#pragma unroll
                for (int s = 0; s < 8; ++s) a[mi][s] = *(const bf16x8*)(QB + (size_t)(m1 + 32 * mi + r) * 1024 + h * 128 + 16 * s + 8 * hh);
        }
#pragma unroll
        for (int mi = 0; mi < 2; ++mi)
#pragma unroll
            for (int nt = 0; nt < 2; ++nt)
#pragma unroll
                for (int e = 0; e < 16; ++e) *(LAS bf16_t*)(lds + (wm * 64 + 32 * mi + crow(e, hh)) * 528 + (n0 + 32 * nt + r) * 2) = f2bf(acc[mi][nt][e] * 0.08838834764831845f);
        __syncthreads();
#pragma unroll
        for (int k = 0; k < 8; ++k) { const int pi = tid + 512 * k, row = pi >> 5, c16 = pi & 31;
            *(u32x4*)(QL + (size_t)(mt * 128 + row) * 2048 + h * 256 + 8 * c16) = *(const LAS u32x4*)(lds + row * 528 + 16 * c16); }
        __syncthreads();
    }
}
__device__ __forceinline__ void wuv_phase(const Params& p, LAS unsigned char* lds) {
    const int tid = threadIdx.x, wave = tid >> 6, G = gridDim.x, wm = wave & 1, wn = wave >> 1;
    const bf16_t* OL = (const bf16_t*)(p.ws + OFF_QL); const bf16_t* WUV = (const bf16_t*)((const char*)p.out + OO_WUV_T); bf16_t* OB = (bf16_t*)(p.ws + OFF_QB); const bf16_t* ZB = (const bf16_t*)(p.ws + OFF_ZB);
    int hcur = -1; bf16x8 bfr[16]; bf16x8 a[2][8]; bool have = false;
    for (int unit = blockIdx.x; unit < 1024; unit += G) {
        int lane = tid & 63; asm volatile("" : "+v"(lane));
        const int r = lane & 31, hh = lane >> 5, h = unit & 7, mt = unit >> 3, m0 = mt * 128 + wm * 64, n0 = wn * 32;
        if (h != hcur) { hcur = h;
#pragma unroll
            for (int s = 0; s < 16; ++s) bfr[s] = *(const bf16x8*)(WUV + (size_t)(h * 128 + n0 + r) * 256 + 16 * s + 8 * hh); }
        f32x16 acc[2];
#pragma unroll
        for (int i = 0; i < 2; ++i)
#pragma unroll
            for (int e = 0; e < 16; ++e) acc[i][e] = 0.f;
#pragma unroll
        for (int s8 = 0; s8 < 2; ++s8) {
            if (s8 == 1 || !have) {
#pragma unroll
                for (int mi = 0; mi < 2; ++mi)
#pragma unroll
                    for (int s = 0; s < 8; ++s) a[mi][s] = *(const bf16x8*)(OL + (size_t)(m0 + 32 * mi + r) * 2048 + h * 256 + 16 * (8 * s8 + s) + 8 * hh);
            }
#pragma unroll
            for (int s = 0; s < 8; ++s)
#pragma unroll
                for (int mi = 0; mi < 2; ++mi) acc[mi] = MFMA32(a[mi][s], bfr[8 * s8 + s], acc[mi]);
        }
        have = false;
        if (unit + G < 1024 && ((unit + G) & 7) == h) {
            const int m1 = ((unit + G) >> 3) * 128 + wm * 64; have = true;
#pragma unroll
            for (int mi = 0; mi < 2; ++mi)
#pragma unroll
                for (int s = 0; s < 8; ++s) a[mi][s] = *(const bf16x8*)(OL + (size_t)(m1 + 32 * mi + r) * 2048 + h * 256 + 16 * s + 8 * hh);
        }
#pragma unroll
        for (int mi = 0; mi < 2; ++mi)
#pragma unroll
            for (int e = 0; e < 16; ++e) *(LAS bf16_t*)(lds + (wm * 64 + 32 * mi + crow(e, hh)) * 272 + (n0 + r) * 2) = f2bf(acc[mi][e]);
        __syncthreads();
#pragma unroll
        for (int k = 0; k < 4; ++k) { const int pi = tid + 512 * k, row = pi >> 4, c16 = pi & 15;
            const u32x4 v = *(const LAS u32x4*)(lds + row * 272 + 16 * c16); const size_t o = (size_t)(mt * 128 + row) * 1024 + h * 128 + 8 * c16;
            const u32x4 z = *(const u32x4*)(ZB + o); u32x4 w;
            w.x = cvt_pk_bf16(bflo(v.x) * silu_f(bflo(z.x)), bfhi(v.x) * silu_f(bfhi(z.x))); w.y = cvt_pk_bf16(bflo(v.y) * silu_f(bflo(z.y)), bfhi(v.y) * silu_f(bfhi(z.y)));
            w.z = cvt_pk_bf16(bflo(v.z) * silu_f(bflo(z.z)), bfhi(v.z) * silu_f(bfhi(z.z))); w.w = cvt_pk_bf16(bflo(v.w) * silu_f(bflo(z.w)), bfhi(v.w) * silu_f(bfhi(z.w)));
            *(u32x4*)(OB + o) = w; }
        __syncthreads();
    }
}

constexpr int D2_RB = 528, D2_KB = 32 * D2_RB, D2_BIAS = 8 * D2_KB;
static_assert(D2_BIAS + 129 * 8 * 4 <= LDSCTL_OFF, "DSA attention LDS map");
__device__ __forceinline__ void d2_phase(const Params& p, LAS unsigned char* lds) {
    const int tid = threadIdx.x, wave = __builtin_amdgcn_readfirstlane(tid >> 6), G = gridDim.x;
    const bf16_t* CKV = (const bf16_t*)(p.ws + OFF_CKV); bf16_t* QL = (bf16_t*)(p.ws + OFF_QL); const u16_t* IDX = (const u16_t*)((const char*)p.out + OO_IDX);
    LAS unsigned char* kb = lds + wave * D2_KB; LAS float* sbias = (LAS float*)(lds + D2_BIAS);
    for (int i = tid; i < 129 * 8; i += NTHR) sbias[i] = p.in[16][t5_bucket(i >> 3) * 8 + (i & 7)];
    __syncthreads();
    for (int it = blockIdx.x; it < 2048; it += G) {
        int lane = tid & 63; asm volatile("" : "+v"(lane));
        const int c16 = lane & 15, q = lane >> 4, b = it & 7, c8 = (it >> 3) & 31, kk = it >> 8, t = kk * 256 + c8 * 8 + wave;
        const size_t token = (size_t)b * NT + t;
        const int n_sel = (t + 1 < 256) ? (t + 1) : 256, nch = (n_sel + 31) >> 5;
        const __amdgpu_buffer_rsrc_t rck = __builtin_amdgcn_make_buffer_rsrc((void*)(CKV + (size_t)b * NT * 256), 0, NT * 512, 0x00020000); const unsigned gvo = 16u * (lane & 31);
        unsigned iw0, iw1;
        if (t < 256) { const int k0 = 4 * lane; iw0 = (unsigned)(k0 < n_sel ? k0 : 0) | ((unsigned)(k0 + 1 < n_sel ? k0 + 1 : 0) << 16); iw1 = (unsigned)(k0 + 2 < n_sel ? k0 + 2 : 0) | ((unsigned)(k0 + 3 < n_sel ? k0 + 3 : 0) << 16); }
        else { const u32x2 w = *(const u32x2*)(IDX + token * 256 + 4 * lane); iw0 = w.x; iw1 = w.y; }
        bf16x8 bq[8];
#pragma unroll
        for (int s = 0; s < 8; ++s) {
            u32x4 v = (u32x4){0u, 0u, 0u, 0u};
            if (c16 < 8) v = *(const u32x4*)(QL + token * 2048 + c16 * 256 + 32 * s + 8 * q);
            bq[s] = __builtin_bit_cast(bf16x8, v);
        }
        f32x4 O[16];
#pragma unroll
        for (int i = 0; i < 16; ++i) O[i] = (f32x4){0.f, 0.f, 0.f, 0.f};
        float mrun = -1.0e30f, lrun = 0.f;
        u32x4 g[16];
#define D2_GATHER(c) do { _Pragma("unroll") for (int i = 0; i < 16; ++i) { \
            const unsigned wa = (unsigned)__builtin_amdgcn_readlane((int)(((2 * i) & 2) ? iw1 : iw0), 8 * (c) + ((2 * i) >> 2)); \
            const int ka = (int)(wa & 0xFFFFu), kb2 = (int)(wa >> 16); const int key = (lane >> 5) ? kb2 : ka; \
            g[i] = __builtin_amdgcn_raw_buffer_load_b128(rck, gvo + ((unsigned)key << 9), 0, 0); } } while (0)
        D2_GATHER(0);
#pragma unroll 1
        for (int ch = 0; ch < nch; ++ch) {
#pragma unroll
            for (int i = 0; i < 16; ++i) *(LAS u32x4*)(kb + (2 * i + (lane >> 5)) * D2_RB + 16 * (lane & 31)) = g[i];
            if (ch + 1 < nch) D2_GATHER(ch + 1);
            f32x4 sc[2];
#pragma unroll
            for (int kt = 0; kt < 2; ++kt) { sc[kt] = (f32x4){0.f, 0.f, 0.f, 0.f};
                bf16x8 fa[8];
#pragma unroll
                for (int s = 0; s < 8; ++s) fa[s] = *(const LAS bf16x8*)(kb + (16 * kt + c16) * D2_RB + (32 * s + 8 * q) * 2);
                __builtin_amdgcn_sched_barrier(0);
#pragma unroll
                for (int s = 0; s < 8; ++s) sc[kt] = MFMA16(fa[s], bq[s], sc[kt]);
                __builtin_amdgcn_sched_barrier(0); }
            float cmax = -1.0e30f;
#pragma unroll
            for (int kt = 0; kt < 2; ++kt) {
                const unsigned w0 = (unsigned)__shfl((int)iw0, 8 * ch + 4 * kt + q), w1 = (unsigned)__shfl((int)iw1, 8 * ch + 4 * kt + q);
#pragma unroll
                for (int e = 0; e < 4; ++e) {
                    const int sl = 16 * kt + 4 * q + e; const unsigned ww = (e & 2) ? w1 : w0; const int key = (e & 1) ? (int)(ww >> 16) : (int)(ww & 0xFFFFu);
                    const int dist = t - key; const float bias = sbias[(dist < 128 ? dist : 128) * 8 + (c16 & 7)];
                    const float v = (ch * 32 + sl < n_sel) ? sc[kt][e] + bias : -1.0e30f;
                    sc[kt][e] = v; cmax = fmaxf(cmax, v);
                }
            }
            cmax = fmaxf(cmax, __shfl_xor(cmax, 16)); cmax = fmaxf(cmax, __shfl_xor(cmax, 32));
            const bool resc = __any(cmax > mrun + 8.0f);
            const float mnew = resc ? fmaxf(mrun, cmax) : mrun, alpha = resc ? __expf(mrun - mnew) : 1.0f;
            float psum = 0.f;
#pragma unroll
            for (int kt = 0; kt < 2; ++kt)
#pragma unroll
                for (int e = 0; e < 4; ++e) { const float pv = __expf(sc[kt][e] - mnew); sc[kt][e] = pv; psum += pv; }
            lrun = lrun * alpha + psum; mrun = mnew;
            if (resc) {
#pragma unroll
                for (int mt = 0; mt < 16; ++mt) O[mt] = O[mt] * alpha;
            }
            f32x8 pf;
#pragma unroll
            for (int e = 0; e < 4; ++e) { pf[e] = sc[0][e]; pf[4 + e] = sc[1][e]; }
            const bf16x8 pb = __builtin_bit_cast(bf16x8, __builtin_convertvector(pf, bf16x8_t));
            {
                s16x4 ft[2][8];
#define D2_LDT(buf, m4) do { _Pragma("unroll") for (int j = 0; j < 4; ++j) { \
                    ft[buf][2 * j] = __builtin_amdgcn_ds_read_tr16_b64_v4i16((LAS s16x4*)(kb + (4 * q + (c16 >> 2)) * D2_RB + (16 * (4 * (m4) + j) + 4 * (lane & 3)) * 2)); \
                    ft[buf][2 * j + 1] = __builtin_amdgcn_ds_read_tr16_b64_v4i16((LAS s16x4*)(kb + (16 + 4 * q + (c16 >> 2)) * D2_RB + (16 * (4 * (m4) + j) + 4 * (lane & 3)) * 2)); } } while (0)
                D2_LDT(0, 0);
#pragma unroll
                for (int m4 = 0; m4 < 4; ++m4) {
                    if (m4 + 1 < 4) D2_LDT((m4 + 1) & 1, m4 + 1);
                    __builtin_amdgcn_sched_barrier(0);
#pragma unroll
                    for (int j = 0; j < 4; ++j) {
                        const bf16x8 a = __builtin_shufflevector(ft[m4 & 1][2 * j], ft[m4 & 1][2 * j + 1], 0, 1, 2, 3, 4, 5, 6, 7);
                        O[4 * m4 + j] = MFMA16(a, pb, O[4 * m4 + j]);
                    }
                    __builtin_amdgcn_sched_barrier(0);
                }
#undef D2_LDT
            }
        }
#undef D2_GATHER
        float lt = lrun + __shfl_xor(lrun, 16); lt += __shfl_xor(lt, 32);
        const float inv = __builtin_amdgcn_rcpf(lt);
        if (c16 < 8 && !p.pad) {
#pragma unroll
            for (int mt = 0; mt < 16; ++mt) { u32x2 w; w.x = cvt_pk_bf16(O[mt][0] * inv, O[mt][1] * inv); w.y = cvt_pk_bf16(O[mt][2] * inv, O[mt][3] * inv);
                *(u32x2*)(QL + token * 2048 + c16 * 256 + 16 * mt + 4 * q) = w; }
        }
    }
}
constexpr int D1_SC = 0, D1_WI = 16 * 2048 * 4;
static_assert(D1_WI + 512 + 8 * 256 <= LDSCTL_OFF, "indexer LDS map");
__device__ __forceinline__ void d1_phase(const Params& p, LAS unsigned char* lds) {
    const int tid = threadIdx.x, wave = __builtin_amdgcn_readfirstlane(tid >> 6), G = gridDim.x;
    const bf16_t* QI = (const bf16_t*)(p.ws + OFF_QI); const bf16_t* KI = (const bf16_t*)(p.ws + OFF_KI); const float* SMALL = (const float*)(p.ws + OFF_SMALL);
    u16_t* IDX = (u16_t*)((char*)p.out + OO_IDX);
    LAS float* sc = (LAS float*)(lds + D1_SC); LAS float* swi = (LAS float*)(lds + D1_WI);
    unsigned* qhead = (unsigned*)(p.ws + OFF_CTL) + CW_D1Q + (p.pad == 2 ? 64 : 0); volatile LAS int* qslot = (volatile LAS int*)(lds + LDSCTL_OFF + 128);
    for (;;) {
        if (tid == 0) *qslot = (int)__hip_atomic_fetch_add(qhead, 1u, __ATOMIC_RELAXED, __HIP_MEMORY_SCOPE_AGENT);
        __syncthreads();
        const int unit = *qslot;
        __syncthreads();
        if (unit >= 896) break;
        int lane = tid & 63; asm volatile("" : "+v"(lane));
        const int r = lane & 31, hh = lane >> 5;
        const int b = unit & 7, t0 = 256 + 16 * (111 - (unit >> 3));
        const size_t tok0 = (size_t)b * NT + t0;
        if (tid < 128) swi[tid] = SMALL[(tok0 + (tid >> 3)) * 32 + 16 + (tid & 7)] * 0.04419417382415922f;
        const int tokr = ((r >> 2) & 1) | ((r >> 4) << 1), headr = (r & 3) | (((r >> 3) & 1) << 2);
        bf16x8 af[4][4];
#pragma unroll
        for (int mt = 0; mt < 4; ++mt)
#pragma unroll
            for (int s = 0; s < 4; ++s) af[mt][s] = *(const bf16x8*)(QI + (tok0 + 4 * mt + tokr) * 512 + headr * 64 + 16 * s + 8 * hh);
        __syncthreads();
        const int ntiles = (t0 + 16 + 31) >> 5;
        bf16x8 bnx[4];
        if (wave < ntiles) {
#pragma unroll
            for (int s = 0; s < 4; ++s) bnx[s] = *(const bf16x8*)(KI + ((size_t)b * NT + 32 * wave + r) * 64 + 16 * s + 8 * hh);
        }
#pragma unroll 1
        for (int nt = wave; nt < ntiles; nt += NWAVES) {
            const int key = 32 * nt + r;
            bf16x8 bfr[4];
#pragma unroll
            for (int s = 0; s < 4; ++s) bfr[s] = bnx[s];
            if (nt + NWAVES < ntiles) {
#pragma unroll
                for (int s = 0; s < 4; ++s) bnx[s] = *(const bf16x8*)(KI + ((size_t)b * NT + key + 32 * NWAVES) * 64 + 16 * s + 8 * hh);
            }
#pragma unroll
            for (int mt = 0; mt < 4; ++mt) {
                f32x16 acc;
#pragma unroll
                for (int e = 0; e < 16; ++e) acc[e] = 0.f;
#pragma unroll
                for (int s = 0; s < 4; ++s) acc = MFMA32(af[mt][s], bfr[s], acc);
                const int ta = 4 * mt + hh, tb = ta + 2;
                const f32x4 wa0 = *(const LAS f32x4*)(swi + ta * 8), wa1 = *(const LAS f32x4*)(swi + ta * 8 + 4), wb0 = *(const LAS f32x4*)(swi + tb * 8), wb1 = *(const LAS f32x4*)(swi + tb * 8 + 4);
                float s0 = 0.f, s1 = 0.f;
#pragma unroll
                for (int e = 0; e < 4; ++e) { s0 += wa0[e] * fmaxf(acc[e], 0.f); s0 += wa1[e] * fmaxf(acc[4 + e], 0.f); s1 += wb0[e] * fmaxf(acc[8 + e], 0.f); s1 += wb1[e] * fmaxf(acc[12 + e], 0.f); }
                sc[ta * 2048 + key] = s0; sc[tb * 2048 + key] = s1;
            }
        }
        __syncthreads();
#pragma unroll 1
        for (int tt = 0; tt < 2; ++tt) {
            const int ti = 2 * wave + tt, t = t0 + ti;
            unsigned u[32];
#pragma unroll
            for (int i = 0; i < 32; ++i) u[i] = 0u;
#pragma unroll
            for (int g8 = 0; g8 < 4; ++g8) if (g8 * 512 <= t) _Pragma("unroll") for (int i = 8 * g8; i < 8 * g8 + 8; ++i) {
                const int key = lane + 64 * i;
                float x = sc[ti * 2048 + key] + 0.0f;
                unsigned v = __float_as_uint(x); v = (v & 0x80000000u) ? ~v : (v | 0x80000000u);
                u[i] = (key <= t) ? v : 0u;
            }
            unsigned P = 0u, Q = 0xFFFFFFFFu; int cQ = 0, cP = 2048;
            bool exact = false; int bit = 31;
#pragma unroll 1
            for (; bit >= 0; --bit) {
                const unsigned cand = P | (1u << bit);
                int cl = 0;
#pragma unroll
                for (int g8 = 0; g8 < 4; ++g8) if (g8 * 512 <= t) _Pragma("unroll") for (int i = 8 * g8; i < 8 * g8 + 8; ++i) cl += (u[i] >= cand) ? 1 : 0;
                int cnt = 0;
#pragma unroll
                for (int bb = 0; bb < 6; ++bb) cnt += __popcll(__ballot((cl >> bb) & 1)) << bb;
                if (cnt >= 256) { P = cand; cP = cnt; if (cnt == 256) { exact = true; break; } }
                else { Q = cand; cQ = cnt; }
                if (cP - cQ <= 64) { --bit; break; }
            }
            if (!exact && bit >= 0) {
                LAS unsigned* wsc = (LAS unsigned*)(lds + D1_WI + 512) + wave * 64;
                int pos = 0;
#pragma unroll
                for (int g8 = 0; g8 < 4; ++g8) if (g8 * 512 <= t) _Pragma("unroll") for (int i = 8 * g8; i < 8 * g8 + 8; ++i) { const bool in = (u[i] >= P) && (u[i] < Q); const unsigned long long m = __ballot(in);
                    if (in) wsc[pos + __builtin_amdgcn_mbcnt_hi((unsigned)(m >> 32), __builtin_amdgcn_mbcnt_lo((unsigned)m, 0u))] = u[i];
                    pos += __popcll(m); }
                const int mcnt = pos, rneed = 256 - cQ;
                const unsigned x = (lane < mcnt) ? wsc[lane] : 0u;
                int gt = 0;
                for (int m2 = 0; m2 < mcnt; ++m2) { const unsigned y = (unsigned)__builtin_amdgcn_readlane((int)x, m2); gt += (y > x) ? 1 : 0; }
                unsigned cand2 = (lane < mcnt && gt < rneed) ? x : 0xFFFFFFFFu;
#pragma unroll
                for (int o = 32; o > 0; o >>= 1) { const unsigned y = (unsigned)__shfl_xor((int)cand2, o); cand2 = y < cand2 ? y : cand2; }
                P = cand2;
                const int gtc = __popcll(__ballot(lane < mcnt && x > cand2)), eqc = __popcll(__ballot(lane < mcnt && x == cand2));
                exact = (cQ + gtc + eqc == 256);
            }
            u16_t* out = IDX + (tok0 + ti) * 256;
            int pos = 0;
            if (exact) {
#pragma unroll
                for (int g8 = 0; g8 < 4; ++g8) if (g8 * 512 <= t) _Pragma("unroll") for (int i = 8 * g8; i < 8 * g8 + 8; ++i) { const bool sel = u[i] >= P; const unsigned long long m = __ballot(sel);
                    if (sel) out[pos + __builtin_amdgcn_mbcnt_hi((unsigned)(m >> 32), __builtin_amdgcn_mbcnt_lo((unsigned)m, 0u))] = (u16_t)(lane + 64 * i);
                    pos += __popcll(m); }
            } else {
#pragma unroll
                for (int g8 = 0; g8 < 4; ++g8) if (g8 * 512 <= t) _Pragma("unroll") for (int i = 8 * g8; i < 8 * g8 + 8; ++i) { const bool sel = u[i] > P; const unsigned long long m = __ballot(sel);
                    if (sel) out[pos + __builtin_amdgcn_mbcnt_hi((unsigned)(m >> 32), __builtin_amdgcn_mbcnt_lo((unsigned)m, 0u))] = (u16_t)(lane + 64 * i);
                    pos += __popcll(m); }
                int need = 256 - pos;
#pragma unroll
                for (int g8 = 0; g8 < 4; ++g8) if (g8 * 512 <= t) _Pragma("unroll") for (int i = 8 * g8; i < 8 * g8 + 8; ++i) { const bool eq = u[i] == P; const unsigned long long m = __ballot(eq);
                    const int rk = __builtin_amdgcn_mbcnt_hi((unsigned)(m >> 32), __builtin_amdgcn_mbcnt_lo((unsigned)m, 0u));
                    if (eq && rk < need) out[pos + rk] = (u16_t)(lane + 64 * i);
                    const int c = __popcll(m), take = c < need ? c : need; pos += take; need -= take; }
            }
        }
        __syncthreads();
    }
}
__device__ __forceinline__ void ckvnorm_phase(const Params& p) {
    const int tid = threadIdx.x, lane = tid & 63, wave = tid >> 6, G = gridDim.x;
    bf16_t* CKV = (bf16_t*)(p.ws + OFF_CKV); const float* g = p.in[11];
    const f32x4 gv = *(const f32x4*)(g + 4 * lane);
    for (int row = blockIdx.x * NWAVES + wave; row < MROWS; row += G * NWAVES) {
        u32x2* rp = (u32x2*)(CKV + (size_t)row * 256 + 4 * lane);
        const u32x2 w = *rp; const float v0 = bflo(w.x), v1 = bfhi(w.x), v2 = bflo(w.y), v3 = bfhi(w.y);
        const float ss = wave_sum(v0 * v0 + v1 * v1 + v2 * v2 + v3 * v3);
        const float rs = rsqrtf(ss * (1.f / 256.f) + 1e-6f);
        u32x2 o; o.x = cvt_pk_bf16(v0 * rs * gv[0], v1 * rs * gv[1]); o.y = cvt_pk_bf16(v2 * rs * gv[2], v3 * rs * gv[3]);
        *rp = o;
    }
}
__global__ void __launch_bounds__(NTHR, 2) fwd(Params p) {
    extern __shared__ __attribute__((aligned(16))) unsigned char lds_raw[];
    LAS unsigned char* lds = (LAS unsigned char*)lds_raw;
    const int tid = threadIdx.x;
    for (int u = tid; u < (LDS_BYTES - LDSCTL_OFF) / 4; u += NTHR) ((LAS unsigned*)(lds + LDSCTL_OFF))[u] = 0u;
    __syncthreads();
    const Bufs B = make_bufs(p.ws, (char*)p.out);
    const int lo = p.ph_lo, hi = p.ph_hi;
    unsigned* barw = (unsigned*)(p.ws + OFF_CTL) + CW_BAR + p.li * XCD_BAR_WORDS;
    XcdBarrier bar; bar.bar = barw; bar.x = 0; bar.st = nullptr;
    if (hi - lo > 1) bar = xcd_barrier_post(barw, (volatile LAS unsigned*)(lds + LDSCTL_OFF + 64));
#define IN(k) (lo <= (k) && (k) < hi)
#define SEAM(k) do { if (IN(k) && IN((k) + 1)) xcd_barrier(bar); } while (0)
    if (IN(0)) { p0_prologue(p, B, lds); SEAM(0); }
    if (IN(1)) { p1_h(p, B); SEAM(1); }
    if (IN(2)) {
        SchedProj S; S.so.init(MROWS, NPAD, gridDim.x, blockIdx.x); S.A = (const char*)B.H; S.Bt = (const char*)B.WT;
        EpiProj E{p.ws, (char*)p.out};
        pg8::gemm_phase<EpiProj, SchedProj, true, true>(lds + RING_OFF, DM, DM, DM, S, E);
        SEAM(2);
    }
    if (IN(3)) { g1_phase(p, lds); ckvnorm_phase(p); SEAM(3); }
    if (IN(4)) { if (p.pad != 2) g2_phase(p, lds); d1_phase(p, lds); SEAM(4); }
    if (IN(5)) { qlat_phase(p, lds); SEAM(5); }
    if (IN(6)) { d2_phase(p, lds); SEAM(6); }
    if (IN(7)) { wuv_phase(p, lds); SEAM(7); }
    if (IN(8)) {
        SchedMerge S; S.so.init(MROWS, DM, gridDim.x, blockIdx.x); S.ws = p.ws; S.os = (const char*)p.out;
        EpiMerge E{B.MERGED, B.PARK};
        pg8::gemm_phase<EpiMerge, SchedMerge, true, true>(lds + RING_OFF, DM, DM, DM, S, E);
        SEAM(8);
    }
    if (IN(9)) {
        SchedProj S; S.so.init(MROWS, DM, gridDim.x, blockIdx.x); S.A = (const char*)B.MERGED; S.Bt = (const char*)B.WOUT_T;
        EpiOut E{p.in[0], B.MOD, B.XNEW};
        pg8::gemm_phase<EpiOut, SchedProj, true, true>(lds + RING_OFF, DM, DM, DM, S, E);
        SEAM(9);
    }
    if (IN(10)) { p8_final(p, B); }
#undef IN
#undef SEAM
}

extern "C" void kernel_launch(void* const* d_in, const int* in_sizes, int n_in, void* d_out, int out_size, void* d_ws, size_t ws_size, hipStream_t stream) {
    static int grid = 0;
    if (grid == 0) {
        if (n_in != 18 || ws_size < WS_NEED || out_size != MROWS * DM) { fprintf(stderr, "kernel_launch: unexpected shapes (n_in %d, ws %zu, out %d)\n", n_in, ws_size, out_size); grid = -1; return; }
        int dev = 0, cus = 0;
        if (hipGetDevice(&dev) != hipSuccess || hipDeviceGetAttribute(&cus, hipDeviceAttributeMultiprocessorCount, dev) != hipSuccess) { grid = -1; return; }
        if (hipFuncSetAttribute((const void*)fwd, hipFuncAttributeMaxDynamicSharedMemorySize, LDS_BYTES) != hipSuccess) { fprintf(stderr, "kernel_launch: hipFuncSetAttribute failed\n"); grid = -1; return; }
        int per_cu = 0;
        if (hipOccupancyMaxActiveBlocksPerMultiprocessor(&per_cu, (const void*)fwd, NTHR, LDS_BYTES) != hipSuccess || per_cu < 1) fprintf(stderr, "kernel_launch: occupancy query says %d\n", per_cu);
        (void)hipGetLastError();
        grid = cus > 0 ? cus : 256;
    }
    if (grid < 0) return;
    (void)hipMemsetAsync((char*)d_ws + OFF_CTL, 0, CTL_ZERO_BYTES, stream);
    Params p{};
    for (int i = 0; i < 18; ++i) p.in[i] = (const float*)d_in[i];
    p.out = (float*)d_out; p.ws = (char*)d_ws;
    int li = 0;
#define FWD(lo_, hi_) do { p.pad = 0; p.ph_lo = (lo_); p.ph_hi = (hi_); p.li = ((hi_) - (lo_) > 1) ? li++ : 0; hipLaunchKernelGGL(fwd, dim3(grid), dim3(NTHR), LDS_BYTES, stream, p); } while (0)
#define DRY(lo_, hi_) do { p.pad = 1; p.ph_lo = (lo_); p.ph_hi = (hi_); p.li = 0; hipLaunchKernelGGL(fwd, dim3(grid), dim3(NTHR), LDS_BYTES, stream, p); } while (0)
#if PROBE_SEQ == 0
    FWD(0, 11);
#elif PROBE_SEQ == 1
    FWD(0, 3); DRY(3, 4); FWD(3, 11);
#elif PROBE_SEQ == 2
    FWD(0, 4); DRY(4, 5); FWD(4, 11);
#elif PROBE_SEQ == 3
    FWD(0, 6); DRY(6, 7); FWD(6, 11);
#elif PROBE_SEQ == 4
    FWD(0, 4); p.pad = 2; p.ph_lo = 4; p.ph_hi = 5; p.li = 0; hipLaunchKernelGGL(fwd, dim3(grid), dim3(NTHR), LDS_BYTES, stream, p); FWD(4, 11);
#endif
#undef FWD
}
```

```cpp
#include <hip/hip_runtime.h>
#include <stdint.h>
#include <stdio.h>

#ifndef PROBE_SEQ
#define PROBE_SEQ 0
#endif
#define LAS __attribute__((address_space(3)))
typedef unsigned short bf16_t;
typedef short bf16x8 __attribute__((ext_vector_type(8)));
typedef float f32x4 __attribute__((ext_vector_type(4)));
typedef unsigned u32x4 __attribute__((ext_vector_type(4)));
typedef unsigned u32x2 __attribute__((ext_vector_type(2)));
__device__ __forceinline__ float bf2f(bf16_t v) { return __uint_as_float(((unsigned)v) << 16); }
__device__ __forceinline__ bf16_t f2bf(float f) { unsigned u = __float_as_uint(f); u += 0x7FFFu + ((u >> 16) & 1u); return (bf16_t)(u >> 16); }
__device__ __forceinline__ float bflo(unsigned w) { return __uint_as_float(w << 16); }
__device__ __forceinline__ float bfhi(unsigned w) { return __uint_as_float(w & 0xFFFF0000u); }
__device__ __forceinline__ unsigned cvt_pk_bf16(float lo, float hi) { unsigned r; asm volatile("v_cvt_pk_bf16_f32 %0, %1, %2" : "=v"(r) : "v"(lo), "v"(hi)); return r; }
__device__ __forceinline__ float silu_f(float x) { return x * __builtin_amdgcn_rcpf(1.f + __expf(-x)); }
__device__ __forceinline__ float sigmoid_f(float x) { return __builtin_amdgcn_rcpf(1.f + __expf(-x)); }
__device__ __forceinline__ float wave_sum(float v) {
#pragma unroll
    for (int o = 32; o > 0; o >>= 1) v += __shfl_xor(v, o);
    return v;
}
__device__ __forceinline__ float wave_max(float v) {
#pragma unroll
    for (int o = 32; o > 0; o >>= 1) v = fmaxf(v, __shfl_xor(v, o));
    return v;
}

constexpr int NB = 8, NT = 2048, DM = 1024, MROWS = NB * NT;
constexpr int NPAD = 7168;
constexpr int NWT = 9216;
constexpr size_t MiB = 1ull << 20;
constexpr size_t OFF_CTL = 0, CTL_ZERO_BYTES = 64 * 1024, OFF_MOD = 64 * 1024, OFF_SMALL = 1 * MiB, OFF_KI = 3 * MiB, OFF_CKV = 5 * MiB, OFF_QI = 13 * MiB,
                 OFF_QA = 29 * MiB, OFF_KA = 61 * MiB, OFF_VA = 93 * MiB, OFF_ZA = 125 * MiB, OFF_QB = 157 * MiB, OFF_ZB = 189 * MiB,
                 OFF_H = 221 * MiB, OFF_WOUT_T = 253 * MiB, WS_NEED = 255 * MiB;
constexpr size_t OFF_XNEW = OFF_QA, OFF_MERGED = OFF_VA, OFF_PARK = OFF_KA;
constexpr size_t OO_WT = 0, OO_WOG_T = 18 * MiB, OO_WOD_T = 20 * MiB;
constexpr size_t OO_TPATT = 31 * MiB;
constexpr size_t OO_STASH = 55 * MiB;
constexpr size_t OO_DEC = 60 * MiB;
constexpr size_t OO_WUK_B = 22 * MiB;
constexpr size_t OO_WUV_T = 22 * MiB + 512 * 1024;
constexpr size_t OO_IDX = 23 * MiB;
constexpr int CW_BAR = 1024, CW_D1Q = 64;

__host__ __device__ __forceinline__ int wt_col(int n) {
    if (n < 4096) return n;
    if (n < 5120) return 4112 + (n - 4096);
    if (n < 6144) return 5392 + (n - 5120);
    if (n < 6400) return 5136 + (n - 6144);
    if (n < 6912) return 6416 + (n - 6400);
    if (n < 6976) return 6928 + (n - 6912);
    if (n < 6984) return 4096 + (n - 6976);
    if (n < 6992) return 4104 + (n - 6984);
    if (n < 7000) return 6992 + (n - 6992);
    if (n < 7168) return -1;
    return 7000 + (n - 7168);
}

struct Bufs {
    bf16_t *QA, *KA, *VA, *ZA, *QB, *ZB, *CKV, *QI, *KI, *H, *WT, *WOG_T, *WOD_T, *WOUT_T, *MERGED, *PARK;
    float *SMALL, *MOD, *XNEW;
};
__host__ __device__ __forceinline__ Bufs make_bufs(char* ws, char* os) {
    Bufs B;
    B.QA = (bf16_t*)(ws + OFF_QA); B.KA = (bf16_t*)(ws + OFF_KA); B.VA = (bf16_t*)(ws + OFF_VA); B.ZA = (bf16_t*)(ws + OFF_ZA);
    B.QB = (bf16_t*)(ws + OFF_QB); B.ZB = (bf16_t*)(ws + OFF_ZB); B.CKV = (bf16_t*)(ws + OFF_CKV); B.QI = (bf16_t*)(ws + OFF_QI);
    B.KI = (bf16_t*)(ws + OFF_KI); B.H = (bf16_t*)(ws + OFF_H); B.WT = (bf16_t*)(os + OO_WT); B.WOG_T = (bf16_t*)(os + OO_WOG_T);
    B.WOD_T = (bf16_t*)(os + OO_WOD_T); B.WOUT_T = (bf16_t*)(ws + OFF_WOUT_T); B.MERGED = (bf16_t*)(ws + OFF_MERGED); B.PARK = (bf16_t*)(ws + OFF_PARK);
    B.SMALL = (float*)(ws + OFF_SMALL); B.MOD = (float*)(ws + OFF_MOD); B.XNEW = (float*)(ws + OFF_XNEW);
    return B;
}

namespace pg8 {
#define PG8_LAS __attribute__((address_space(3)))
constexpr int BM = 256, BK = 64, HALF = 128, HTB = HALF * BK * 2  , STAGE_BYTES = 8 * HTB, NXCD = 8, WGM = 8;
__host__ __device__ __forceinline__ int lds_byte(int r, int c) { const int st = (r >> 4) * 2 + (c >> 5), rr = r & 15, cc = c & 31, ob = rr * 64 + cc * 2; return st * 1024 + (ob ^ (((ob >> 9) & 1) << 5)); }
__host__ __device__ __forceinline__ void stage_rc(int b, int& R, int& C) { const int st = b / 1024, sb = b % 1024, swz = sb ^ (((sb >> 9) & 1) << 5); R = (st >> 1) * 16 + swz / 64; C = (st & 1) * 32 + (swz % 64) / 2; }
__host__ __device__ __forceinline__ int perm32(int rho) { const int n = rho >> 4, i = rho & 15; return 8 * (i >> 2) + 4 * n + (i & 3); }
struct Unit { int pm, pn, st; };
struct StaticOrder {
    int nM, nN, nwg, G, c;
    __host__ __device__ void init(int M, int N, int G_, int c_) { nM = M / BM; nN = N / BM; nwg = nM * nN; G = G_; c = c_; }
    __host__ __device__ bool tile(int i, int& pm, int& pn) const {
        const long L = (long)i * G + c; if (L >= nwg) return false;
        int wgid = (int)L; { const int q = nwg / NXCD, r = nwg % NXCD, xcd = wgid % NXCD, off = wgid / NXCD; wgid = (xcd < r ? xcd * (q + 1) : r * (q + 1) + (xcd - r) * q) + off; }
        const int nig = WGM * nN, gid = wgid / nig, fm = gid * WGM, gsz = (nM - fm) < WGM ? (nM - fm) : WGM;
        pm = fm + ((wgid % nig) % gsz); pn = (wgid % nig) / gsz; return true;
    }
};
template <class Epi, class Sched, bool ALIGN_EPI = false, bool SP2 = false>
__device__ __forceinline__ void gemm_phase(PG8_LAS unsigned char* lds, const int K, const int lda, const int ldb, const Sched& S, const Epi& E) {
    const int tid = threadIdx.x, wid = __builtin_amdgcn_readfirstlane(tid >> 6), lane = tid & 63, wr = wid >> 2, wc = wid & 3, fr = lane & 15, fq = lane >> 4;
    const int nt = K / BK;
    unsigned voffA[2], voffB[2];
#pragma unroll
    for (int i = 0; i < 2; ++i) { int R, C; stage_rc(tid * 16 + i * 8192, R, C); const int Rb = Epi::PERM ? ((R & ~31) + perm32(R & 31)) : R;
        voffA[i] = (unsigned)(R * lda + C) * 2u; voffB[i] = (unsigned)(Rb * ldb + C) * 2u; }
    const size_t kstep = (size_t)(BK * 2);
    const size_t hstepA = (size_t)HALF * lda * 2, hstepB = (size_t)HALF * ldb * 2;
    const unsigned ldsw = (unsigned)wid * 1024u;
    const int aoff = lds_byte(wr * 64 + fr, fq * 8), boff = lds_byte(wc * 32 + fr, fq * 8);
#define PG8_SA(b, h) (((b) * 2 + (h)) * HTB)
#define PG8_SB(b, h) ((4 + (b) * 2 + (h)) * HTB)
#define PG8_STAGE(bufoff, gbase, voff) do { _Pragma("unroll") for (int _i = 0; _i < 2; ++_i) \
        __builtin_amdgcn_global_load_lds((const unsigned*)((const char*)(gbase) + (voff)[_i]), (PG8_LAS unsigned*)(lds + (bufoff) + ldsw + _i * 8192), 16, 0, 0); } while (0)
#define PG8_LDA(dst, b, h) do { _Pragma("unroll") for (int m = 0; m < 4; ++m) _Pragma("unroll") for (int k = 0; k < 2; ++k) dst[m][k] = *(const PG8_LAS bf16x8*)(lds + PG8_SA(b, h) + aoff + m * 2048 + k * 1024); } while (0)
#define PG8_LDB(dst, b, h) do { _Pragma("unroll") for (int n = 0; n < 2; ++n) _Pragma("unroll") for (int k = 0; k < 2; ++k) dst[n][k] = *(const PG8_LAS bf16x8*)(lds + PG8_SB(b, h) + boff + n * 2048 + k * 1024); } while (0)
#define PG8_MMA(ai, bj, At, Bt) do { __builtin_amdgcn_s_setprio(1); _Pragma("unroll") for (int m = 0; m < 4; ++m) _Pragma("unroll") for (int n = 0; n < 2; ++n) _Pragma("unroll") for (int k = 0; k < 2; ++k) \
        acc[ai][bj][m][n] = __builtin_amdgcn_mfma_f32_16x16x32_bf16(Bt[n][k], At[m][k], acc[ai][bj][m][n], 0, 0, 0); __builtin_amdgcn_s_setprio(0); } while (0)
#define PG8_WAIT_V(n) asm volatile("s_waitcnt vmcnt(" #n ")" ::: "memory")
#define PG8_WAIT_L(n) asm volatile("s_waitcnt lgkmcnt(" #n ")" ::: "memory")
#define PG8_BAR __builtin_amdgcn_s_barrier()
#define PG8_SCHED __builtin_amdgcn_sched_barrier(0)
    Unit cur, nxt; int ui = 0;
    if (!S.next(0, cur)) return;
    f32x4 acc[2][2][4][2];
#pragma unroll
    for (int a = 0; a < 2; ++a)
#pragma unroll
        for (int b = 0; b < 2; ++b)
#pragma unroll
            for (int m = 0; m < 4; ++m)
#pragma unroll
                for (int n = 0; n < 2; ++n) acc[a][b][m][n] = (f32x4){0.f, 0.f, 0.f, 0.f};
    bf16x8 At[4][2], B0[2][2], B1[2][2];
    const char* cA = S.a_ptr(cur); const char* cB = S.b_ptr(cur);
    S.a_ready(cur);
    if constexpr (SP2) {
        PG8_STAGE(PG8_SB(0, 0), cB, voffB); PG8_STAGE(PG8_SB(0, 1), cB + hstepB, voffB); PG8_STAGE(PG8_SA(0, 0), cA, voffA); PG8_STAGE(PG8_SA(0, 1), cA + hstepA, voffA);
        if (wr == 1) PG8_BAR;
        PG8_WAIT_V(2); PG8_BAR;
        PG8_STAGE(PG8_SB(1, 0), cB + kstep, voffB); PG8_STAGE(PG8_SA(1, 0), cA + kstep, voffA); PG8_STAGE(PG8_SB(1, 1), cB + hstepB + kstep, voffB);
        PG8_WAIT_V(6); PG8_BAR;
    } else {
        PG8_STAGE(PG8_SB(0, 0), cB, voffB); PG8_STAGE(PG8_SA(0, 0), cA, voffA); PG8_STAGE(PG8_SB(0, 1), cB + hstepB, voffB); PG8_STAGE(PG8_SA(0, 1), cA + hstepA, voffA);
        if (wr == 1) PG8_BAR;
        PG8_WAIT_V(4); PG8_BAR;
        PG8_STAGE(PG8_SB(1, 0), cB + kstep, voffB); PG8_STAGE(PG8_SA(1, 0), cA + kstep, voffA); PG8_STAGE(PG8_SB(1, 1), cB + hstepB + kstep, voffB);
        PG8_WAIT_V(6); PG8_BAR;
    }
    for (;;) {
        const bool has_next = S.next(ui + 1, nxt);
        const char* nA = has_next ? S.a_ptr(nxt) : cA; const char* nB = has_next ? S.b_ptr(nxt) : cB;
        for (int t = 0; t < nt; t += 2) {
            const bool last = (t == nt - 2);
            const char* a1 = cA + (size_t)(t + 1) * kstep;
            const char* a2 = last ? nA : cA + (size_t)(t + 2) * kstep; const char* b2 = last ? nB : cB + (size_t)(t + 2) * kstep;
            const char* a3 = a2 + kstep; const char* b3 = b2 + kstep;
            if (last && has_next) S.a_ready(nxt);
            if constexpr (SP2) {
            PG8_LDB(B0, 0, 0); PG8_LDB(B1, 0, 1); PG8_SCHED; PG8_LDA(At, 0, 0); PG8_STAGE(PG8_SA(1, 1), a1 + hstepA, voffA);
            PG8_WAIT_V(8); PG8_WAIT_L(0); PG8_BAR; PG8_MMA(0, 0, At, B0); PG8_MMA(0, 1, At, B1); PG8_BAR; PG8_SCHED;
            PG8_LDA(At, 0, 1); PG8_STAGE(PG8_SB(0, 0), b2, voffB); PG8_STAGE(PG8_SB(0, 1), b2 + hstepB, voffB); PG8_STAGE(PG8_SA(0, 0), a2, voffA);
            PG8_WAIT_V(8); PG8_WAIT_L(0); PG8_BAR; PG8_MMA(1, 0, At, B0); PG8_MMA(1, 1, At, B1); PG8_BAR; PG8_SCHED;
            PG8_LDB(B0, 1, 0); PG8_LDB(B1, 1, 1); PG8_SCHED; PG8_LDA(At, 1, 0); PG8_STAGE(PG8_SA(0, 1), a2 + hstepA, voffA);
            PG8_WAIT_V(8); PG8_WAIT_L(0); PG8_BAR; PG8_MMA(0, 0, At, B0); PG8_MMA(0, 1, At, B1); PG8_BAR; PG8_SCHED;
            PG8_LDA(At, 1, 1); PG8_STAGE(PG8_SB(1, 0), b3, voffB); PG8_STAGE(PG8_SB(1, 1), b3 + hstepB, voffB); PG8_STAGE(PG8_SA(1, 0), a3, voffA);
            PG8_WAIT_V(8); PG8_WAIT_L(0); PG8_BAR; PG8_MMA(1, 0, At, B0); PG8_MMA(1, 1, At, B1); PG8_BAR; PG8_SCHED;
            } else {
            PG8_LDB(B0, 0, 0); PG8_SCHED; PG8_LDA(At, 0, 0); PG8_STAGE(PG8_SA(1, 1), a1 + hstepA, voffA);
            PG8_WAIT_L(8); PG8_BAR; PG8_WAIT_L(0); PG8_MMA(0, 0, At, B0); PG8_BAR; PG8_SCHED;
            PG8_LDB(B1, 0, 1); PG8_STAGE(PG8_SB(0, 0), b2, voffB);
            PG8_BAR; PG8_WAIT_L(0); PG8_MMA(0, 1, At, B1); PG8_BAR;
            PG8_LDA(At, 0, 1); PG8_STAGE(PG8_SA(0, 0), a2, voffA);
            PG8_BAR; PG8_WAIT_L(0); PG8_MMA(1, 0, At, B0); PG8_BAR; PG8_SCHED;
            PG8_STAGE(PG8_SB(0, 1), b2 + hstepB, voffB);
            PG8_WAIT_V(6); PG8_BAR; PG8_MMA(1, 1, At, B1); PG8_BAR;
            PG8_LDB(B0, 1, 0); PG8_SCHED; PG8_LDA(At, 1, 0); PG8_STAGE(PG8_SA(0, 1), a2 + hstepA, voffA);
            PG8_WAIT_L(8); PG8_BAR; PG8_WAIT_L(0); PG8_MMA(0, 0, At, B0); PG8_BAR; PG8_SCHED;
            PG8_LDB(B1, 1, 1); PG8_STAGE(PG8_SB(1, 0), b3, voffB);
            PG8_BAR; PG8_WAIT_L(0); PG8_MMA(0, 1, At, B1); PG8_BAR;
            PG8_LDA(At, 1, 1); PG8_STAGE(PG8_SA(1, 0), a3, voffA);
            PG8_BAR; PG8_WAIT_L(0); PG8_MMA(1, 0, At, B0); PG8_BAR; PG8_SCHED;
            PG8_STAGE(PG8_SB(1, 1), b3 + hstepB, voffB);
            PG8_WAIT_V(6); PG8_BAR; PG8_MMA(1, 1, At, B1); PG8_BAR;
            }
        }
        if constexpr (ALIGN_EPI) { if (wr == 0) PG8_BAR; }
        if constexpr (!Epi::AFTER_DRAIN) { E(acc, cur, wr, wc, fr, fq); S.done(cur); }
        if (!has_next) break;
#pragma unroll
        for (int a = 0; a < 2; ++a)
#pragma unroll
            for (int b = 0; b < 2; ++b)
#pragma unroll
                for (int m = 0; m < 4; ++m)
#pragma unroll
                    for (int n = 0; n < 2; ++n) acc[a][b][m][n] = (f32x4){0.f, 0.f, 0.f, 0.f};
        cur = nxt; cA = nA; cB = nB; ++ui;
        if constexpr (ALIGN_EPI) { if (wr == 1) PG8_BAR; }
    }
    PG8_WAIT_V(0);
    if constexpr (!ALIGN_EPI) { if (wr == 0) PG8_BAR; }
    PG8_BAR;
    if constexpr (Epi::AFTER_DRAIN) { E.fused(acc, cur, wr, wc, fr, fq, lds, wid, lane); S.done(cur); }
#undef PG8_SA
#undef PG8_SB
#undef PG8_STAGE
#undef PG8_LDA
#undef PG8_LDB
#undef PG8_MMA
#undef PG8_WAIT_V
#undef PG8_WAIT_L
#undef PG8_BAR
#undef PG8_SCHED
}
}

struct SchedProj {
    pg8::StaticOrder so; const char* A; const char* Bt;
    __device__ __forceinline__ bool next(int i, pg8::Unit& u) const { u.st = 0; return so.tile(i, u.pm, u.pn); }
    __device__ __forceinline__ const char* a_ptr(const pg8::Unit& u) const { return A + (size_t)u.pm * (256 * DM * 2); }
    __device__ __forceinline__ const char* b_ptr(const pg8::Unit& u) const { return Bt + (size_t)u.pn * (256 * DM * 2); }
    __device__ __forceinline__ void a_ready(const pg8::Unit&) const {}
    __device__ __forceinline__ void done(const pg8::Unit&) const {}
};
struct SchedMerge {
    pg8::StaticOrder so; const char* ws; const char* os;
    __device__ __forceinline__ bool next(int i, pg8::Unit& u) const { u.st = i & 3; return so.tile(i >> 2, u.pm, u.pn); }
    __device__ __forceinline__ const char* a_ptr(const pg8::Unit& u) const {
        const size_t off = (u.st == 1) ? OFF_ZA : (u.st == 3) ? OFF_QB : OFF_H;
        return ws + off + (size_t)u.pm * (256 * DM * 2); }
    __device__ __forceinline__ const char* b_ptr(const pg8::Unit& u) const {
        const size_t off = (u.st == 0) ? (OO_WT + (size_t)7168 * DM * 2) : (u.st == 1) ? OO_WOG_T : (u.st == 2) ? (OO_WT + (size_t)8192 * DM * 2) : OO_WOD_T;
        return os + off + (size_t)u.pn * (256 * DM * 2); }
    __device__ __forceinline__ void a_ready(const pg8::Unit&) const {}
    __device__ __forceinline__ void done(const pg8::Unit&) const {}
};

__device__ __forceinline__ u32x4 pack8(const f32x4 v0, const f32x4 v1) { u32x4 w; w.x = cvt_pk_bf16(v0[0], v0[1]); w.y = cvt_pk_bf16(v0[2], v0[3]); w.z = cvt_pk_bf16(v1[0], v1[1]); w.w = cvt_pk_bf16(v1[2], v1[3]); return w; }
struct EpiProj {
    static constexpr bool PERM = true, AFTER_DRAIN = false;
    char* ws; char* os;
    __device__ __forceinline__ void operator()(const f32x4 (&acc)[2][2][4][2], const pg8::Unit& u, int wr, int wc, int fr, int fq) const {
        const int row0 = u.pm * 256 + wr * 64 + fr, lc0 = wc * 32 + 8 * fq, pn = u.pn;
        bf16_t* const KI = (bf16_t*)(ws + OFF_KI); float* const SMALL = (float*)(ws + OFF_SMALL);
        if (pn < 27) {
            bf16_t* base; int ldc, cb;
            if (pn < 24) { base = (bf16_t*)(ws + OFF_QA + (size_t)(pn >> 2) * (32 * MiB)); ldc = 1024; cb = (pn & 3) * 256; }
            else if (pn == 24) { base = (bf16_t*)(ws + OFF_CKV); ldc = 256; cb = 0; }
            else { base = (bf16_t*)(ws + OFF_QI); ldc = 512; cb = (pn - 25) * 256; }
#pragma unroll
            for (int ai = 0; ai < 2; ++ai)
#pragma unroll
                for (int m = 0; m < 4; ++m) { bf16_t* rowp = base + (size_t)(row0 + ai * 128 + m * 16) * ldc + cb + lc0;
#pragma unroll
                    for (int bj = 0; bj < 2; ++bj) *(u32x4*)(rowp + bj * 128) = pack8(acc[ai][bj][m][0], acc[ai][bj][m][1]); }
            if (pn < 12 && fr >= 13) {
                bf16_t* st = (bf16_t*)(os + OO_STASH) + (size_t)(pn >> 2) * (256 * 3 * 1024);
#pragma unroll
                for (int ai = 0; ai < 2; ++ai) { const int row = row0 + ai * 128 + 48; bf16_t* sp = st + ((size_t)(row >> 6) * 3 + ((row & 63) - 61)) * 1024 + cb + lc0;
#pragma unroll
                    for (int bj = 0; bj < 2; ++bj) *(u32x4*)(sp + bj * 128) = pack8(acc[ai][bj][3][0], acc[ai][bj][3][1]); }
            }
        } else {
#pragma unroll
            for (int ai = 0; ai < 2; ++ai)
#pragma unroll
                for (int m = 0; m < 4; ++m) { const size_t row = (size_t)(row0 + ai * 128 + m * 16);
                    if (lc0 < 64) *(u32x4*)(KI + row * 64 + lc0) = pack8(acc[ai][0][m][0], acc[ai][0][m][1]);
                    else if (lc0 < 88) { *(f32x4*)(SMALL + row * 32 + (lc0 - 64)) = acc[ai][0][m][0]; *(f32x4*)(SMALL + row * 32 + (lc0 - 64) + 4) = acc[ai][0][m][1]; } }
        }
    }
};
__device__ __forceinline__ f32x4 sig4(const f32x4 v) { f32x4 r; r[0] = sigmoid_f(v[0]); r[1] = sigmoid_f(v[1]); r[2] = sigmoid_f(v[2]); r[3] = sigmoid_f(v[3]); return r; }
__device__ __forceinline__ void unpack8(const u32x4 w, f32x4& a, f32x4& b) { a[0] = bflo(w.x); a[1] = bfhi(w.x); a[2] = bflo(w.y); a[3] = bfhi(w.y); b[0] = bflo(w.z); b[1] = bfhi(w.z); b[2] = bflo(w.w); b[3] = bfhi(w.w); }
struct EpiMerge {
    static constexpr bool PERM = true, AFTER_DRAIN = false;
    bf16_t* MERGED; bf16_t* PARK;
    __device__ __forceinline__ void operator()(const f32x4 (&acc)[2][2][4][2], const pg8::Unit& u, int wr, int wc, int fr, int fq) const {
        const int row0 = u.pm * 256 + wr * 64 + fr, col0 = u.pn * 256 + wc * 32 + 8 * fq, st = u.st;
#pragma unroll
        for (int ai = 0; ai < 2; ++ai)
#pragma unroll
            for (int m = 0; m < 4; ++m) { const size_t off = (size_t)(row0 + ai * 128 + m * 16) * 1024 + col0;
#pragma unroll
                for (int bj = 0; bj < 2; ++bj) {
                    const f32x4 v0 = acc[ai][bj][m][0], v1 = acc[ai][bj][m][1];
                    u32x4* pm_ = (u32x4*)(MERGED + off + bj * 128); u32x4* pp_ = (u32x4*)(PARK + off + bj * 128);
                    if (st == 0) *pm_ = pack8(sig4(v0), sig4(v1));
                    else if (st == 1) { f32x4 g0, g1; unpack8(*pm_, g0, g1); *pm_ = pack8(g0 * v0, g1 * v1); }
                    else if (st == 2) *pp_ = pack8(sig4(v0), sig4(v1));
                    else { f32x4 a0, a1, g0, g1; unpack8(*pm_, a0, a1); unpack8(*pp_, g0, g1); *pm_ = pack8(a0 + g0 * v0, a1 + g1 * v1); }
                } }
    }
};
struct EpiOut {
    static constexpr bool PERM = false, AFTER_DRAIN = false;
    const float* x; const float* MOD; float* XNEW;
    __device__ __forceinline__ void operator()(const f32x4 (&acc)[2][2][4][2], const pg8::Unit& u, int wr, int wc, int fr, int fq) const {
        const int row0 = u.pm * 256 + wr * 64 + fr, col0 = u.pn * 256 + wc * 32 + 4 * fq; const int b = u.pm >> 3;
        f32x4 gv[2][2];
#pragma unroll
        for (int bj = 0; bj < 2; ++bj)
#pragma unroll
            for (int n = 0; n < 2; ++n) gv[bj][n] = *(const f32x4*)(MOD + b * 3072 + 2048 + col0 + bj * 128 + n * 16);
#pragma unroll
        for (int ai = 0; ai < 2; ++ai)
#pragma unroll
            for (int m = 0; m < 4; ++m) { const size_t off = (size_t)(row0 + ai * 128 + m * 16) * 1024 + col0;
#pragma unroll
                for (int bj = 0; bj < 2; ++bj)
#pragma unroll
                    for (int n = 0; n < 2; ++n) { const f32x4 xv = *(const f32x4*)(x + off + bj * 128 + n * 16); *(f32x4*)(XNEW + off + bj * 128 + n * 16) = xv + gv[bj][n] * acc[ai][bj][m][n]; } }
    }
};

#define XB_TMO      128
#define XB_XCNT(j)  (256  + 64 * (j))
#define XB_XSUB(j)  (1280 + 64 * (j))
#define XB_XGEN(j)  (2304 + 64 * (j))
#define XB_TOP      3328
#define XB_TOPGEN   3392
#define XCD_BAR_WORDS 3456
#define XB_SPIN_CAP (1u << 18)

__device__ __forceinline__ unsigned xb_ld(unsigned* p)              { return __hip_atomic_load(p, __ATOMIC_RELAXED, __HIP_MEMORY_SCOPE_AGENT); }
__device__ __forceinline__ unsigned xb_add(unsigned* p, unsigned v) { return __hip_atomic_fetch_add(p, v, __ATOMIC_RELAXED, __HIP_MEMORY_SCOPE_AGENT); }
__device__ __forceinline__ unsigned xb_xcc_id() { return (unsigned)__builtin_amdgcn_s_getreg((3 << 11) | 20) & 0xFu; }
#define XB_SPIN(cond, bar) do { unsigned _sp = 0; while (cond) { __builtin_amdgcn_s_sleep(1); \
    if ((++_sp & 255u) == 0u) { if (xb_ld(&(bar)[XB_TMO])) break; if (_sp > XB_SPIN_CAP) { atomicAdd(&(bar)[XB_TMO], 1u); break; } } } } while (0)

struct XcdBarrier {
    unsigned* bar; unsigned x;
    volatile LAS unsigned* st;
};

__device__ __forceinline__ XcdBarrier xcd_barrier_post(unsigned* bar, volatile LAS unsigned* st) {
    XcdBarrier b; b.bar = bar; b.x = xb_xcc_id(); b.st = st;
    if (threadIdx.x == 0) (void)xb_add(&bar[XB_XCNT(b.x)], 1u);
    return b;
}
__device__ __forceinline__ void xcd_barrier_complete(unsigned* bar, unsigned x, unsigned& nloc, unsigned& nx) {
    const unsigned G = gridDim.x * gridDim.y * gridDim.z;
    unsigned sum, cnt, mine, sp = 0u;
    for (;;) {
        sum = 0u; cnt = 0u; mine = 0u;
#pragma unroll
        for (unsigned j = 0; j < 16; ++j) { const unsigned c = xb_ld(&bar[XB_XCNT(j)]); sum += c; cnt += (c > 0u) ? 1u : 0u; mine = (j == x) ? c : mine; }
        if (sum == G) break;
        __builtin_amdgcn_s_sleep(1);
        if ((++sp & 255u) == 0u) { if (xb_ld(&bar[XB_TMO])) break; if (sp > XB_SPIN_CAP) { atomicAdd(&bar[XB_TMO], 1u); break; } }
    }
    nloc = mine > 0u ? mine : 1u; nx = cnt > 0u ? cnt : 1u;
}

__device__ __forceinline__ void xcd_barrier(const XcdBarrier& b) {
    asm volatile("s_waitcnt vmcnt(0)" ::: "memory");
    __syncthreads();
    if (threadIdx.x == 0) {
        unsigned* bar = b.bar;
        __builtin_amdgcn_s_waitcnt(0);
        unsigned nloc = b.st[0], nx = b.st[1];
        if (nloc == 0u) { xcd_barrier_complete(bar, b.x, nloc, nx); b.st[0] = nloc; b.st[1] = nx; }
        const unsigned old = xb_add(&bar[XB_XSUB(b.x)], 1u);
        const unsigned gen = old / nloc;
        if (old + 1u == (gen + 1u) * nloc) {
            __builtin_amdgcn_fence(__ATOMIC_RELEASE, "agent");
            asm volatile("s_waitcnt vmcnt(0)" ::: "memory");
            const unsigned og = xb_add(&bar[XB_TOP], 1u);
            const unsigned tg = og / nx;
            if (og + 1u == (tg + 1u) * nx) xb_add(&bar[XB_TOPGEN], 1u);
            else XB_SPIN(xb_ld(&bar[XB_TOPGEN]) == tg, bar);
            __builtin_amdgcn_fence(__ATOMIC_ACQUIRE, "agent");
            xb_add(&bar[XB_XGEN(b.x)], 1u);
            asm volatile("s_waitcnt vmcnt(0)" ::: "memory");
        } else {
            XB_SPIN(xb_ld(&bar[XB_XGEN(b.x)]) == gen, bar);
            __builtin_amdgcn_fence(__ATOMIC_ACQUIRE, "agent");
            asm volatile("s_waitcnt vmcnt(0)" ::: "memory");
        }
    }
    __syncthreads();
}

constexpr int NWAVES = 8, NTHR = 512;
constexpr int RING_OFF = 0, RING_BYTES = 131072, LDS_BYTES = 163840, LDSCTL_OFF = LDS_BYTES - 256;
struct Params { const float* in[18]; float* out; char* ws; int ph_lo, ph_hi, li, pad; };

__device__ __forceinline__ void tr_tiles(const float* __restrict__ src, const int ld_src, bf16_t* __restrict__ dst, const int mode, const int ntn, LAS unsigned char* lds, const int nkt = 32, const int dstld = DM) {
    const int tid = threadIdx.x, G = gridDim.x, sub = tid >> 8, t = tid & 255, tx = t & 31, ty = t >> 5;
    LAS float* tile = (LAS float*)lds + sub * (4 * 32 * 33);
    const int NTILES = ntn * nkt;
    for (int base = blockIdx.x * 8; base < NTILES; base += G * 8) {
        float v[4][4];
#pragma unroll
        for (int q = 0; q < 4; ++q) {
            const int id = base + sub * 4 + q, tn = id / nkt, tk = id - tn * nkt, n0 = tn * 32, k0 = tk * 32;
#pragma unroll
            for (int i = 0; i < 4; ++i) { const int k = k0 + ty + i * 8, n = n0 + tx; const int col = mode ? wt_col(n) : n; v[q][i] = (id < NTILES && col >= 0) ? src[(size_t)k * ld_src + col] : 0.f; }
        }
#pragma unroll
        for (int q = 0; q < 4; ++q)
#pragma unroll
            for (int i = 0; i < 4; ++i) tile[q * (32 * 33) + (ty + i * 8) * 33 + tx] = v[q][i];
        __syncthreads();
#pragma unroll
        for (int q = 0; q < 4; ++q) {
            const int id = base + sub * 4 + q, tn = id / nkt, tk = id - tn * nkt, n0 = tn * 32, k0 = tk * 32;
            if (id < NTILES) {
#pragma unroll
                for (int i = 0; i < 4; ++i) { const int n = n0 + ty + i * 8, k = k0 + tx; dst[(size_t)n * dstld + k] = f2bf(tile[q * (32 * 33) + tx * 33 + ty + i * 8]); }
            }
        }
        __syncthreads();
    }
}
__device__ __forceinline__ void p0_prologue(const Params& p, const Bufs& B, LAS unsigned char* lds) {
    const int tid = threadIdx.x, G = gridDim.x;
    tr_tiles(p.in[5], 9048, B.WT, 1, NWT / 32, lds);
    tr_tiles(p.in[10], 1024, B.WOG_T, 0, 32, lds);
    tr_tiles(p.in[14], 1024, B.WOD_T, 0, 32, lds);
    tr_tiles(p.in[15], 1024, B.WOUT_T, 0, 32, lds);
    tr_tiles(p.in[13], 1024, (bf16_t*)((char*)p.out + OO_WUV_T), 0, 32, lds, 8, 256);
    { bf16_t* wk = (bf16_t*)((char*)p.out + OO_WUK_B); const float* src = p.in[12]; for (int i = blockIdx.x * NTHR + threadIdx.x; i < 256 * 1024; i += G * NTHR) wk[i] = f2bf(src[i]); }
    {
        LAS float* sc = (LAS float*)(lds + 36864);
        LAS float* part = (LAS float*)(lds + 36864 + 32768);
        const float* c = p.in[1]; const float* w_ada = p.in[3]; const float* b_ada = p.in[4];
        for (int jb = blockIdx.x; jb < 192; jb += G) {
            for (int i = tid; i < 8192; i += NTHR) sc[i] = silu_f(c[i]);
            __syncthreads();
            const int jj = tid & 15, sl = tid >> 4, j = jb * 16 + jj;
            float acc[8];
#pragma unroll
            for (int b = 0; b < 8; ++b) acc[b] = 0.f;
            for (int ii = 0; ii < 32; ++ii) { const int i = sl * 32 + ii; const float w = w_ada[(size_t)i * 3072 + j];
#pragma unroll
                for (int b = 0; b < 8; ++b) acc[b] += sc[b * 1024 + i] * w; }
#pragma unroll
            for (int b = 0; b < 8; ++b) part[(sl * 8 + b) * 16 + jj] = acc[b];
            __syncthreads();
            if (tid < 128) { const int b = tid >> 4, j2 = tid & 15; float s = 0.f;
                for (int s2 = 0; s2 < 32; ++s2) s += part[(s2 * 8 + b) * 16 + j2];
                B.MOD[b * 3072 + jb * 16 + j2] = s + b_ada[jb * 16 + j2]; }
            __syncthreads();
        }
    }
}
__device__ __forceinline__ void p1_h(const Params& p, const Bufs& B) {
    const int tid = threadIdx.x, lane = tid & 63, wave = tid >> 6, G = gridDim.x;
    const float* x = p.in[0]; const float* ng = p.in[2];
    for (int row0 = (blockIdx.x * NWAVES + wave) * 4; row0 < MROWS; row0 += G * NWAVES * 4) {
        const int b = row0 >> 11; f32x4 v[4][4]; float ss[4];
#pragma unroll
        for (int rr = 0; rr < 4; ++rr) { ss[rr] = 0.f;
#pragma unroll
            for (int i = 0; i < 4; ++i) v[rr][i] = *(const f32x4*)(x + (size_t)(row0 + rr) * DM + 4 * lane + 256 * i); }
#pragma unroll
        for (int rr = 0; rr < 4; ++rr)
#pragma unroll
            for (int i = 0; i < 4; ++i) ss[rr] += v[rr][i][0] * v[rr][i][0] + v[rr][i][1] * v[rr][i][1] + v[rr][i][2] * v[rr][i][2] + v[rr][i][3] * v[rr][i][3];
#pragma unroll
        for (int o = 32; o > 0; o >>= 1) { float t4[4];
#pragma unroll
            for (int rr = 0; rr < 4; ++rr) t4[rr] = __shfl_xor(ss[rr], o);
#pragma unroll
            for (int rr = 0; rr < 4; ++rr) ss[rr] += t4[rr]; }
#pragma unroll
        for (int i = 0; i < 4; ++i) { const int col = 4 * lane + 256 * i;
            const f32x4 g = *(const f32x4*)(ng + col), sc = *(const f32x4*)(B.MOD + b * 3072 + 1024 + col), sh = *(const f32x4*)(B.MOD + b * 3072 + col);
#pragma unroll
            for (int rr = 0; rr < 4; ++rr) { const float r = rsqrtf(ss[rr] * (1.f / DM) + 1e-6f);
                const f32x4 y = (v[rr][i] * r * g) * (sc + 1.0f) + sh;
                u32x2 w; w.x = cvt_pk_bf16(y[0], y[1]); w.y = cvt_pk_bf16(y[2], y[3]);
                *(u32x2*)(B.H + (size_t)(row0 + rr) * DM + col) = w; } }
    }
}
__device__ __forceinline__ void p8_final(const Params& p, const Bufs& B) {
    const int tid = threadIdx.x, lane = tid & 63, wave = tid >> 6, G = gridDim.x;
    const float* fg = p.in[17];
    for (int row0 = (blockIdx.x * NWAVES + wave) * 4; row0 < MROWS; row0 += G * NWAVES * 4) {
        f32x4 v[4][4]; float ss[4];
#pragma unroll
        for (int rr = 0; rr < 4; ++rr) { ss[rr] = 0.f;
#pragma unroll
            for (int i = 0; i < 4; ++i) v[rr][i] = *(const f32x4*)(B.XNEW + (size_t)(row0 + rr) * DM + 4 * lane + 256 * i); }
#pragma unroll
        for (int rr = 0; rr < 4; ++rr)
#pragma unroll
            for (int i = 0; i < 4; ++i) ss[rr] += v[rr][i][0] * v[rr][i][0] + v[rr][i][1] * v[rr][i][1] + v[rr][i][2] * v[rr][i][2] + v[rr][i][3] * v[rr][i][3];
#pragma unroll
        for (int o = 32; o > 0; o >>= 1) { float t4[4];
#pragma unroll
            for (int rr = 0; rr < 4; ++rr) t4[rr] = __shfl_xor(ss[rr], o);
#pragma unroll
            for (int rr = 0; rr < 4; ++rr) ss[rr] += t4[rr]; }
#pragma unroll
        for (int i = 0; i < 4; ++i) { const int col = 4 * lane + 256 * i; const f32x4 g = *(const f32x4*)(fg + col);
#pragma unroll
            for (int rr = 0; rr < 4; ++rr) { const float r = rsqrtf(ss[rr] * (1.f / DM) + 1e-6f); *(f32x4*)(p.out + (size_t)(row0 + rr) * DM + col) = v[rr][i] * r * g; } }
    }
}


typedef float f32x16 __attribute__((ext_vector_type(16)));
#define MFMA32(a, b, c) __builtin_amdgcn_mfma_f32_32x32x16_bf16((a), (b), (c), 0, 0, 0)
__device__ __forceinline__ int crow(int reg, int h) { return (reg & 3) + 8 * (reg >> 2) + 4 * h; }
constexpr int G1_ROWB = 272, G1_IMG = 64 * G1_ROWB, G1_WAVE = G1_IMG + 2048;

template <int MODE>
__device__ __forceinline__ void g1_conv(const bf16_t* __restrict__ X, const bf16_t* __restrict__ stash  , const float* __restrict__ cw  ,
                                        LAS unsigned char* img, int b, int n, int h, int lane, int dry = 0) {
    const int col = h * 128 + 2 * lane; const unsigned row0 = (unsigned)(b * NT + n * 64);
    const __amdgpu_buffer_rsrc_t rs = __builtin_amdgcn_make_buffer_rsrc((void*)X, 0, MROWS * 1024 * 2, 0x00020000);
    const unsigned voff = (unsigned)col * 2u;
    float w[4][2];
#pragma unroll
    for (int j = 0; j < 4; ++j) { w[j][0] = cw[j * 3072 + col]; w[j][1] = cw[j * 3072 + col + 1]; }
    float h0[2] = {0.f, 0.f}, h1[2] = {0.f, 0.f}, h2[2] = {0.f, 0.f};
    if (n > 0) {
        const bf16_t* sp = stash + ((size_t)(b * 32 + n - 1) * 3) * 1024 + col;
        const unsigned a0 = *(const unsigned*)(sp), a1 = *(const unsigned*)(sp + 1024), a2 = *(const unsigned*)(sp + 2048);
        h0[0] = bflo(a0); h0[1] = bfhi(a0); h1[0] = bflo(a1); h1[1] = bfhi(a1); h2[0] = bflo(a2); h2[1] = bfhi(a2);
    }
    unsigned rawn[16];
#pragma unroll
    for (int t = 0; t < 16; ++t) rawn[t] = __builtin_amdgcn_raw_buffer_load_b32(rs, voff, (row0 + t) * 2048u, 0);
#pragma unroll 1
    for (int q4 = 0; q4 < 4; ++q4) {
        unsigned raw[16];
#pragma unroll
        for (int t = 0; t < 16; ++t) raw[t] = rawn[t];
        const unsigned rb = (row0 + q4 * 16) * 2048u;
        if (q4 < 3) {
#pragma unroll
            for (int t = 0; t < 16; ++t) rawn[t] = __builtin_amdgcn_raw_buffer_load_b32(rs, voff, rb + (16 + t) * 2048u, 0);
        }
#pragma unroll
        for (int t = 0; t < 16; ++t) {
            const float x0 = bflo(raw[t]), x1 = bfhi(raw[t]);
            const float y0 = silu_f(w[0][0] * h0[0] + w[1][0] * h1[0] + w[2][0] * h2[0] + w[3][0] * x0);
            const float y1 = silu_f(w[0][1] * h0[1] + w[1][1] * h1[1] + w[2][1] * h2[1] + w[3][1] * x1);
            h0[0] = h1[0]; h1[0] = h2[0]; h2[0] = x0; h0[1] = h1[1]; h1[1] = h2[1]; h2[1] = x1;
            const unsigned pk = cvt_pk_bf16(y0, y1);
            if (MODE == 0) *(LAS unsigned*)(img + (q4 * 16 + t) * G1_ROWB + 4 * lane) = pk;
            else if (!dry) __builtin_amdgcn_raw_buffer_store_b32(pk, rs, voff, rb + t * 2048u, 0);
        }
    }
}
__device__ __forceinline__ float g1_diag(const f32x16& g, int r, int hh) {
    float d = 0.f;
#pragma unroll
    for (int reg = 0; reg < 16; ++reg) d = (crow(reg, hh) == r) ? g[reg] : d;
    return d + __shfl_xor(d, 32);
}
__device__ __forceinline__ void g1_store_norm(bf16_t* __restrict__ Xout, const LAS unsigned char* img, const LAS float* scl, float mul, int b, int n, int h, int lane, int dry) {
    const size_t row0 = (size_t)b * NT + n * 64;
#pragma unroll 4
    for (int ps = 0; ps < 16; ++ps) {
        const int row = ps * 4 + (lane >> 4), c16 = lane & 15;
        const u32x4 v = *(const LAS u32x4*)(img + row * G1_ROWB + 16 * c16);
        const float s = scl[row] * mul;
        u32x4 o; o.x = cvt_pk_bf16(bflo(v.x) * s, bfhi(v.x) * s); o.y = cvt_pk_bf16(bflo(v.y) * s, bfhi(v.y) * s); o.z = cvt_pk_bf16(bflo(v.z) * s, bfhi(v.z) * s); o.w = cvt_pk_bf16(bflo(v.w) * s, bfhi(v.w) * s);
        if (!dry) *(u32x4*)(Xout + (row0 + row) * 1024 + h * 128 + 8 * c16) = o;
    }
}
__device__ __forceinline__ void g1_phase(const Params& p, LAS unsigned char* lds) {
    const int tid = threadIdx.x, lane0 = tid & 63, h = tid >> 6, G = gridDim.x;
    char* ws = p.ws; char* os = (char*)p.out;
    bf16_t* QA = (bf16_t*)(ws + OFF_QA); bf16_t* KA = (bf16_t*)(ws + OFF_KA); bf16_t* VA = (bf16_t*)(ws + OFF_VA);
    const float* SMALL = (const float*)(ws + OFF_SMALL);
    const bf16_t* STASH = (const bf16_t*)(os + OO_STASH);
    const float* conv_w = p.in[6];
    LAS unsigned char* img = lds + h * G1_WAVE;
    LAS float* sm = (LAS float*)(img + G1_IMG);
    const float Aexp = __expf(p.in[7][h]), dtb = p.in[8][h];
    for (int unit = blockIdx.x; unit < NB * 32; unit += G) {
        int lane = lane0; asm volatile("" : "+v"(lane));
        const int r = lane & 31, hh = lane >> 5;
        const int b = unit >> 5, n = unit & 31; const size_t row0 = (size_t)b * NT + n * 64;
        const int u = (b * 8 + h) * 32 + n;
        float gi, beta, d;
        {
            const float xg = SMALL[(row0 + lane) * 32 + h] + dtb;
            const float sp = xg > 20.f ? xg : log1pf(__expf(xg));
            gi = -Aexp * sp; beta = sigmoid_f(SMALL[(row0 + lane) * 32 + 8 + h]);
            d = gi;
#pragma unroll
            for (int o = 1; o < 64; o <<= 1) { const float v = __shfl_up(d, o); if (lane >= o) d += v; }
            const float dl = __shfl(d, 63);
            float* dec = (float*)(os + OO_DEC) + (size_t)u * 256;
            dec[lane] = __expf(d); dec[64 + lane] = __expf(dl - d); dec[128 + lane] = gi; dec[192 + lane] = beta;
            sm[128 + lane] = d; sm[192 + lane] = beta;
        }
        g1_conv<0>(KA, STASH + (size_t)1 * 256 * 3 * 1024, conv_w + 1024, img, b, n, h, lane);
        __syncthreads();
        f32x16 g00, g10, g11;
#pragma unroll
        for (int i = 0; i < 16; ++i) { g00[i] = 0.f; g10[i] = 0.f; g11[i] = 0.f; }
#pragma unroll 2
        for (int s = 0; s < 8; ++s) {
            const bf16x8 k0 = *(const LAS bf16x8*)(img + (r) * G1_ROWB + (16 * s + 8 * hh) * 2), k1 = *(const LAS bf16x8*)(img + (32 + r) * G1_ROWB + (16 * s + 8 * hh) * 2);
            g00 = MFMA32(k0, k0, g00); g10 = MFMA32(k1, k0, g10); g11 = MFMA32(k1, k1, g11);
        }
        {
            const float nlo = rsqrtf(g1_diag(g00, r, hh) + 1e-6f), nhi = rsqrtf(g1_diag(g11, r, hh) + 1e-6f);
            if (hh == 0) { sm[r] = nlo; sm[32 + r] = nhi; }
        }
        __syncthreads();
        g1_store_norm(KA, img, sm, 1.0f, b, n, h, lane, p.pad);
        asm volatile("s_waitcnt vmcnt(0)" ::: "memory");
        __syncthreads();
        g1_conv<0>(QA, STASH, conv_w, img, b, n, h, lane);
        __syncthreads();
        {
            f32x16 qq0, qq1;
#pragma unroll
            for (int i = 0; i < 16; ++i) { qq0[i] = 0.f; qq1[i] = 0.f; }
#pragma unroll 2
            for (int s = 0; s < 8; ++s) {
                const bf16x8 qa = *(const LAS bf16x8*)(img + (r) * G1_ROWB + (16 * s + 8 * hh) * 2), qb = *(const LAS bf16x8*)(img + (32 + r) * G1_ROWB + (16 * s + 8 * hh) * 2);
                qq0 = MFMA32(qa, qa, qq0); qq1 = MFMA32(qb, qb, qq1);
            }
            const float nlo = rsqrtf(g1_diag(qq0, r, hh) + 1e-6f), nhi = rsqrtf(g1_diag(qq1, r, hh) + 1e-6f);
            if (hh == 0) { sm[64 + r] = nlo; sm[96 + r] = nhi; }
        }
        f32x16 q00, q10, q11;
#pragma unroll
        for (int i = 0; i < 16; ++i) { q00[i] = 0.f; q10[i] = 0.f; q11[i] = 0.f; }
#pragma unroll 1
        for (int s4 = 0; s4 < 2; ++s4) {
            bf16x8 kf0[4], kf1[4];
#pragma unroll
            for (int s = 0; s < 4; ++s) {
                kf0[s] = *(const bf16x8*)(KA + (row0 + r) * 1024 + h * 128 + 16 * (4 * s4 + s) + 8 * hh);
                kf1[s] = *(const bf16x8*)(KA + (row0 + 32 + r) * 1024 + h * 128 + 16 * (4 * s4 + s) + 8 * hh);
            }
#pragma unroll
            for (int s = 0; s < 4; ++s) {
                const bf16x8 qa = *(const LAS bf16x8*)(img + (r) * G1_ROWB + (16 * (4 * s4 + s) + 8 * hh) * 2), qb = *(const LAS bf16x8*)(img + (32 + r) * G1_ROWB + (16 * (4 * s4 + s) + 8 * hh) * 2);
                q00 = MFMA32(qa, kf0[s], q00); q10 = MFMA32(qb, kf0[s], q10); q11 = MFMA32(qb, kf1[s], q11);
            }
        }
        __syncthreads();
        g1_store_norm(QA, img, sm + 64, 0.08838834764831845f, b, n, h, lane, p.pad);
        __syncthreads();
        g1_conv<1>(VA, STASH + (size_t)2 * 256 * 3 * 1024, conv_w + 2048, img, b, n, h, lane, p.pad);
        bf16_t* tp = (bf16_t*)(os + OO_TPATT + (size_t)u * 12288);
        LAS float* Am = (LAS float*)img;
#pragma unroll
        for (int blk = 0; blk < 3; ++blk) {
            __builtin_amdgcn_sched_barrier(0);
            const int bi = (blk == 0) ? 0 : 1, bj = (blk == 2) ? 1 : 0;
            const f32x16& gk = (blk == 0) ? g00 : (blk == 1) ? g10 : g11;
            const f32x16& gq = (blk == 0) ? q00 : (blk == 1) ? q10 : q11;
            const int j = 32 * bj + r; const float nkj = sm[j], dj = sm[128 + j];
#pragma unroll
            for (int g4 = 0; g4 < 4; ++g4) {
                const int ib = 32 * bi + 8 * g4 + 4 * hh;
                const f32x4 nki = *(const LAS f32x4*)(sm + ib), nqi = *(const LAS f32x4*)(sm + 64 + ib), di = *(const LAS f32x4*)(sm + 128 + ib), bti = *(const LAS f32x4*)(sm + 192 + ib);
#pragma unroll
                for (int e = 0; e < 4; ++e) {
                    const int i = ib + e, reg = 4 * g4 + e;
                    const float gam = __expf(di[e] - dj);
                    const float av = (i > j) ? gk[reg] * nki[e] * nkj * bti[e] * gam : 0.f;
                    const float tv = (i >= j) ? gq[reg] * (nqi[e] * 0.08838834764831845f) * gam : 0.f;
                    Am[i * 64 + j] = av;
                    if (blk == 0) Am[i * 64 + 32 + j] = 0.f;
                    tp[(3 + blk) * 1024 + (i & 31) * 32 + r] = f2bf(tv);
                }
            }
        }
        __syncthreads();
#pragma unroll 1
        for (int i0 = 0; i0 < 64; i0 += 4) {
            float t0 = (lane == i0) ? 1.f : 0.f, t1 = (lane == i0 + 1) ? 1.f : 0.f, t2 = (lane == i0 + 2) ? 1.f : 0.f, t3 = (lane == i0 + 3) ? 1.f : 0.f;
#pragma unroll 2
            for (int j4 = 0; j4 < i0; j4 += 4) {
                const f32x4 a0 = *(const LAS f32x4*)(Am + (i0 + 0) * 64 + j4), a1 = *(const LAS f32x4*)(Am + (i0 + 1) * 64 + j4), a2 = *(const LAS f32x4*)(Am + (i0 + 2) * 64 + j4), a3 = *(const LAS f32x4*)(Am + (i0 + 3) * 64 + j4);
#pragma unroll
                for (int e = 0; e < 4; ++e) { const float tj = Am[(j4 + e) * 64 + lane]; t0 -= a0[e] * tj; t1 -= a1[e] * tj; t2 -= a2[e] * tj; t3 -= a3[e] * tj; }
            }
            const f32x4 d1 = *(const LAS f32x4*)(Am + (i0 + 1) * 64 + i0), d2 = *(const LAS f32x4*)(Am + (i0 + 2) * 64 + i0), d3 = *(const LAS f32x4*)(Am + (i0 + 3) * 64 + i0);
            t1 -= d1[0] * t0;
            t2 -= d2[0] * t0 + d2[1] * t1;
            t3 -= d3[0] * t0 + d3[1] * t1 + d3[2] * t2;
            Am[(i0 + 0) * 64 + lane] = t0; Am[(i0 + 1) * 64 + lane] = t1; Am[(i0 + 2) * 64 + lane] = t2; Am[(i0 + 3) * 64 + lane] = t3;
        }
        for (int i = 0; i < 64; ++i) {
            const bf16_t v = f2bf(Am[i * 64 + lane] * beta);
            if (i < 32) { if (lane < 32) tp[0 * 1024 + i * 32 + lane] = v; }
            else { tp[(lane < 32 ? 1 : 2) * 1024 + (i - 32) * 32 + (lane & 31)] = v; }
        }
        __syncthreads();
    }
}


typedef short s16x4 __attribute__((ext_vector_type(4)));
typedef __bf16 bf16x8_t __attribute__((ext_vector_type(8)));
typedef float f32x8 __attribute__((ext_vector_type(8)));
constexpr int G2_RB = 264, G2_IMG = 64 * G2_RB, G2_BRB = 72, G2_BLK = 32 * G2_BRB;
constexpr int G2_K = 0, G2_Q = G2_IMG, G2_V = 2 * G2_IMG, G2_TP = 3 * G2_IMG, G2_AT = G2_TP + 3 * G2_BLK, G2_DE = G2_AT + 3 * G2_BLK, G2_CB = G2_DE + 512;
constexpr int G2_OB = 2 * G2_CB, G2_OBSZ = 64 * 256;
static_assert(G2_CB % 16 == 0 && G2_OB + 2 * G2_OBSZ <= LDSCTL_OFF, "GDN scan LDS map");
__device__ __forceinline__ bf16x8 pack_step(const f32x16& x, const int s) {
    f32x8 v;
#pragma unroll
    for (int j = 0; j < 8; ++j) v[j] = x[8 * s + j];
    return __builtin_bit_cast(bf16x8, __builtin_convertvector(v, bf16x8_t));
}
__device__ __forceinline__ bf16x8 perm_frag(const LAS unsigned char* img, const int rowb, const int row, const int kc, const int hh) {
    const s16x4 lo = *(const LAS s16x4*)(img + row * rowb + (kc + 4 * hh) * 2), hi = *(const LAS s16x4*)(img + row * rowb + (kc + 8 + 4 * hh) * 2);
    return __builtin_shufflevector(lo, hi, 0, 1, 2, 3, 4, 5, 6, 7);
}
__device__ __forceinline__ s16x4 tr4(const LAS unsigned char* img, const int rowb, const int row0, const int c0, const int lane) {
    const int q = (lane & 15) >> 2, pq = lane & 3, blk = (lane >> 4) & 1;
    return __builtin_amdgcn_ds_read_tr16_b64_v4i16((LAS s16x4*)(img + (row0 + q) * rowb + (c0 + 16 * blk + 4 * pq) * 2));
}
#define G2_LV_SET(S_, k_, val_) do { const u32x4 _v = (val_); S_[(k_) >> 2][4 * ((k_) & 3) + 0] = __uint_as_float(_v.x); S_[(k_) >> 2][4 * ((k_) & 3) + 1] = __uint_as_float(_v.y); S_[(k_) >> 2][4 * ((k_) & 3) + 2] = __uint_as_float(_v.z); S_[(k_) >> 2][4 * ((k_) & 3) + 3] = __uint_as_float(_v.w); } while (0)
#define G2_LV_GET(S_, k_) ((u32x4){__float_as_uint(S_[(k_) >> 2][4 * ((k_) & 3) + 0]), __float_as_uint(S_[(k_) >> 2][4 * ((k_) & 3) + 1]), __float_as_uint(S_[(k_) >> 2][4 * ((k_) & 3) + 2]), __float_as_uint(S_[(k_) >> 2][4 * ((k_) & 3) + 3])})
__device__ __forceinline__ void g2_issue_chunk(const Params& p, f32x16 (&v)[4], const int b, const int h, const int n, const int lt) {
    char* ws = p.ws; const char* os = (const char*)p.out;
    const unsigned row0 = (unsigned)(b * NT + n * 64); const int u = (b * 8 + h) * 32 + n;
    const unsigned voff = (unsigned)((lt >> 4) * 2048 + h * 256 + (lt & 15) * 16);
#pragma unroll
    for (int t3 = 0; t3 < 3; ++t3) {
        const __amdgpu_buffer_rsrc_t rs = __builtin_amdgcn_make_buffer_rsrc((void*)(ws + OFF_QA + (size_t)(t3 == 0 ? 1 : t3 == 1 ? 0 : 2) * (32 * MiB)), 0, 32 * 1024 * 1024, 0x00020000);
#pragma unroll
        for (int k = 0; k < 4; ++k) G2_LV_SET(v, t3 * 4 + k, __builtin_amdgcn_raw_buffer_load_b128(rs, voff, (row0 + 16 * k) * 2048u, 0));
    }
    const __amdgpu_buffer_rsrc_t rt = __builtin_amdgcn_make_buffer_rsrc((void*)(os + OO_TPATT), 0, 24 * 1024 * 1024, 0x00020000);
#pragma unroll
    for (int k = 0; k < 3; ++k) G2_LV_SET(v, 12 + k, __builtin_amdgcn_raw_buffer_load_b128(rt, (unsigned)lt * 16u, (unsigned)u * 12288u + 4096u * k, 0));
    const __amdgpu_buffer_rsrc_t rd = __builtin_amdgcn_make_buffer_rsrc((void*)(os + OO_DEC), 0, 2 * 1024 * 1024, 0x00020000);
    G2_LV_SET(v, 15, __builtin_amdgcn_raw_buffer_load_b128(rd, (unsigned)(lt & 31) * 16u, (unsigned)u * 1024u, 0));
}
__device__ __forceinline__ void g2_commit_chunk(LAS unsigned char* cb, const f32x16 (&v)[4], const int lt) {
#pragma unroll
    for (int t3 = 0; t3 < 3; ++t3)
#pragma unroll
        for (int k = 0; k < 4; ++k) { const int pi = lt + 256 * k, row = pi >> 4, c16 = pi & 15; LAS u32x2* d = (LAS u32x2*)(cb + t3 * G2_IMG + row * G2_RB + 16 * c16);
            const u32x4 vv = G2_LV_GET(v, t3 * 4 + k); d[0] = (u32x2){vv.x, vv.y}; d[1] = (u32x2){vv.z, vv.w}; }
#pragma unroll
    for (int k = 0; k < 3; ++k) { const int pi = lt + 256 * k, blk = pi >> 7, row = (pi & 127) >> 2, c16 = pi & 3; LAS u32x2* d = (LAS u32x2*)(cb + G2_TP + blk * G2_BLK + row * G2_BRB + 16 * c16);
        const u32x4 vv = G2_LV_GET(v, 12 + k); d[0] = (u32x2){vv.x, vv.y}; d[1] = (u32x2){vv.z, vv.w}; }
    if (lt < 32) *(LAS u32x4*)(cb + G2_DE + 16 * lt) = G2_LV_GET(v, 15);
}
__device__ __forceinline__ void g2_issue_za(const Params& p, unsigned (&z)[16], const int b, const int h, const int n, const int lw, const int lane) {
    const __amdgpu_buffer_rsrc_t rz = __builtin_amdgcn_make_buffer_rsrc((void*)(p.ws + OFF_ZA), 0, 32 * 1024 * 1024, 0x00020000);
    const unsigned row0 = (unsigned)(b * NT + n * 64 + lw * 16), voff = (unsigned)(h * 256 + 4 * lane);
#pragma unroll
    for (int rr = 0; rr < 16; ++rr) z[rr] = __builtin_amdgcn_raw_buffer_load_b32(rz, voff, (row0 + rr) * 2048u, 0);
}
__device__ __forceinline__ void g2_epilogue(const Params& p, const LAS unsigned char* ob, const unsigned (&z)[16], const int b, const int h, const int n, const int lw  , const int lane) {
    const float* gg = p.in[9];
    const float g0 = gg[2 * lane], g1 = gg[2 * lane + 1];
    const __amdgpu_buffer_rsrc_t rz = __builtin_amdgcn_make_buffer_rsrc((void*)(p.ws + OFF_ZA), 0, 32 * 1024 * 1024, 0x00020000);
    const unsigned row0 = (unsigned)(b * NT + n * 64 + lw * 16), voff = (unsigned)(h * 256 + 4 * lane);
    unsigned w[16]; float ss[16];
#pragma unroll
    for (int rr = 0; rr < 16; ++rr) { w[rr] = *(const LAS unsigned*)(ob + (lw * 16 + rr) * 256 + 4 * lane); const float o0 = bflo(w[rr]), o1 = bfhi(w[rr]); ss[rr] = o0 * o0 + o1 * o1; }
#pragma unroll
    for (int o = 32; o > 0; o >>= 1) {
        float tmp[16];
#pragma unroll
        for (int rr = 0; rr < 16; ++rr) tmp[rr] = __shfl_xor(ss[rr], o);
#pragma unroll
        for (int rr = 0; rr < 16; ++rr) ss[rr] += tmp[rr];
    }
    if (!p.pad) {
#pragma unroll
        for (int rr = 0; rr < 16; ++rr) {
            const float rs = rsqrtf(ss[rr] * (1.f / 128.f) + 1e-6f);
            __builtin_amdgcn_raw_buffer_store_b32(cvt_pk_bf16(bflo(w[rr]) * rs * g0 * silu_f(bflo(z[rr])), bfhi(w[rr]) * rs * g1 * silu_f(bfhi(z[rr]))), rz, voff, (row0 + rr) * 2048u, 0);
        }
    }
}
__device__ __forceinline__ void g2_phase(const Params& p, LAS unsigned char* lds) {
    const int tid = threadIdx.x, wave = __builtin_amdgcn_readfirstlane(tid >> 6), G = gridDim.x;
    for (int bh = blockIdx.x; bh < NB * 8; bh += G) {
        int lane = tid & 63; asm volatile("" : "+v"(lane));
        const int r = lane & 31, hh = lane >> 5, b = bh >> 3, h = bh & 7;
        f32x16 S[4];
#pragma unroll
        for (int i = 0; i < 4; ++i)
#pragma unroll
            for (int e = 0; e < 16; ++e) S[i][e] = 0.f;
        unsigned zc[16];
        if (wave >= 4) { g2_issue_chunk(p, S, b, h, 0, tid - 256); g2_commit_chunk(lds, S, tid - 256); g2_issue_chunk(p, S, b, h, 1, tid - 256); g2_issue_za(p, zc, b, h, 0, wave - 4, lane); }
        __syncthreads();
#pragma unroll 1
        for (int n = 0; n < 32; ++n) {
            LAS unsigned char* cb = lds + (n & 1) * G2_CB;
            if (wave < 4) {
                const int j = wave;
                const LAS unsigned char* KI = cb + G2_K; const LAS unsigned char* QI = cb + G2_Q; const LAS unsigned char* VI = cb + G2_V;
                const LAS float* ED = (const LAS float*)(cb + G2_DE); const LAS float* EDL = ED + 64;
                f32x16 ks[2], qs[2];
#pragma unroll
                for (int tb = 0; tb < 2; ++tb)
#pragma unroll
                    for (int e = 0; e < 16; ++e) { ks[tb][e] = 0.f; qs[tb][e] = 0.f; }
                bf16x8 fa[2][4];
#define G2_LD1(buf, g) do { fa[buf][0] = perm_frag(KI, G2_RB, r, 16 * (g), hh); fa[buf][1] = perm_frag(KI, G2_RB, 32 + r, 16 * (g), hh); \
                            fa[buf][2] = perm_frag(QI, G2_RB, r, 16 * (g), hh); fa[buf][3] = perm_frag(QI, G2_RB, 32 + r, 16 * (g), hh); } while (0)
                G2_LD1(0, 0);
#pragma unroll
                for (int g = 0; g < 8; ++g) {
                    if (g + 1 < 8) G2_LD1((g + 1) & 1, g + 1);
                    __builtin_amdgcn_sched_barrier(0);
                    const bf16x8 xs = pack_step(S[g >> 1], g & 1);
                    ks[0] = MFMA32(fa[g & 1][0], xs, ks[0]); ks[1] = MFMA32(fa[g & 1][1], xs, ks[1]);
                    qs[0] = MFMA32(fa[g & 1][2], xs, qs[0]); qs[1] = MFMA32(fa[g & 1][3], xs, qs[1]);
                    __builtin_amdgcn_sched_barrier(0);
                }
#undef G2_LD1
                f32x16 R[2], O[2];
#pragma unroll
                for (int tb = 0; tb < 2; ++tb)
#pragma unroll
                    for (int g4 = 0; g4 < 4; ++g4) {
                        const int t0 = 32 * tb + 8 * g4 + 4 * hh;
                        const s16x4 vv = tr4(VI, G2_RB, t0, 32 * j, lane);
                        const f32x4 ed = *(const LAS f32x4*)(ED + t0);
#pragma unroll
                        for (int e = 0; e < 4; ++e) { R[tb][4 * g4 + e] = bf2f((bf16_t)vv[e]) - ed[e] * ks[tb][4 * g4 + e]; O[tb][4 * g4 + e] = ed[e] * qs[tb][4 * g4 + e]; }
                    }
                f32x16 vn[2];
#pragma unroll
                for (int e = 0; e < 16; ++e) { vn[0][e] = 0.f; vn[1][e] = 0.f; }
                {
                    bf16x8 ft[3][2];
#pragma unroll
                    for (int bk = 0; bk < 3; ++bk)
#pragma unroll
                        for (int s = 0; s < 2; ++s) ft[bk][s] = perm_frag(cb + G2_TP + bk * G2_BLK, G2_BRB, r, 16 * s, hh);
                    __builtin_amdgcn_sched_barrier(0);
#pragma unroll
                    for (int s = 0; s < 2; ++s) {
                        const bf16x8 x0 = pack_step(R[0], s), x1 = pack_step(R[1], s);
                        vn[0] = MFMA32(ft[0][s], x0, vn[0]); vn[1] = MFMA32(ft[1][s], x0, vn[1]); vn[1] = MFMA32(ft[2][s], x1, vn[1]);
                    }
                }
                f32x16 vs[2];
#pragma unroll
                for (int tb = 0; tb < 2; ++tb)
#pragma unroll
                    for (int g4 = 0; g4 < 4; ++g4) {
                        const f32x4 el = *(const LAS f32x4*)(EDL + 32 * tb + 8 * g4 + 4 * hh);
#pragma unroll
                        for (int e = 0; e < 4; ++e) vs[tb][4 * g4 + e] = el[e] * vn[tb][4 * g4 + e];
                    }
                {
                    bf16x8 ft[3][2];
#pragma unroll
                    for (int bk = 0; bk < 3; ++bk)
#pragma unroll
                        for (int s = 0; s < 2; ++s) ft[bk][s] = perm_frag(cb + G2_AT + bk * G2_BLK, G2_BRB, r, 16 * s, hh);
                    __builtin_amdgcn_sched_barrier(0);
#pragma unroll
                    for (int s = 0; s < 2; ++s) {
                        const bf16x8 x0 = pack_step(vn[0], s), x1 = pack_step(vn[1], s);
                        O[0] = MFMA32(ft[0][s], x0, O[0]); O[1] = MFMA32(ft[1][s], x0, O[1]); O[1] = MFMA32(ft[2][s], x1, O[1]);
                    }
                }
                LAS unsigned char* ob = lds + G2_OB + (n & 1) * G2_OBSZ;
#pragma unroll
                for (int tb = 0; tb < 2; ++tb)
#pragma unroll
                    for (int e = 0; e < 16; ++e) *(LAS bf16_t*)(ob + (32 * tb + crow(e, hh)) * 256 + (32 * j + r) * 2) = f2bf(O[tb][e]);
                const float edl_all = ED[63];
                bf16x8 xv[2][2];
#pragma unroll
                for (int tb = 0; tb < 2; ++tb)
#pragma unroll
                    for (int s = 0; s < 2; ++s) xv[tb][s] = pack_step(vs[tb], s);
                s16x4 fk[1][8];
#define G2_LD5(buf, i) do { _Pragma("unroll") for (int tb = 0; tb < 2; ++tb) _Pragma("unroll") for (int s = 0; s < 2; ++s) { const int t0 = 32 * tb + 16 * s + 4 * hh; \
                            fk[buf][(tb * 2 + s) * 2] = tr4(KI, G2_RB, t0, 32 * (i), lane); fk[buf][(tb * 2 + s) * 2 + 1] = tr4(KI, G2_RB, t0 + 8, 32 * (i), lane); } } while (0)
#pragma unroll
                for (int i = 0; i < 4; ++i) {
                    G2_LD5(0, i);
                    __builtin_amdgcn_sched_barrier(0);
#pragma unroll
                    for (int e = 0; e < 16; ++e) S[i][e] *= edl_all;
#pragma unroll
                    for (int tb = 0; tb < 2; ++tb)
#pragma unroll
                        for (int s = 0; s < 2; ++s) {
                            const bf16x8 a = __builtin_shufflevector(fk[0][(tb * 2 + s) * 2], fk[0][(tb * 2 + s) * 2 + 1], 0, 1, 2, 3, 4, 5, 6, 7);
                            S[i] = MFMA32(a, xv[tb][s], S[i]);
                        }
                    __builtin_amdgcn_sched_barrier(0);
                }
#undef G2_LD5
            } else {
                const int lt = tid - 256;
                if (n > 0) g2_epilogue(p, lds + G2_OB + ((n - 1) & 1) * G2_OBSZ, zc, b, h, n - 1, wave - 4, lane);
                if (n + 1 < 32) g2_commit_chunk(lds + ((n + 1) & 1) * G2_CB, S, lt);
                if (n + 2 < 32) g2_issue_chunk(p, S, b, h, n + 2, lt);
                if (n > 0) g2_issue_za(p, zc, b, h, n, wave - 4, lane);
            }
            __syncthreads();
        }
        if (wave >= 4) g2_epilogue(p, lds + G2_OB + 1 * G2_OBSZ, zc, b, h, 31, wave - 4, lane);
        __syncthreads();
    }
}

__device__ const unsigned char T5_BUCKET[128] = {
    0, 1, 2, 3, 4, 5, 6, 7, 8, 9, 10, 11, 12, 13, 14, 15, 16, 16, 16, 17, 17, 18, 18, 18, 19, 19, 19, 20, 20, 20, 20, 21,
    21, 21, 21, 22, 22, 22, 22, 22, 23, 23, 23, 23, 23, 23, 24, 24, 24, 24, 24, 24, 25, 25, 25, 25, 25, 25, 25, 26, 26, 26, 26, 26,
    26, 26, 26, 27, 27, 27, 27, 27, 27, 27, 27, 27, 27, 28, 28, 28, 28, 28, 28, 28, 28, 28, 28, 29, 29, 29, 29, 29, 29, 29, 29, 29,
    29, 29, 29, 30, 30, 30, 30, 30, 30, 30, 30, 30, 30, 30, 30, 30, 30, 31, 31, 31, 31, 31, 31, 31, 31, 31, 31, 31, 31, 31, 31, 31};
__device__ __forceinline__ int t5_bucket(int n) { return n >= 128 ? 31 : (int)T5_BUCKET[n]; }

constexpr size_t OFF_QL = OFF_QA;
typedef unsigned short u16_t;
#define MFMA16(a, b, c) __builtin_amdgcn_mfma_f32_16x16x32_bf16((a), (b), (c), 0, 0, 0)

constexpr int D2_RB = 528, D2_KB = 32 * D2_RB, D2_BIAS = 8 * D2_KB;
static_assert(D2_BIAS + 129 * 8 * 4 <= LDSCTL_OFF, "DSA attention LDS map");
__device__ __forceinline__ size_t d2_tok(const int b, const int c8, const int r) { return (size_t)b * NT + (r >> 3) * 256 + c8 * 8 + (r & 7); }
__device__ __forceinline__ void d2_qlat(const Params& p, LAS unsigned char* stg, const int b, const int c8, const int h, int lane) {
    asm volatile("" : "+v"(lane));
    const int r = lane & 31, hh = lane >> 5;
    const bf16_t* QB = (const bf16_t*)(p.ws + OFF_QB); const bf16_t* WUK = (const bf16_t*)((const char*)p.out + OO_WUK_B); bf16_t* QL = (bf16_t*)(p.ws + OFF_QL);
    bf16x8 a[2][8];
#pragma unroll
    for (int mi = 0; mi < 2; ++mi)
#pragma unroll
        for (int s = 0; s < 8; ++s) a[mi][s] = *(const bf16x8*)(QB + d2_tok(b, c8, 32 * mi + r) * 1024 + h * 128 + 16 * s + 8 * hh);
    bf16x8 bn[8];
#pragma unroll
    for (int s = 0; s < 8; ++s) bn[s] = *(const bf16x8*)(WUK + (size_t)(r) * 1024 + h * 128 + 16 * s + 8 * hh);
#pragma unroll 1
    for (int nh = 0; nh < 2; ++nh) {
#pragma unroll 1
        for (int nt = 0; nt < 4; ++nt) {
            bf16x8 bb[8];
#pragma unroll
            for (int s = 0; s < 8; ++s) bb[s] = bn[s];
            const int nxt = 4 * nh + nt + 1;
            if (nxt < 8) {
#pragma unroll
                for (int s = 0; s < 8; ++s) bn[s] = *(const bf16x8*)(WUK + (size_t)(32 * nxt + r) * 1024 + h * 128 + 16 * s + 8 * hh);
            }
            f32x16 acc[2];
#pragma unroll
            for (int e = 0; e < 16; ++e) { acc[0][e] = 0.f; acc[1][e] = 0.f; }
#pragma unroll
            for (int s = 0; s < 8; ++s) { acc[0] = MFMA32(a[0][s], bb[s], acc[0]); acc[1] = MFMA32(a[1][s], bb[s], acc[1]); }
#pragma unroll
            for (int mi = 0; mi < 2; ++mi)
#pragma unroll
                for (int e = 0; e < 16; ++e) *(LAS bf16_t*)(stg + (32 * mi + crow(e, hh)) * 256 + (32 * nt + r) * 2) = f2bf(acc[mi][e] * 0.08838834764831845f);
        }
#pragma unroll 4
        for (int ps = 0; ps < 16; ++ps) { const int row = 4 * ps + (lane >> 4), c16 = lane & 15;
            *(u32x4*)(QL + d2_tok(b, c8, row) * 2048 + h * 256 + 128 * nh + 8 * c16) = *(const LAS u32x4*)(stg + row * 256 + 16 * c16); }
    }
}
__device__ __forceinline__ void d2_wuv(const Params& p, LAS unsigned char* stg, const int b, const int c8, const int h, int lane) {
    asm volatile("" : "+v"(lane));
    const int r = lane & 31, hh = lane >> 5;
    const bf16_t* OL = (const bf16_t*)(p.ws + OFF_QL); const bf16_t* WUV = (const bf16_t*)((const char*)p.out + OO_WUV_T); bf16_t* OB = (bf16_t*)(p.ws + OFF_QB); const bf16_t* ZB = (const bf16_t*)(p.ws + OFF_ZB);
    bf16x8 a[2][16];
#pragma unroll
    for (int mi = 0; mi < 2; ++mi)
#pragma unroll
        for (int s = 0; s < 16; ++s) a[mi][s] = *(const bf16x8*)(OL + d2_tok(b, c8, 32 * mi + r) * 2048 + h * 256 + 16 * s + 8 * hh);
    bf16x8 bn[8];
#pragma unroll
    for (int s = 0; s < 8; ++s) bn[s] = *(const bf16x8*)(WUV + (size_t)(h * 128 + r) * 256 + 16 * s + 8 * hh);
    f32x16 acc[2];
#pragma unroll 1
    for (int st = 0; st < 8; ++st) {
        const int nt = st >> 1, kh = st & 1;
        bf16x8 bb[8];
#pragma unroll
        for (int s = 0; s < 8; ++s) bb[s] = bn[s];
        if (st + 1 < 8) { const int nt1 = (st + 1) >> 1, kh1 = (st + 1) & 1;
#pragma unroll
            for (int s = 0; s < 8; ++s) bn[s] = *(const bf16x8*)(WUV + (size_t)(h * 128 + 32 * nt1 + r) * 256 + 16 * (8 * kh1 + s) + 8 * hh); }
        if (kh == 0) {
#pragma unroll
            for (int e = 0; e < 16; ++e) { acc[0][e] = 0.f; acc[1][e] = 0.f; }
#pragma unroll
            for (int s = 0; s < 8; ++s) { acc[0] = MFMA32(a[0][s], bb[s], acc[0]); acc[1] = MFMA32(a[1][s], bb[s], acc[1]); }
        } else {
#pragma unroll
            for (int s = 0; s < 8; ++s) { acc[0] = MFMA32(a[0][8 + s], bb[s], acc[0]); acc[1] = MFMA32(a[1][8 + s], bb[s], acc[1]); }
#pragma unroll
            for (int mi = 0; mi < 2; ++mi)
#pragma unroll
                for (int e = 0; e < 16; ++e) *(LAS bf16_t*)(stg + (32 * mi + crow(e, hh)) * 256 + (32 * nt + r) * 2) = f2bf(acc[mi][e]);
        }
    }
    if (!p.pad) {
#pragma unroll 4
    for (int ps = 0; ps < 16; ++ps) { const int row = 4 * ps + (lane >> 4), c16 = lane & 15;
        const u32x4 v = *(const LAS u32x4*)(stg + row * 256 + 16 * c16); const size_t o = d2_tok(b, c8, row) * 1024 + h * 128 + 8 * c16;
        const u32x4 z = *(const u32x4*)(ZB + o); u32x4 w;
        w.x = cvt_pk_bf16(bflo(v.x) * silu_f(bflo(z.x)), bfhi(v.x) * silu_f(bfhi(z.x))); w.y = cvt_pk_bf16(bflo(v.y) * silu_f(bflo(z.y)), bfhi(v.y) * silu_f(bfhi(z.y)));
        w.z = cvt_pk_bf16(bflo(v.z) * silu_f(bflo(z.z)), bfhi(v.z) * silu_f(bfhi(z.z))); w.w = cvt_pk_bf16(bflo(v.w) * silu_f(bflo(z.w)), bfhi(v.w) * silu_f(bfhi(z.w)));
        *(u32x4*)(OB + o) = w; }
    }
}
__device__ __forceinline__ void d2_phase(const Params& p, LAS unsigned char* lds) {
    const int tid = threadIdx.x, wave = __builtin_amdgcn_readfirstlane(tid >> 6), G = gridDim.x;
    const bf16_t* CKV = (const bf16_t*)(p.ws + OFF_CKV); bf16_t* QL = (bf16_t*)(p.ws + OFF_QL); const u16_t* IDX = (const u16_t*)((const char*)p.out + OO_IDX);
    LAS unsigned char* kb = lds + wave * D2_KB; LAS float* sbias = (LAS float*)(lds + D2_BIAS);
    for (int i = tid; i < 129 * 8; i += NTHR) sbias[i] = p.in[16][t5_bucket(i >> 3) * 8 + (i & 7)];
    __syncthreads();
    for (int grp = blockIdx.x; grp < 256; grp += G) {
      const int b = grp & 7, c8 = grp >> 3;
      d2_qlat(p, kb, b, c8, wave, tid & 63);
      asm volatile("s_waitcnt vmcnt(0)" ::: "memory");
      __syncthreads();
#pragma unroll 1
      for (int kk = 0; kk < 8; ++kk) {
        int lane = tid & 63; asm volatile("" : "+v"(lane));
        const int c16 = lane & 15, q = lane >> 4, t = kk * 256 + c8 * 8 + wave;
        const size_t token = (size_t)b * NT + t;
        const int n_sel = (t + 1 < 256) ? (t + 1) : 256, nch = (n_sel + 31) >> 5;
        const __amdgpu_buffer_rsrc_t rck = __builtin_amdgcn_make_buffer_rsrc((void*)(CKV + (size_t)b * NT * 256), 0, NT * 512, 0x00020000); const unsigned gvo = 16u * (lane & 31);
        unsigned iw0, iw1;
        if (t < 256) { const int k0 = 4 * lane; iw0 = (unsigned)(k0 < n_sel ? k0 : 0) | ((unsigned)(k0 + 1 < n_sel ? k0 + 1 : 0) << 16); iw1 = (unsigned)(k0 + 2 < n_sel ? k0 + 2 : 0) | ((unsigned)(k0 + 3 < n_sel ? k0 + 3 : 0) << 16); }
        else { const u32x2 w = *(const u32x2*)(IDX + token * 256 + 4 * lane); iw0 = w.x; iw1 = w.y; }
        bf16x8 bq[8];
#pragma unroll
        for (int s = 0; s < 8; ++s) {
            u32x4 v = (u32x4){0u, 0u, 0u, 0u};
            if (c16 < 8) v = *(const u32x4*)(QL + token * 2048 + c16 * 256 + 32 * s + 8 * q);
            bq[s] = __builtin_bit_cast(bf16x8, v);
        }
        f32x4 O[16];
#pragma unroll
        for (int i = 0; i < 16; ++i) O[i] = (f32x4){0.f, 0.f, 0.f, 0.f};
        float mrun = -1.0e30f, lrun = 0.f;
        u32x4 g[16];
#define D2_GATHER(c) do { _Pragma("unroll") for (int i = 0; i < 16; ++i) { \
            const unsigned wa = (unsigned)__builtin_amdgcn_readlane((int)(((2 * i) & 2) ? iw1 : iw0), 8 * (c) + ((2 * i) >> 2)); \
            const int ka = (int)(wa & 0xFFFFu), kb2 = (int)(wa >> 16); const int key = (lane >> 5) ? kb2 : ka; \
            g[i] = __builtin_amdgcn_raw_buffer_load_b128(rck, gvo + ((unsigned)key << 9), 0, 0); } } while (0)
        D2_GATHER(0);
#pragma unroll 1
        for (int ch = 0; ch < nch; ++ch) {
#pragma unroll
            for (int i = 0; i < 16; ++i) *(LAS u32x4*)(kb + (2 * i + (lane >> 5)) * D2_RB + 16 * (lane & 31)) = g[i];
            if (ch + 1 < nch) D2_GATHER(ch + 1);
            f32x4 sc[2];
#pragma unroll
            for (int kt = 0; kt < 2; ++kt) { sc[kt] = (f32x4){0.f, 0.f, 0.f, 0.f};
                bf16x8 fa[8];
#pragma unroll
                for (int s = 0; s < 8; ++s) fa[s] = *(const LAS bf16x8*)(kb + (16 * kt + c16) * D2_RB + (32 * s + 8 * q) * 2);
                __builtin_amdgcn_sched_barrier(0);
#pragma unroll
                for (int s = 0; s < 8; ++s) sc[kt] = MFMA16(fa[s], bq[s], sc[kt]);
                __builtin_amdgcn_sched_barrier(0); }
            float cmax = -1.0e30f;
#pragma unroll
            for (int kt = 0; kt < 2; ++kt) {
                const unsigned w0 = (unsigned)__shfl((int)iw0, 8 * ch + 4 * kt + q), w1 = (unsigned)__shfl((int)iw1, 8 * ch + 4 * kt + q);
#pragma unroll
                for (int e = 0; e < 4; ++e) {
                    const int sl = 16 * kt + 4 * q + e; const unsigned ww = (e & 2) ? w1 : w0; const int key = (e & 1) ? (int)(ww >> 16) : (int)(ww & 0xFFFFu);
                    const int dist = t - key; const float bias = sbias[(dist < 128 ? dist : 128) * 8 + (c16 & 7)];
                    const float v = (ch * 32 + sl < n_sel) ? sc[kt][e] + bias : -1.0e30f;
                    sc[kt][e] = v; cmax = fmaxf(cmax, v);
                }
            }
            cmax = fmaxf(cmax, __shfl_xor(cmax, 16)); cmax = fmaxf(cmax, __shfl_xor(cmax, 32));
            const bool resc = __any(cmax > mrun + 8.0f);
            const float mnew = resc ? fmaxf(mrun, cmax) : mrun, alpha = resc ? __expf(mrun - mnew) : 1.0f;
            float psum = 0.f;
#pragma unroll
            for (int kt = 0; kt < 2; ++kt)
#pragma unroll
                for (int e = 0; e < 4; ++e) { const float pv = __expf(sc[kt][e] - mnew); sc[kt][e] = pv; psum += pv; }
            lrun = lrun * alpha + psum; mrun = mnew;
            if (resc) {
#pragma unroll
                for (int mt = 0; mt < 16; ++mt) O[mt] = O[mt] * alpha;
            }
            f32x8 pf;
#pragma unroll
            for (int e = 0; e < 4; ++e) { pf[e] = sc[0][e]; pf[4 + e] = sc[1][e]; }
            const bf16x8 pb = __builtin_bit_cast(bf16x8, __builtin_convertvector(pf, bf16x8_t));
            {
                s16x4 ft[2][8];
#define D2_LDT(buf, m4) do { _Pragma("unroll") for (int j = 0; j < 4; ++j) { \
                    ft[buf][2 * j] = __builtin_amdgcn_ds_read_tr16_b64_v4i16((LAS s16x4*)(kb + (4 * q + (c16 >> 2)) * D2_RB + (16 * (4 * (m4) + j) + 4 * (lane & 3)) * 2)); \
                    ft[buf][2 * j + 1] = __builtin_amdgcn_ds_read_tr16_b64_v4i16((LAS s16x4*)(kb + (16 + 4 * q + (c16 >> 2)) * D2_RB + (16 * (4 * (m4) + j) + 4 * (lane & 3)) * 2)); } } while (0)
                D2_LDT(0, 0);
#pragma unroll
                for (int m4 = 0; m4 < 4; ++m4) {
                    if (m4 + 1 < 4) D2_LDT((m4 + 1) & 1, m4 + 1);
                    __builtin_amdgcn_sched_barrier(0);
#pragma unroll
                    for (int j = 0; j < 4; ++j) {
                        const bf16x8 a = __builtin_shufflevector(ft[m4 & 1][2 * j], ft[m4 & 1][2 * j + 1], 0, 1, 2, 3, 4, 5, 6, 7);
                        O[4 * m4 + j] = MFMA16(a, pb, O[4 * m4 + j]);
                    }
                    __builtin_amdgcn_sched_barrier(0);
                }
#undef D2_LDT
            }
        }
#undef D2_GATHER
        float lt = lrun + __shfl_xor(lrun, 16); lt += __shfl_xor(lt, 32);
        const float inv = __builtin_amdgcn_rcpf(lt);
        if (c16 < 8 && !p.pad) {
#pragma unroll
            for (int mt = 0; mt < 16; ++mt) { u32x2 w; w.x = cvt_pk_bf16(O[mt][0] * inv, O[mt][1] * inv); w.y = cvt_pk_bf16(O[mt][2] * inv, O[mt][3] * inv);
                *(u32x2*)(QL + token * 2048 + c16 * 256 + 16 * mt + 4 * q) = w; }
        }
      }
      asm volatile("s_waitcnt vmcnt(0)" ::: "memory");
      __syncthreads();
      d2_wuv(p, kb, b, c8, wave, tid & 63);
      __syncthreads();
    }
}
constexpr int D1_SC = 0, D1_WI = 16 * 2048 * 4;
static_assert(D1_WI + 512 + 8 * 256 <= LDSCTL_OFF, "indexer LDS map");
__device__ __forceinline__ void d1_phase(const Params& p, LAS unsigned char* lds) {
    const int tid = threadIdx.x, wave = __builtin_amdgcn_readfirstlane(tid >> 6), G = gridDim.x;
    const bf16_t* QI = (const bf16_t*)(p.ws + OFF_QI); const bf16_t* KI = (const bf16_t*)(p.ws + OFF_KI); const float* SMALL = (const float*)(p.ws + OFF_SMALL);
    u16_t* IDX = (u16_t*)((char*)p.out + OO_IDX);
    LAS float* sc = (LAS float*)(lds + D1_SC); LAS float* swi = (LAS float*)(lds + D1_WI);
    unsigned* qhead = (unsigned*)(p.ws + OFF_CTL) + CW_D1Q + (p.pad == 2 ? 64 : 0); volatile LAS int* qslot = (volatile LAS int*)(lds + LDSCTL_OFF + 128);
    for (;;) {
        if (tid == 0) *qslot = (int)__hip_atomic_fetch_add(qhead, 1u, __ATOMIC_RELAXED, __HIP_MEMORY_SCOPE_AGENT);
        __syncthreads();
        const int unit = *qslot;
        __syncthreads();
        if (unit >= 896) break;
        int lane = tid & 63; asm volatile("" : "+v"(lane));
        const int r = lane & 31, hh = lane >> 5;
        const int b = unit & 7, t0 = 256 + 16 * (111 - (unit >> 3));
        const size_t tok0 = (size_t)b * NT + t0;
        if (tid < 128) swi[tid] = SMALL[(tok0 + (tid >> 3)) * 32 + 16 + (tid & 7)] * 0.04419417382415922f;
        const int tokr = ((r >> 2) & 1) | ((r >> 4) << 1), headr = (r & 3) | (((r >> 3) & 1) << 2);
        bf16x8 af[4][4];
#pragma unroll
        for (int mt = 0; mt < 4; ++mt)
#pragma unroll
            for (int s = 0; s < 4; ++s) af[mt][s] = *(const bf16x8*)(QI + (tok0 + 4 * mt + tokr) * 512 + headr * 64 + 16 * s + 8 * hh);
        __syncthreads();
        const int ntiles = (t0 + 16 + 31) >> 5;
        bf16x8 bnx[4];
        if (wave < ntiles) {
#pragma unroll
            for (int s = 0; s < 4; ++s) bnx[s] = *(const bf16x8*)(KI + ((size_t)b * NT + 32 * wave + r) * 64 + 16 * s + 8 * hh);
        }
#pragma unroll 1
        for (int nt = wave; nt < ntiles; nt += NWAVES) {
            const int key = 32 * nt + r;
            bf16x8 bfr[4];
#pragma unroll
            for (int s = 0; s < 4; ++s) bfr[s] = bnx[s];
            if (nt + NWAVES < ntiles) {
#pragma unroll
                for (int s = 0; s < 4; ++s) bnx[s] = *(const bf16x8*)(KI + ((size_t)b * NT + key + 32 * NWAVES) * 64 + 16 * s + 8 * hh);
            }
#pragma unroll
            for (int mt = 0; mt < 4; ++mt) {
                f32x16 acc;
#pragma unroll
                for (int e = 0; e < 16; ++e) acc[e] = 0.f;
#pragma unroll
                for (int s = 0; s < 4; ++s) acc = MFMA32(af[mt][s], bfr[s], acc);
                const int ta = 4 * mt + hh, tb = ta + 2;
                const f32x4 wa0 = *(const LAS f32x4*)(swi + ta * 8), wa1 = *(const LAS f32x4*)(swi + ta * 8 + 4), wb0 = *(const LAS f32x4*)(swi + tb * 8), wb1 = *(const LAS f32x4*)(swi + tb * 8 + 4);
                float s0 = 0.f, s1 = 0.f;
#pragma unroll
                for (int e = 0; e < 4; ++e) { s0 += wa0[e] * fmaxf(acc[e], 0.f); s0 += wa1[e] * fmaxf(acc[4 + e], 0.f); s1 += wb0[e] * fmaxf(acc[8 + e], 0.f); s1 += wb1[e] * fmaxf(acc[12 + e], 0.f); }
                sc[ta * 2048 + key] = s0; sc[tb * 2048 + key] = s1;
            }
        }
        __syncthreads();
#pragma unroll 1
        for (int tt = 0; tt < 2; ++tt) {
            const int ti = 2 * wave + tt, t = t0 + ti;
            unsigned u[32];
#pragma unroll
            for (int i = 0; i < 32; ++i) u[i] = 0u;
#pragma unroll
            for (int g8 = 0; g8 < 4; ++g8) if (g8 * 512 <= t) _Pragma("unroll") for (int i = 8 * g8; i < 8 * g8 + 8; ++i) {
                const int key = lane + 64 * i;
                float x = sc[ti * 2048 + key] + 0.0f;
                unsigned v = __float_as_uint(x); v = (v & 0x80000000u) ? ~v : (v | 0x80000000u);
                u[i] = (key <= t) ? v : 0u;
            }
            unsigned P = 0u, Q = 0xFFFFFFFFu; int cQ = 0, cP = 2048;
            bool exact = false; int bit = 31;
#pragma unroll 1
            for (; bit >= 0; --bit) {
                const unsigned cand = P | (1u << bit);
                int cl = 0;
#pragma unroll
                for (int g8 = 0; g8 < 4; ++g8) if (g8 * 512 <= t) _Pragma("unroll") for (int i = 8 * g8; i < 8 * g8 + 8; ++i) cl += (u[i] >= cand) ? 1 : 0;
                int cnt = 0;
#pragma unroll
                for (int bb = 0; bb < 6; ++bb) cnt += __popcll(__ballot((cl >> bb) & 1)) << bb;
                if (cnt >= 256) { P = cand; cP = cnt; if (cnt == 256) { exact = true; break; } }
                else { Q = cand; cQ = cnt; }
                if (cP - cQ <= 64) { --bit; break; }
            }
            if (!exact && bit >= 0) {
                LAS unsigned* wsc = (LAS unsigned*)(lds + D1_WI + 512) + wave * 64;
                int pos = 0;
#pragma unroll
                for (int g8 = 0; g8 < 4; ++g8) if (g8 * 512 <= t) _Pragma("unroll") for (int i = 8 * g8; i < 8 * g8 + 8; ++i) { const bool in = (u[i] >= P) && (u[i] < Q); const unsigned long long m = __ballot(in);
                    if (in) wsc[pos + __builtin_amdgcn_mbcnt_hi((unsigned)(m >> 32), __builtin_amdgcn_mbcnt_lo((unsigned)m, 0u))] = u[i];
                    pos += __popcll(m); }
                const int mcnt = pos, rneed = 256 - cQ;
                const unsigned x = (lane < mcnt) ? wsc[lane] : 0u;
                int gt = 0;
                for (int m2 = 0; m2 < mcnt; ++m2) { const unsigned y = (unsigned)__builtin_amdgcn_readlane((int)x, m2); gt += (y > x) ? 1 : 0; }
                unsigned cand2 = (lane < mcnt && gt < rneed) ? x : 0xFFFFFFFFu;
#pragma unroll
                for (int o = 32; o > 0; o >>= 1) { const unsigned y = (unsigned)__shfl_xor((int)cand2, o); cand2 = y < cand2 ? y : cand2; }
                P = cand2;
                const int gtc = __popcll(__ballot(lane < mcnt && x > cand2)), eqc = __popcll(__ballot(lane < mcnt && x == cand2));
                exact = (cQ + gtc + eqc == 256);
            }
            u16_t* out = IDX + (tok0 + ti) * 256;
            int pos = 0;
            if (exact) {
#pragma unroll
                for (int g8 = 0; g8 < 4; ++g8) if (g8 * 512 <= t) _Pragma("unroll") for (int i = 8 * g8; i < 8 * g8 + 8; ++i) { const bool sel = u[i] >= P; const unsigned long long m = __ballot(sel);
                    if (sel) out[pos + __builtin_amdgcn_mbcnt_hi((unsigned)(m >> 32), __builtin_amdgcn_mbcnt_lo((unsigned)m, 0u))] = (u16_t)(lane + 64 * i);
                    pos += __popcll(m); }
            } else {
#pragma unroll
                for (int g8 = 0; g8 < 4; ++g8) if (g8 * 512 <= t) _Pragma("unroll") for (int i = 8 * g8; i < 8 * g8 + 8; ++i) { const bool sel = u[i] > P; const unsigned long long m = __ballot(sel);
                    if (sel) out[pos + __builtin_amdgcn_mbcnt_hi((unsigned)(m >> 32), __builtin_amdgcn_mbcnt_lo((unsigned)m, 0u))] = (u16_t)(lane + 64 * i);
                    pos += __popcll(m); }
                int need = 256 - pos;
#pragma unroll
                for (int g8 = 0; g8 < 4; ++g8) if (g8 * 512 <= t) _Pragma("unroll") for (int i = 8 * g8; i < 8 * g8 + 8; ++i) { const bool eq = u[i] == P; const unsigned long long m = __ballot(eq);
                    const int rk = __builtin_amdgcn_mbcnt_hi((unsigned)(m >> 32), __builtin_amdgcn_mbcnt_lo((unsigned)m, 0u));
                    if (eq && rk < need) out[pos + rk] = (u16_t)(lane + 64 * i);
                    const int c = __popcll(m), take = c < need ? c : need; pos += take; need -= take; }
            }
        }
        __syncthreads();
    }
}
__device__ __forceinline__ void ckvnorm_phase(const Params& p) {
    const int tid = threadIdx.x, lane = tid & 63, wave = tid >> 6, G = gridDim.x;
    bf16_t* CKV = (bf16_t*)(p.ws + OFF_CKV); const float* g = p.in[11];
    const f32x4 gv = *(const f32x4*)(g + 4 * lane);
    for (int row = blockIdx.x * NWAVES + wave; row < MROWS; row += G * NWAVES) {
        u32x2* rp = (u32x2*)(CKV + (size_t)row * 256 + 4 * lane);
        const u32x2 w = *rp; const float v0 = bflo(w.x), v1 = bfhi(w.x), v2 = bflo(w.y), v3 = bfhi(w.y);
        const float ss = wave_sum(v0 * v0 + v1 * v1 + v2 * v2 + v3 * v3);
        const float rs = rsqrtf(ss * (1.f / 256.f) + 1e-6f);
        u32x2 o; o.x = cvt_pk_bf16(v0 * rs * gv[0], v1 * rs * gv[1]); o.y = cvt_pk_bf16(v2 * rs * gv[2], v3 * rs * gv[3]);
        *rp = o;
    }
}
__global__ void __launch_bounds__(NTHR, 2) fwd(Params p) {
    extern __shared__ __attribute__((aligned(16))) unsigned char lds_raw[];
    LAS unsigned char* lds = (LAS unsigned char*)lds_raw;
    const int tid = threadIdx.x;
    for (int u = tid; u < (LDS_BYTES - LDSCTL_OFF) / 4; u += NTHR) ((LAS unsigned*)(lds + LDSCTL_OFF))[u] = 0u;
    __syncthreads();
    const Bufs B = make_bufs(p.ws, (char*)p.out);
    const int lo = p.ph_lo, hi = p.ph_hi;
    unsigned* barw = (unsigned*)(p.ws + OFF_CTL) + CW_BAR + p.li * XCD_BAR_WORDS;
    XcdBarrier bar; bar.bar = barw; bar.x = 0; bar.st = nullptr;
    if (hi - lo > 1) bar = xcd_barrier_post(barw, (volatile LAS unsigned*)(lds + LDSCTL_OFF + 64));
#define IN(k) (lo <= (k) && (k) < hi)
#define SEAM(k) do { if (IN(k) && IN((k) + 1)) xcd_barrier(bar); } while (0)
    if (IN(0)) { p0_prologue(p, B, lds); SEAM(0); }
    if (IN(1)) { p1_h(p, B); SEAM(1); }
    if (IN(2)) {
        SchedProj S; S.so.init(MROWS, NPAD, gridDim.x, blockIdx.x); S.A = (const char*)B.H; S.Bt = (const char*)B.WT;
        EpiProj E{p.ws, (char*)p.out};
        pg8::gemm_phase<EpiProj, SchedProj, true, true>(lds + RING_OFF, DM, DM, DM, S, E);
        SEAM(2);
    }
    if (IN(3)) { g1_phase(p, lds); ckvnorm_phase(p); SEAM(3); }
    if (IN(4)) { if (p.pad != 2) g2_phase(p, lds); d1_phase(p, lds); SEAM(4); }
    if (IN(5)) { d2_phase(p, lds); SEAM(5); }
    if (IN(6)) {
        SchedMerge S; S.so.init(MROWS, DM, gridDim.x, blockIdx.x); S.ws = p.ws; S.os = (const char*)p.out;
        EpiMerge E{B.MERGED, B.PARK};
        pg8::gemm_phase<EpiMerge, SchedMerge, true, true>(lds + RING_OFF, DM, DM, DM, S, E);
        SEAM(6);
    }
    if (IN(7)) {
        SchedProj S; S.so.init(MROWS, DM, gridDim.x, blockIdx.x); S.A = (const char*)B.MERGED; S.Bt = (const char*)B.WOUT_T;
        EpiOut E{p.in[0], B.MOD, B.XNEW};
        pg8::gemm_phase<EpiOut, SchedProj, true, true>(lds + RING_OFF, DM, DM, DM, S, E);
        SEAM(7);
    }
    if (IN(8)) { p8_final(p, B); }
#undef IN
#undef SEAM
}

extern "C" void kernel_launch(void* const* d_in, const int* in_sizes, int n_in, void* d_out, int out_size, void* d_ws, size_t ws_size, hipStream_t stream) {
    static int grid = 0;
    if (grid == 0) {
        if (n_in != 18 || ws_size < WS_NEED || out_size != MROWS * DM) { fprintf(stderr, "kernel_launch: unexpected shapes (n_in %d, ws %zu, out %d)\n", n_in, ws_size, out_size); grid = -1; return; }
        int dev = 0, cus = 0;
        if (hipGetDevice(&dev) != hipSuccess || hipDeviceGetAttribute(&cus, hipDeviceAttributeMultiprocessorCount, dev) != hipSuccess) { grid = -1; return; }
        if (hipFuncSetAttribute((const void*)fwd, hipFuncAttributeMaxDynamicSharedMemorySize, LDS_BYTES) != hipSuccess) { fprintf(stderr, "kernel_launch: hipFuncSetAttribute failed\n"); grid = -1; return; }
        int per_cu = 0;
        if (hipOccupancyMaxActiveBlocksPerMultiprocessor(&per_cu, (const void*)fwd, NTHR, LDS_BYTES) != hipSuccess || per_cu < 1) fprintf(stderr, "kernel_launch: occupancy query says %d\n", per_cu);
        (void)hipGetLastError();
        grid = cus > 0 ? cus : 256;
    }
    if (grid < 0) return;
    (void)hipMemsetAsync((char*)d_ws + OFF_CTL, 0, CTL_ZERO_BYTES, stream);
    Params p{};
    for (int i = 0; i < 18; ++i) p.in[i] = (const float*)d_in[i];
    p.out = (float*)d_out; p.ws = (char*)d_ws;
    int li = 0;
#define FWD(lo_, hi_) do { p.pad = 0; p.ph_lo = (lo_); p.ph_hi = (hi_); p.li = ((hi_) - (lo_) > 1) ? li++ : 0; hipLaunchKernelGGL(fwd, dim3(grid), dim3(NTHR), LDS_BYTES, stream, p); } while (0)
#define DRY(lo_, hi_) do { p.pad = 1; p.ph_lo = (lo_); p.ph_hi = (hi_); p.li = 0; hipLaunchKernelGGL(fwd, dim3(grid), dim3(NTHR), LDS_BYTES, stream, p); } while (0)
#if PROBE_SEQ == 0
    FWD(0, 9);
#elif PROBE_SEQ == 1
    FWD(0, 3); DRY(3, 4); FWD(3, 9);
#elif PROBE_SEQ == 2
    FWD(0, 4); DRY(4, 5); FWD(4, 9);
#elif PROBE_SEQ == 3
    FWD(0, 5); DRY(5, 6); FWD(5, 9);
#elif PROBE_SEQ == 4
    FWD(0, 4); p.pad = 2; p.ph_lo = 4; p.ph_hi = 5; p.li = 0; hipLaunchKernelGGL(fwd, dim3(grid), dim3(NTHR), LDS_BYTES, stream, p); FWD(4, 9);
#endif
#undef FWD
}
```
